# Optimizing an MI355X kernel written in HIP

```python
import jax, jax.numpy as jnp
from jax import lax
import numpy as np

D_MODEL = 1024
BATCH = 8
SEQ = 8192
DEPTH = 1

GRID_W = 64
PLE_DIM = 256
ATTN_HEADS = 8
ATTN_KV_HEADS = 2
ATTN_HEAD_DIM = 64
ATTN_GROUP = ATTN_HEADS // ATTN_KV_HEADS
Q_BLOCK = 128
ROPE_THETA = 10000.0
ATTN_Q_W = ATTN_HEADS * ATTN_HEAD_DIM
ATTN_KV_W = ATTN_KV_HEADS * ATTN_HEAD_DIM
DN_HEADS = 4
DN_HEAD_K = 128
DN_HEAD_V = 128
DN_CHUNK = 64
CONV_W = 5
DN_QK_W = DN_HEADS * DN_HEAD_K
DN_V_W = DN_HEADS * DN_HEAD_V
DN_QKV_W = 2 * DN_QK_W + DN_V_W
IN_W = ATTN_Q_W + 2 * ATTN_KV_W + DN_QKV_W + DN_V_W + 4 * DN_HEADS
MIX_W = ATTN_Q_W + DN_V_W
FF_DIM = -(-8 * D_MODEL // (3 * 256)) * 256
EPS = 1e-6

kernel_name = "hymba_gqa_axialrope_gdeltanet_swiglu_ple"


def rms_norm(x, gain):
    xf = x.astype(jnp.float32)
    y = xf * lax.rsqrt(jnp.mean(xf * xf, axis=-1, keepdims=True) + EPS)
    return (y * gain.astype(jnp.float32)).astype(x.dtype)


def l2_norm(x):
    return x * lax.rsqrt(jnp.sum(x * x, axis=-1, keepdims=True) + EPS)


def rope_1d(x, ang):
    c = jnp.cos(ang)[:, None, :].astype(x.dtype)
    s = jnp.sin(ang)[:, None, :].astype(x.dtype)
    half = x.shape[-1] // 2
    x1, x2 = x[..., :half], x[..., half:]
    return jnp.concatenate([x1 * c - x2 * s, x2 * c + x1 * s], axis=-1)


def axial_rope(x, ang_row, ang_col):
    half = x.shape[-1] // 2
    return jnp.concatenate([rope_1d(x[..., :half], ang_row), rope_1d(x[..., half:], ang_col)], axis=-1)


def grid_angles(s):
    rows = s // GRID_W
    row = jnp.broadcast_to(jnp.arange(rows, dtype=jnp.float32)[:, None], (rows, GRID_W)).reshape(s)
    col = jnp.broadcast_to(jnp.arange(GRID_W, dtype=jnp.float32)[None, :], (rows, GRID_W)).reshape(s)
    sec = ATTN_HEAD_DIM // 2
    inv_freq = ROPE_THETA ** (-jnp.arange(0, sec, 2, dtype=jnp.float32) / sec)
    return row[:, None] * inv_freq[None, :], col[:, None] * inv_freq[None, :]


def block_attention(q, k, v):
    b, s, _, d = q.shape
    nb = s // Q_BLOCK
    qb = jnp.moveaxis(q.reshape(b, nb, Q_BLOCK, ATTN_KV_HEADS, ATTN_GROUP, d), 1, 0)
    scale = d ** -0.5

    def one_block(q_blk):
        scores = jnp.einsum('bqkgd,bskd->bkgqs', q_blk, k, preferred_element_type=jnp.float32) * scale
        probs = jax.nn.softmax(scores, axis=-1).astype(v.dtype)
        return jnp.einsum('bkgqs,bskd->bqkgd', probs, v)

    out = lax.map(one_block, qb)
    return jnp.moveaxis(out, 0, 1).reshape(b, s, ATTN_HEADS * d)


def chunked_gated_delta_rule(q, k, v, g, beta):
    b, h, s, dk = q.shape
    dv = v.shape[-1]
    c = DN_CHUNK
    n = s // c
    q = q.reshape(b, h, n, c, dk)
    k = k.reshape(b, h, n, c, dk)
    v = v.reshape(b, h, n, c, dv)
    beta = beta.reshape(b, h, n, c)
    G = jnp.cumsum(g.reshape(b, h, n, c), axis=-1)
    incl = jnp.tril(jnp.ones((c, c), dtype=bool))
    strict = jnp.tril(jnp.ones((c, c), dtype=bool), -1)
    diff = G[..., :, None] - G[..., None, :]
    decay = jnp.where(incl, jnp.exp(jnp.where(incl, diff, 0.0)), 0.0)
    k_beta = k * beta[..., None]
    a_mat = jnp.where(strict, jnp.einsum('bhnid,bhnjd->bhnij', k_beta, k) * decay, 0.0) + jnp.eye(c, dtype=q.dtype)
    rhs = jnp.concatenate([v * beta[..., None], k_beta * jnp.exp(G)[..., None]], axis=-1)
    sol = lax.linalg.triangular_solve(a_mat, rhs, left_side=True, lower=True, unit_diagonal=True)
    u, w = sol[..., :dv], sol[..., dv:]
    qk = jnp.einsum('bhnid,bhnjd->bhnij', q, k) * decay
    q_dec = q * jnp.exp(G)[..., None]
    k_dec = k * jnp.exp(G[..., -1:] - G)[..., None]
    g_tot = jnp.exp(G[..., -1])
    xs = tuple(jnp.moveaxis(t, 2, 0) for t in (w, u, qk, q_dec, k_dec, g_tot))

    def step(state, inp):
        w_c, u_c, qk_c, qd_c, kd_c, gt_c = inp
        v_new = u_c - jnp.einsum('bhck,bhkv->bhcv', w_c, state)
        o_c = jnp.einsum('bhck,bhkv->bhcv', qd_c, state) + jnp.einsum('bhcj,bhjv->bhcv', qk_c, v_new)
        state = state * gt_c[..., None, None] + jnp.einsum('bhck,bhcv->bhkv', kd_c, v_new)
        return state, o_c

    state0 = jnp.zeros((b, h, dk, dv), dtype=q.dtype)
    _, o = lax.scan(step, state0, xs)
    return jnp.moveaxis(o, 0, 2).reshape(b, h, s, dv)


def deltanet_mixer(qkv, z, b_raw, a_raw, conv_w, a_log, dt_bias, norm_gain):
    b, s, _ = qkv.shape
    dtype = qkv.dtype
    f32 = jnp.float32
    qkv = jax.nn.silu(lax.conv_general_dilated(
        qkv, conv_w[:, None, :], window_strides=(1,), padding=[(CONV_W // 2, CONV_W // 2)],
        dimension_numbers=('NWC', 'WIO', 'NWC'), feature_group_count=DN_QKV_W))
    q, k, v = jnp.split(qkv.astype(f32), [DN_QK_W, 2 * DN_QK_W], axis=-1)
    q = l2_norm(q.reshape(b, s, DN_HEADS, DN_HEAD_K).transpose(0, 2, 1, 3)) * (DN_HEAD_K ** -0.5)
    k = l2_norm(k.reshape(b, s, DN_HEADS, DN_HEAD_K).transpose(0, 2, 1, 3))
    v = v.reshape(b, s, DN_HEADS, DN_HEAD_V).transpose(0, 2, 1, 3)
    beta = jax.nn.sigmoid(b_raw.astype(f32))
    g = -jnp.exp(a_log.astype(f32)) * jax.nn.softplus(a_raw.astype(f32) + dt_bias.astype(f32))
    q2 = jnp.concatenate([q, jnp.flip(q, axis=2)], axis=1)
    k2 = jnp.concatenate([k, jnp.flip(k, axis=2)], axis=1)
    v2 = jnp.concatenate([v, jnp.flip(v, axis=2)], axis=1)
    g2 = jnp.concatenate([g[..., :DN_HEADS], jnp.flip(g[..., DN_HEADS:], axis=1)], axis=-1).transpose(0, 2, 1)
    beta2 = jnp.concatenate([beta[..., :DN_HEADS], jnp.flip(beta[..., DN_HEADS:], axis=1)], axis=-1).transpose(0, 2, 1)
    o2 = chunked_gated_delta_rule(q2, k2, v2, g2, beta2)
    o = o2[:, :DN_HEADS] + jnp.flip(o2[:, DN_HEADS:], axis=2)
    o = o.transpose(0, 2, 1, 3)
    o = rms_norm(o, norm_gain) * jax.nn.silu(z.reshape(b, s, DN_HEADS, DN_HEAD_V).astype(f32))
    return o.reshape(b, s, DN_V_W).astype(dtype)


def setup_inputs(seed: int = 0) -> dict:
    key = jax.random.key(seed)
    ks = jax.random.split(key, 20)
    nrm = lambda k_, shape, scale: jax.random.normal(k_, shape, dtype=jnp.float32) * scale
    gain = lambda k_, shape: 1.0 + 0.01 * jax.random.normal(k_, shape, dtype=jnp.float32)
    dt = jnp.exp(jax.random.uniform(ks[8], (DEPTH, 2 * DN_HEADS), minval=np.log(0.001), maxval=np.log(0.1)))
    return {
        "x": nrm(ks[0], (BATCH, SEQ, D_MODEL), 1.0),
        "p": nrm(ks[1], (DEPTH, BATCH, SEQ, PLE_DIM), 1.0),
        "norm_mix": gain(ks[2], (DEPTH, D_MODEL)),
        "w_in": nrm(ks[3], (DEPTH, D_MODEL, IN_W), D_MODEL ** -0.5),
        "conv_w": nrm(ks[4], (DEPTH, CONV_W, DN_QKV_W), CONV_W ** -0.5),
        "q_norm": gain(ks[5], (DEPTH, ATTN_HEAD_DIM)),
        "k_norm": gain(ks[6], (DEPTH, ATTN_HEAD_DIM)),
        "a_log": jnp.log(jax.random.uniform(ks[7], (DEPTH, 2 * DN_HEADS), minval=1.0, maxval=16.0)),
        "dt_bias": dt + jnp.log(-jnp.expm1(-dt)),
        "dn_norm": gain(ks[9], (DEPTH, DN_HEAD_V)),
        "w_out": nrm(ks[10], (DEPTH, MIX_W, D_MODEL), MIX_W ** -0.5),
        "norm_ffn": gain(ks[11], (DEPTH, D_MODEL)),
        "w_gate": nrm(ks[12], (DEPTH, D_MODEL, FF_DIM), D_MODEL ** -0.5),
        "w_up": nrm(ks[13], (DEPTH, D_MODEL, FF_DIM), D_MODEL ** -0.5),
        "w_down": nrm(ks[14], (DEPTH, FF_DIM, D_MODEL), FF_DIM ** -0.5),
        "norm_ple": gain(ks[15], (DEPTH, D_MODEL)),
        "w_ple_gate": nrm(ks[16], (DEPTH, D_MODEL, D_MODEL), D_MODEL ** -0.5),
        "w_ple": nrm(ks[17], (DEPTH, PLE_DIM, D_MODEL), PLE_DIM ** -0.5),
        "norm_final": gain(ks[18], (D_MODEL,)),
    }


def reference(x, p, norm_mix, w_in, conv_w, q_norm, k_norm, a_log, dt_bias, dn_norm, w_out,
              norm_ffn, w_gate, w_up, w_down, norm_ple, w_ple_gate, w_ple, norm_final):
    b, s, _ = x.shape
    ang_row, ang_col = grid_angles(s)
    split_at = list(np.cumsum([ATTN_Q_W, ATTN_KV_W, ATTN_KV_W, DN_QKV_W, DN_V_W, 2 * DN_HEADS]))
    h = x
    for i in range(DEPTH):
        hn = rms_norm(h, norm_mix[i])
        proj = hn @ w_in[i]
        aq, ak, av, dqkv, dz, dbeta, dalpha = jnp.split(proj, split_at, axis=-1)
        aq = axial_rope(rms_norm(aq.reshape(b, s, ATTN_HEADS, ATTN_HEAD_DIM), q_norm[i]), ang_row, ang_col)
        ak = axial_rope(rms_norm(ak.reshape(b, s, ATTN_KV_HEADS, ATTN_HEAD_DIM), k_norm[i]), ang_row, ang_col)
        av = av.reshape(b, s, ATTN_KV_HEADS, ATTN_HEAD_DIM)
        attn_out = block_attention(aq, ak, av)
        dn_out = deltanet_mixer(dqkv, dz, dbeta, dalpha, conv_w[i], a_log[i], dt_bias[i], dn_norm[i])
        mixed = jnp.concatenate([attn_out.astype(h.dtype), dn_out.astype(h.dtype)], axis=-1)
        h = h + mixed @ w_out[i]
        hn = rms_norm(h, norm_ffn[i])
        h = h + (jax.nn.silu(hn @ w_gate[i]) * (hn @ w_up[i])) @ w_down[i]
        gate = jax.nn.sigmoid(rms_norm(h, norm_ple[i]) @ w_ple_gate[i])
        h = h + gate * (p[i] @ w_ple[i])
    return rms_norm(h, norm_final)
```

```cpp
#include <hip/hip_runtime.h>
#include <hip/hip_cooperative_groups.h>
#include <cstdio>
#include <cstdint>
namespace pg8 {
#define PG8_LAS __attribute__((address_space(3)))
typedef unsigned short bf16_t;
typedef short bf16x8 __attribute__((ext_vector_type(8)));
typedef float f32x4 __attribute__((ext_vector_type(4)));
typedef unsigned u32x4 __attribute__((ext_vector_type(4)));
constexpr int BM = 256, BK = 64, HALF = 128, HTB = HALF * BK * 2  , STAGE_BYTES = 8 * HTB, NXCD = 8, WGM = 8;

__host__ __device__ __forceinline__ int lds_byte(int r, int c) { const int st = (r >> 4) * 2 + (c >> 5), rr = r & 15, cc = c & 31, ob = rr * 64 + cc * 2; return st * 1024 + (ob ^ (((ob >> 9) & 1) << 5)); }
__host__ __device__ __forceinline__ void stage_rc(int b, int& R, int& C) { const int st = b / 1024, sb = b % 1024, swz = sb ^ (((sb >> 9) & 1) << 5); R = (st >> 1) * 16 + swz / 64; C = (st & 1) * 32 + (swz % 64) / 2; }
__host__ __device__ __forceinline__ int perm32(int rho) { const int n = rho >> 4, i = rho & 15; return 8 * (i >> 2) + 4 * n + (i & 3); }

struct Unit { int pm, pn; };
struct Gemm { const bf16_t* A; const bf16_t* Bt; int M, N, K; };

struct StaticOrder {
    int nM, nN, nwg, G, c;
    __host__ __device__ void init(int M, int N, int G_, int c_) { nM = M / BM; nN = N / BM; nwg = nM * nN; G = G_; c = c_; }
    __host__ __device__ bool next(int i, Unit& u) const {
        const long L = (long)i * G + c; if (L >= nwg) return false;
        int wgid = (int)L; { const int q = nwg / NXCD, r = nwg % NXCD, xcd = wgid % NXCD, off = wgid / NXCD; wgid = (xcd < r ? xcd * (q + 1) : r * (q + 1) + (xcd - r) * q) + off; }
        const int nig = WGM * nN, gid = wgid / nig, fm = gid * WGM, gsz = (nM - fm) < WGM ? (nM - fm) : WGM;
        u.pm = fm + ((wgid % nig) % gsz); u.pn = (wgid % nig) / gsz; return true;
    }
    __device__ __forceinline__ void a_ready(const Unit&) const {}
    __device__ __forceinline__ void done(const Unit&) const {}
};

__device__ __forceinline__ unsigned cvt_pk_bf16(float lo, float hi) { unsigned r; asm volatile("v_cvt_pk_bf16_f32 %0, %1, %2" : "=v"(r) : "v"(lo), "v"(hi)); return r; }
typedef float f32x2 __attribute__((ext_vector_type(2)));
typedef unsigned u32x2 __attribute__((ext_vector_type(2)));
__device__ __forceinline__ float fast_sigmoid(float v) { return __builtin_amdgcn_rcpf(1.f + __expf(-v)); }
struct EpiProj {
    static constexpr bool PERM = true, AFTER_DRAIN = false;
    bf16_t* O; float* BA;
    __device__ __forceinline__ void operator()(const f32x4 (&acc)[2][2][4][2], const Unit& u, int wr, int wc, int fr, int fq) const {
        const int row0 = u.pm * BM + wr * 64 + fr;
        if (u.pn < 11) {
            const int col0 = u.pn * BM + wc * 32 + 8 * fq;
#pragma unroll
            for (int ai = 0; ai < 2; ++ai)
#pragma unroll
                for (int m = 0; m < 4; ++m) { bf16_t* rowp = O + (size_t)(row0 + ai * HALF + m * 16) * 2816 + col0;
#pragma unroll
                    for (int bj = 0; bj < 2; ++bj) { const f32x4 v0 = acc[ai][bj][m][0], v1 = acc[ai][bj][m][1];
                        u32x4 w; w.x = cvt_pk_bf16(v0[0], v0[1]); w.y = cvt_pk_bf16(v0[2], v0[3]); w.z = cvt_pk_bf16(v1[0], v1[1]); w.w = cvt_pk_bf16(v1[2], v1[3]);
                        *(u32x4*)(rowp + bj * HALF) = w; } }
        } else if (wc == 0 && fq < 2) {
#pragma unroll
            for (int ai = 0; ai < 2; ++ai)
#pragma unroll
                for (int m = 0; m < 4; ++m) { float* rowp = BA + (size_t)(row0 + ai * HALF + m * 16) * 16 + 8 * fq;
                    *(f32x4*)(rowp) = acc[ai][0][m][0]; *(f32x4*)(rowp + 4) = acc[ai][0][m][1]; }
        }
    }
};
struct EpiStore {
    static constexpr bool PERM = true, AFTER_DRAIN = false;
    bf16_t* O; int ldc;
    __device__ __forceinline__ void operator()(const f32x4 (&acc)[2][2][4][2], const Unit& u, int wr, int wc, int fr, int fq) const {
        const int row0 = u.pm * BM + wr * 64 + fr; const int col0 = u.pn * BM + wc * 32 + 8 * fq;
#pragma unroll
        for (int ai = 0; ai < 2; ++ai)
#pragma unroll
            for (int m = 0; m < 4; ++m) { bf16_t* rowp = O + (size_t)(row0 + ai * HALF + m * 16) * ldc + col0;
#pragma unroll
                for (int bj = 0; bj < 2; ++bj) { const f32x4 v0 = acc[ai][bj][m][0], v1 = acc[ai][bj][m][1];
                    u32x4 w; w.x = cvt_pk_bf16(v0[0], v0[1]); w.y = cvt_pk_bf16(v0[2], v0[3]); w.z = cvt_pk_bf16(v1[0], v1[1]); w.w = cvt_pk_bf16(v1[2], v1[3]);
                    *(u32x4*)(rowp + bj * HALF) = w; } }
    }
};
struct EpiRes {
    static constexpr bool PERM = false, AFTER_DRAIN = false;
    const float* base; float* out; bf16_t* hb; float* ss;
    __device__ __forceinline__ void operator()(const f32x4 (&acc)[2][2][4][2], const Unit& u, int wr, int wc, int fr, int fq) const {
        const int col0 = u.pn * BM + wc * 32 + 4 * fq;
#pragma unroll
        for (int ai = 0; ai < 2; ++ai)
#pragma unroll
            for (int m = 0; m < 4; ++m) { const int row = u.pm * BM + ai * HALF + wr * 64 + m * 16 + fr; const size_t off = (size_t)row * 1024 + col0; float s = 0.f;
#pragma unroll
                for (int bj = 0; bj < 2; ++bj)
#pragma unroll
                    for (int n = 0; n < 2; ++n) { const f32x4 bs = *(const f32x4*)(base + off + bj * HALF + n * 16); const f32x4 o = bs + acc[ai][bj][m][n];
                        *(f32x4*)(out + off + bj * HALF + n * 16) = o; s += (o[0] * o[0] + o[1] * o[1]) + (o[2] * o[2] + o[3] * o[3]);
                        u32x2 w; w.x = cvt_pk_bf16(o[0], o[1]); w.y = cvt_pk_bf16(o[2], o[3]); *(u32x2*)(hb + off + bj * HALF + n * 16) = w; }
                s += __shfl_xor(s, 16); s += __shfl_xor(s, 32);
                if (fq == 0) unsafeAtomicAdd(ss + row, s); }
    }
};
struct EpiGU {
    static constexpr bool PERM = true, AFTER_DRAIN = false;
    const float* ss; bf16_t* act;
    __device__ __forceinline__ void operator()(const f32x4 (&acc)[2][2][4][2], const Unit& u, int wr, int wc, int fr, int fq) const {
        const int col0 = u.pn * HALF + wc * 32 + 8 * fq;
#pragma unroll
        for (int ai = 0; ai < 2; ++ai)
#pragma unroll
            for (int m = 0; m < 4; ++m) { const int row = u.pm * BM + ai * HALF + wr * 64 + m * 16 + fr;
                const float rstd = rsqrtf(ss[row] * (1.0f / 1024.0f) + 1e-6f); float a[8];
#pragma unroll
                for (int n = 0; n < 2; ++n)
#pragma unroll
                    for (int e = 0; e < 4; ++e) { const float g = acc[ai][0][m][n][e] * rstd, up = acc[ai][1][m][n][e] * rstd; a[4 * n + e] = g * fast_sigmoid(g) * up; }
                u32x4 w; w.x = cvt_pk_bf16(a[0], a[1]); w.y = cvt_pk_bf16(a[2], a[3]); w.z = cvt_pk_bf16(a[4], a[5]); w.w = cvt_pk_bf16(a[6], a[7]);
                *(u32x4*)(act + (size_t)row * 2816 + col0) = w; }
    }
};
struct EpiPle {
    static constexpr bool PERM = false, AFTER_DRAIN = false;
    float* h; const bf16_t* pe; const float* ss2; float* ss3;
    __device__ __forceinline__ void operator()(const f32x4 (&acc)[2][2][4][2], const Unit& u, int wr, int wc, int fr, int fq) const {
        const int col0 = u.pn * BM + wc * 32 + 4 * fq;
#pragma unroll
        for (int ai = 0; ai < 2; ++ai)
#pragma unroll
            for (int m = 0; m < 4; ++m) { const int row = u.pm * BM + ai * HALF + wr * 64 + m * 16 + fr; const size_t off = (size_t)row * 1024 + col0; float s = 0.f;
                const float rstd = rsqrtf(ss2[row] * (1.0f / 1024.0f) + 1e-6f);
#pragma unroll
                for (int bj = 0; bj < 2; ++bj)
#pragma unroll
                    for (int n = 0; n < 2; ++n) { const size_t o2 = off + bj * HALF + n * 16; const f32x4 bs = *(const f32x4*)(h + o2); const u32x2 pw = *(const u32x2*)(pe + o2);
                        const f32x4 a = acc[ai][bj][m][n]; f32x4 o;
                        o[0] = bs[0] + fast_sigmoid(a[0] * rstd) * __uint_as_float(pw.x << 16); o[1] = bs[1] + fast_sigmoid(a[1] * rstd) * __uint_as_float(pw.x & 0xffff0000u);
                        o[2] = bs[2] + fast_sigmoid(a[2] * rstd) * __uint_as_float(pw.y << 16); o[3] = bs[3] + fast_sigmoid(a[3] * rstd) * __uint_as_float(pw.y & 0xffff0000u);
                        *(f32x4*)(h + o2) = o; s += (o[0] * o[0] + o[1] * o[1]) + (o[2] * o[2] + o[3] * o[3]); asm volatile("" ::: "memory"); }
                s += __shfl_xor(s, 16); s += __shfl_xor(s, 32);
                if (fq == 0) unsafeAtomicAdd(ss3 + row, s);
                asm volatile("" ::: "memory"); }
    }
};
template <class Epi, class Sched, bool ALIGN_EPI = false, bool SP2 = false>
__device__ __forceinline__ void gemm_phase(PG8_LAS unsigned char* lds, const Gemm g, const Sched& S, const Epi& E) {
    const int tid = threadIdx.x, wid = __builtin_amdgcn_readfirstlane(tid >> 6), lane = tid & 63, wr = wid >> 2, wc = wid & 3, fr = lane & 15, fq = lane >> 4;
    const int K = g.K, nt = K / BK;
    unsigned voffA[2], voffB[2];
#pragma unroll
    for (int i = 0; i < 2; ++i) { int R, C; stage_rc(tid * 16 + i * 8192, R, C); const int Rb = Epi::PERM ? ((R & ~31) + perm32(R & 31)) : R;
        voffA[i] = (unsigned)(R * K + C) * 2u; voffB[i] = (unsigned)(Rb * K + C) * 2u; }
    const size_t kstep = (size_t)(BK * 2);
    const size_t hstep = (size_t)HALF * K * 2;
    const size_t tstep = 2 * hstep;
    const unsigned ldsw = (unsigned)wid * 1024u;
    const int aoff = lds_byte(wr * 64 + fr, fq * 8), boff = lds_byte(wc * 32 + fr, fq * 8);
#define PG8_SA(b, h) (((b) * 2 + (h)) * HTB)
#define PG8_SB(b, h) ((4 + (b) * 2 + (h)) * HTB)
#define PG8_STAGE(bufoff, gbase, voff) do { _Pragma("unroll") for (int _i = 0; _i < 2; ++_i) \
        __builtin_amdgcn_global_load_lds((const unsigned*)((const char*)(gbase) + (voff)[_i]), (PG8_LAS unsigned*)(lds + (bufoff) + ldsw + _i * 8192), 16, 0, 0); } while (0)
#define PG8_LDA(dst, b, h) do { _Pragma("unroll") for (int m = 0; m < 4; ++m) _Pragma("unroll") for (int k = 0; k < 2; ++k) dst[m][k] = *(const PG8_LAS bf16x8*)(lds + PG8_SA(b, h) + aoff + m * 2048 + k * 1024); } while (0)
#define PG8_LDB(dst, b, h) do { _Pragma("unroll") for (int n = 0; n < 2; ++n) _Pragma("unroll") for (int k = 0; k < 2; ++k) dst[n][k] = *(const PG8_LAS bf16x8*)(lds + PG8_SB(b, h) + boff + n * 2048 + k * 1024); } while (0)
#define PG8_MMA(ai, bj, At, Bt) do { __builtin_amdgcn_s_setprio(1); _Pragma("unroll") for (int m = 0; m < 4; ++m) _Pragma("unroll") for (int n = 0; n < 2; ++n) _Pragma("unroll") for (int k = 0; k < 2; ++k) \
        acc[ai][bj][m][n] = __builtin_amdgcn_mfma_f32_16x16x32_bf16(Bt[n][k], At[m][k], acc[ai][bj][m][n], 0, 0, 0); __builtin_amdgcn_s_setprio(0); } while (0)
#define PG8_WAIT_V(n) asm volatile("s_waitcnt vmcnt(" #n ")" ::: "memory")
#define PG8_WAIT_L(n) asm volatile("s_waitcnt lgkmcnt(" #n ")" ::: "memory")
#define PG8_BAR __builtin_amdgcn_s_barrier()
#define PG8_SCHED __builtin_amdgcn_sched_barrier(0)
    Unit cur, nxt; int ui = 0;
    if (!S.next(0, cur)) return;
    f32x4 acc[2][2][4][2];
#pragma unroll
    for (int a = 0; a < 2; ++a)
#pragma unroll
        for (int b = 0; b < 2; ++b)
#pragma unroll
            for (int m = 0; m < 4; ++m)
#pragma unroll
                for (int n = 0; n < 2; ++n) acc[a][b][m][n] = (f32x4){0.f, 0.f, 0.f, 0.f};
    bf16x8 At[4][2], B0[2][2], B1[2][2];
    const char* cA = (const char*)g.A + (size_t)cur.pm * tstep; const char* cB = (const char*)g.Bt + (size_t)cur.pn * tstep;
    S.a_ready(cur);
    if constexpr (SP2) {
        PG8_STAGE(PG8_SB(0, 0), cB, voffB); PG8_STAGE(PG8_SB(0, 1), cB + hstep, voffB); PG8_STAGE(PG8_SA(0, 0), cA, voffA); PG8_STAGE(PG8_SA(0, 1), cA + hstep, voffA);
        if (wr == 1) PG8_BAR;
        PG8_WAIT_V(2); PG8_BAR;
        PG8_STAGE(PG8_SB(1, 0), cB + kstep, voffB); PG8_STAGE(PG8_SA(1, 0), cA + kstep, voffA); PG8_STAGE(PG8_SB(1, 1), cB + hstep + kstep, voffB);
        PG8_WAIT_V(6); PG8_BAR;
    } else {
        PG8_STAGE(PG8_SB(0, 0), cB, voffB); PG8_STAGE(PG8_SA(0, 0), cA, voffA); PG8_STAGE(PG8_SB(0, 1), cB + hstep, voffB); PG8_STAGE(PG8_SA(0, 1), cA + hstep, voffA);
        if (wr == 1) PG8_BAR;
        PG8_WAIT_V(4); PG8_BAR;
        PG8_STAGE(PG8_SB(1, 0), cB + kstep, voffB); PG8_STAGE(PG8_SA(1, 0), cA + kstep, voffA); PG8_STAGE(PG8_SB(1, 1), cB + hstep + kstep, voffB);
        PG8_WAIT_V(6); PG8_BAR;
    }
    for (;;) {
        const bool has_next = S.next(ui + 1, nxt);
        const char* nA = has_next ? (const char*)g.A + (size_t)nxt.pm * tstep : cA; const char* nB = has_next ? (const char*)g.Bt + (size_t)nxt.pn * tstep : cB;
        for (int t = 0; t < nt; t += 2) {
            const bool last = (t == nt - 2);
            const char* a1 = cA + (size_t)(t + 1) * kstep;
            const char* a2 = last ? nA : cA + (size_t)(t + 2) * kstep; const char* b2 = last ? nB : cB + (size_t)(t + 2) * kstep;
            const char* a3 = a2 + kstep; const char* b3 = b2 + kstep;
            if (last && has_next) S.a_ready(nxt);
            if constexpr (SP2) {
            PG8_LDB(B0, 0, 0); PG8_LDB(B1, 0, 1); PG8_SCHED; PG8_LDA(At, 0, 0); PG8_STAGE(PG8_SA(1, 1), a1 + hstep, voffA);
            PG8_WAIT_V(8); PG8_WAIT_L(0); PG8_BAR; PG8_MMA(0, 0, At, B0); PG8_MMA(0, 1, At, B1); PG8_BAR; PG8_SCHED;
            PG8_LDA(At, 0, 1); PG8_STAGE(PG8_SB(0, 0), b2, voffB); PG8_STAGE(PG8_SB(0, 1), b2 + hstep, voffB); PG8_STAGE(PG8_SA(0, 0), a2, voffA);
            PG8_WAIT_V(8); PG8_WAIT_L(0); PG8_BAR; PG8_MMA(1, 0, At, B0); PG8_MMA(1, 1, At, B1); PG8_BAR; PG8_SCHED;
            PG8_LDB(B0, 1, 0); PG8_LDB(B1, 1, 1); PG8_SCHED; PG8_LDA(At, 1, 0); PG8_STAGE(PG8_SA(0, 1), a2 + hstep, voffA);
            PG8_WAIT_V(8); PG8_WAIT_L(0); PG8_BAR; PG8_MMA(0, 0, At, B0); PG8_MMA(0, 1, At, B1); PG8_BAR; PG8_SCHED;
            PG8_LDA(At, 1, 1); PG8_STAGE(PG8_SB(1, 0), b3, voffB); PG8_STAGE(PG8_SB(1, 1), b3 + hstep, voffB); PG8_STAGE(PG8_SA(1, 0), a3, voffA);
            PG8_WAIT_V(8); PG8_WAIT_L(0); PG8_BAR; PG8_MMA(1, 0, At, B0); PG8_MMA(1, 1, At, B1); PG8_BAR; PG8_SCHED;
            } else {
            PG8_LDB(B0, 0, 0); PG8_SCHED; PG8_LDA(At, 0, 0); PG8_STAGE(PG8_SA(1, 1), a1 + hstep, voffA);
            PG8_WAIT_L(8); PG8_BAR; PG8_WAIT_L(0); PG8_MMA(0, 0, At, B0); PG8_BAR; PG8_SCHED;
            PG8_LDB(B1, 0, 1); PG8_STAGE(PG8_SB(0, 0), b2, voffB);
            PG8_BAR; PG8_WAIT_L(0); PG8_MMA(0, 1, At, B1); PG8_BAR;
            PG8_LDA(At, 0, 1); PG8_STAGE(PG8_SA(0, 0), a2, voffA);
            PG8_BAR; PG8_WAIT_L(0); PG8_MMA(1, 0, At, B0); PG8_BAR; PG8_SCHED;
            PG8_STAGE(PG8_SB(0, 1), b2 + hstep, voffB);
            PG8_WAIT_V(6); PG8_BAR; PG8_MMA(1, 1, At, B1); PG8_BAR;
            PG8_LDB(B0, 1, 0); PG8_SCHED; PG8_LDA(At, 1, 0); PG8_STAGE(PG8_SA(0, 1), a2 + hstep, voffA);
            PG8_WAIT_L(8); PG8_BAR; PG8_WAIT_L(0); PG8_MMA(0, 0, At, B0); PG8_BAR; PG8_SCHED;
            PG8_LDB(B1, 1, 1); PG8_STAGE(PG8_SB(1, 0), b3, voffB);
            PG8_BAR; PG8_WAIT_L(0); PG8_MMA(0, 1, At, B1); PG8_BAR;
            PG8_LDA(At, 1, 1); PG8_STAGE(PG8_SA(1, 0), a3, voffA);
            PG8_BAR; PG8_WAIT_L(0); PG8_MMA(1, 0, At, B0); PG8_BAR; PG8_SCHED;
            PG8_STAGE(PG8_SB(1, 1), b3 + hstep, voffB);
            PG8_WAIT_V(6); PG8_BAR; PG8_MMA(1, 1, At, B1); PG8_BAR;
            }
        }
        if constexpr (ALIGN_EPI) { if (wr == 0) PG8_BAR; }
        if constexpr (!Epi::AFTER_DRAIN) { E(acc, cur, wr, wc, fr, fq); S.done(cur); }
        if (!has_next) break;
#pragma unroll
        for (int a = 0; a < 2; ++a)
#pragma unroll
            for (int b = 0; b < 2; ++b)
#pragma unroll
                for (int m = 0; m < 4; ++m)
#pragma unroll
                    for (int n = 0; n < 2; ++n) acc[a][b][m][n] = (f32x4){0.f, 0.f, 0.f, 0.f};
        cur = nxt; cA = nA; cB = nB; ++ui;
        if constexpr (ALIGN_EPI) { if (wr == 1) PG8_BAR; }
    }
    PG8_WAIT_V(0);
    if constexpr (!ALIGN_EPI) { if (wr == 0) PG8_BAR; }
    PG8_BAR;
    if constexpr (Epi::AFTER_DRAIN) { E.fused(acc, cur, wr, wc, fr, fq, lds, wid, lane); S.done(cur); }
#undef PG8_SA
#undef PG8_SB
#undef PG8_STAGE
#undef PG8_LDA
#undef PG8_LDB
#undef PG8_MMA
#undef PG8_WAIT_V
#undef PG8_WAIT_L
#undef PG8_BAR
#undef PG8_SCHED
}
}
#include <hip/hip_bf16.h>
#include <cmath>
namespace attn_body {
using bf16=__hip_bfloat16;
using bf16x8=__attribute__((ext_vector_type(8)))short;
using s16x4=__attribute__((ext_vector_type(4)))short;
using f32x16=__attribute__((ext_vector_type(16)))float;
using u32x4=__attribute__((ext_vector_type(4)))unsigned;
constexpr int BATCH=8,NHEAD=8,SEQ=8192,D=64,QP=512,KP=128,OP=1024,GQ=4;
constexpr int NW=8,QBLK=32,QB=QBLK*NW,KVBLK=64,NQB=SEQ/QB;
constexpr int ATTN_UNIT_ROWS=QB;
__device__ __forceinline__ int crow(int r,int hi){return (r&3)+8*(r>>2)+4*hi;}
#define SBAR() __builtin_amdgcn_sched_barrier(0)
__device__ __forceinline__ void cmask(f32x16&p0,f32x16&p1,int jb,int qrel,int hi){
  const float NEG=-INFINITY; int kb=64*jb+4*hi;
  #pragma unroll
  for(int r=0;r<16;++r){int kv=kb+(r&3)+8*(r>>2); if(kv>qrel)p0[r]=NEG; if(kv+32>qrel)p1[r]=NEG;}
}

constexpr int NSLOT=3, SLOTB=8192;
constexpr int LDS_K=0, LDS_V=NSLOT*SLOTB, LDS_WS=2*NSLOT*SLOTB, LDS_OST=LDS_WS+NW*64*4, LDS_BYTES=LDS_OST+NW*4096;
constexpr float C2=0.125f*1.4426950408889634f;
__device__ __forceinline__ void glds16(const void*gsrc,unsigned lds_dst){unsigned keep;
  asm volatile("s_mov_b32 %0, m0\n\ts_mov_b32 m0, %2\n\ts_nop 0\n\tglobal_load_lds_dwordx4 %1, off\n\ts_mov_b32 m0, %0":"=&s"(keep):"v"(gsrc),"s"(lds_dst):"memory");}
__device__ __forceinline__ float max3f(float a,float b,float c){float r;asm("v_max3_f32 %0, %1, %2, %3":"=v"(r):"v"(a),"v"(b),"v"(c));return r;}
__device__ __forceinline__ float max2f(float a,float b){float r;asm("v_max_f32_e32 %0, %1, %2":"=v"(r):"v"(a),"v"(b));return r;}
__device__ __forceinline__ float fadd_s(float a,float b){float r;asm("v_add_f32_e32 %0, %1, %2":"=v"(r):"v"(a),"v"(b));return r;}
__device__ __forceinline__ float fsub_s(float a,float b){float r;asm("v_sub_f32_e32 %0, %1, %2":"=v"(r):"v"(a),"v"(b));return r;}
typedef float f32x2_t __attribute__((ext_vector_type(2))); typedef __bf16 bf16x2_t __attribute__((ext_vector_type(2)));
__device__ __forceinline__ unsigned cvtpk_s(float lo,float hi){f32x2_t v={lo,hi};bf16x2_t b=__builtin_convertvector(v,bf16x2_t);return __builtin_bit_cast(unsigned,b);}
#define WAIT_BAR(N) asm volatile("s_waitcnt vmcnt(" #N ") lgkmcnt(0)\n\ts_barrier":::"memory")

__device__ __forceinline__ void qkt(f32x16&p0,f32x16&p1,const char*Kslot,const bf16x8*qr,const f32x16&negm,int r32,int hi){
  const char*kb=Kslot+hi*1024+r32*16;
  #pragma unroll
  for(int d0=0;d0<4;++d0){
    const bf16x8 b0=*reinterpret_cast<const bf16x8*>(kb+d0*2048);
    const bf16x8 b1=*reinterpret_cast<const bf16x8*>(kb+d0*2048+512);
    if(d0==0){p0=__builtin_amdgcn_mfma_f32_32x32x16_bf16(b0,qr[0],negm,0,0,0);p1=__builtin_amdgcn_mfma_f32_32x32x16_bf16(b1,qr[0],negm,0,0,0);}
    else{p0=__builtin_amdgcn_mfma_f32_32x32x16_bf16(b0,qr[d0],p0,0,0,0);p1=__builtin_amdgcn_mfma_f32_32x32x16_bf16(b1,qr[d0],p1,0,0,0);}}
}
typedef __attribute__((address_space(3))) const char* lds_cptr;
typedef short v4i16_t __attribute__((ext_vector_type(4)));
__device__ __forceinline__ void kload8(bf16x8*kf,lds_cptr kp){
  kf[0]=*(const __attribute__((address_space(3))) bf16x8*)(kp);      kf[1]=*(const __attribute__((address_space(3))) bf16x8*)(kp+512);
  kf[2]=*(const __attribute__((address_space(3))) bf16x8*)(kp+2048); kf[3]=*(const __attribute__((address_space(3))) bf16x8*)(kp+2560);
  kf[4]=*(const __attribute__((address_space(3))) bf16x8*)(kp+4096); kf[5]=*(const __attribute__((address_space(3))) bf16x8*)(kp+4608);
  kf[6]=*(const __attribute__((address_space(3))) bf16x8*)(kp+6144); kf[7]=*(const __attribute__((address_space(3))) bf16x8*)(kp+6656);
}
__device__ __forceinline__ void kload2(bf16x8*kf,lds_cptr kp,int j){ kf[2*j]=*(const __attribute__((address_space(3))) bf16x8*)(kp+j*2048); kf[2*j+1]=*(const __attribute__((address_space(3))) bf16x8*)(kp+j*2048+512); }
__device__ __forceinline__ s16x4 vtr(lds_cptr p){ return __builtin_bit_cast(s16x4,__builtin_amdgcn_ds_read_tr16_b64_v4i16((__attribute__((address_space(3))) v4i16_t*)p)); }
__device__ __forceinline__ float rowmax(const f32x16&p0,const f32x16&p1){
  float a=max3f(p0[0],p0[1],p1[0]),b=max3f(p0[2],p0[3],p1[1]);a=max3f(a,p1[2],p1[3]);
  #pragma unroll
  for(int r=4;r<16;r+=4){a=max3f(a,p0[r],p0[r+1]);b=max3f(b,p0[r+2],p0[r+3]);a=max3f(a,p1[r],p1[r+1]);b=max3f(b,p1[r+2],p1[r+3]);}
  const float m=max2f(a,b);
  auto rr=__builtin_amdgcn_permlane32_swap(__float_as_uint(m),__float_as_uint(m),false,false);
  return max2f(__uint_as_float(rr[0]),__uint_as_float(rr[1]));
}
__device__ __forceinline__ void pv(f32x16*o,int vb,bf16x8 pa0,bf16x8 pa1,bf16x8 pa2,bf16x8 pa3){
  #pragma unroll
  for(int d0=0;d0<2;++d0){s16x4 lo[4],hi[4];
    #pragma unroll
    for(int ks=0;ks<4;++ks){
      asm volatile("ds_read_b64_tr_b16 %0,%1 offset:%c2":"=&v"(lo[ks]):"v"(vb),"i"(d0*4096+ks*1024):"memory");
      asm volatile("ds_read_b64_tr_b16 %0,%1 offset:%c2":"=&v"(hi[ks]):"v"(vb),"i"(d0*4096+ks*1024+512):"memory");}
    asm volatile("s_waitcnt lgkmcnt(0)":::"memory");SBAR();
    #define PK(k) (bf16x8){lo[k][0],lo[k][1],lo[k][2],lo[k][3],hi[k][0],hi[k][1],hi[k][2],hi[k][3]}
    o[d0]=__builtin_amdgcn_mfma_f32_32x32x16_bf16(pa0,PK(0),o[d0],0,0,0);
    o[d0]=__builtin_amdgcn_mfma_f32_32x32x16_bf16(pa1,PK(1),o[d0],0,0,0);
    o[d0]=__builtin_amdgcn_mfma_f32_32x32x16_bf16(pa2,PK(2),o[d0],0,0,0);
    o[d0]=__builtin_amdgcn_mfma_f32_32x32x16_bf16(pa3,PK(3),o[d0],0,0,0);
    #undef PK
  }
}

#ifndef ATTN_STORE16
#define ATTN_STORE16(p,v) (*(u32x4*)(p)=(v))
#endif
template<int THRL> __device__ __forceinline__ void attn_unit(int b,int h,int qb,const bf16*Q,const bf16*__restrict__ K,const bf16*__restrict__ V,bf16*O,char*shm){
  const int tid=threadIdx.x,lane=tid&63,r32=lane&31,hi=lane>>5; const int wid=__builtin_amdgcn_readfirstlane(tid>>6);
  const long rowbase=(long)b*SEQ; const int q0=qb*QB;
  const bf16*Qw=Q+(rowbase+q0+wid*QBLK)*QP+h*D;
  const bf16*Kh=K+rowbase*KP+(h/GQ)*D,*Vh=V+rowbase*KP+(h/GQ)*D;
  const unsigned lds0=(unsigned)(uintptr_t)shm;
  float*wsf=(float*)(shm+LDS_WS)+wid*64;
  const bf16*ksrc=Kh+(long)lane*KP+wid*8;
  const bf16*vsrc=Vh+(long)(16*(wid&3)+(lane>>2))*KP+(wid>>2)*32+(lane&3)*8;
  const unsigned kdst=lds0+LDS_K+wid*1024, vdst=lds0+LDS_V+wid*1024;
  #define DMA_K(t,slot) glds16(ksrc+(long)(t)*KVBLK*KP,(unsigned)__builtin_amdgcn_readfirstlane(kdst+(slot)))
  #define DMA_V(t,slot) glds16(vsrc+(long)(t)*KVBLK*KP,(unsigned)__builtin_amdgcn_readfirstlane(vdst+(slot)))
  const int vb0=(int)(lds0+LDS_V)+((lane>>4)&1)*32+(lane&3)*8+(4*hi+((lane&15)>>2))*64;
  const char*Kbase=shm+LDS_K; bf16x8 kf[8];
  const lds_cptr shm3=(lds_cptr)shm; const lds_cptr kp0=shm3+LDS_K+hi*1024+r32*16; const lds_cptr vp0=shm3+LDS_V+((lane>>4)&1)*32+(lane&3)*8+(4*hi+((lane&15)>>2))*64;
  const int NT=SEQ/KVBLK;
  DMA_K(0,0);DMA_V(0,0);DMA_K(1,SLOTB);
  bf16x8 qr[4];
  #pragma unroll
  for(int d0=0;d0<4;++d0)qr[d0]=*reinterpret_cast<const bf16x8*>(&Qw[(long)r32*QP+d0*16+hi*8]);
  float mhat=0.f,l_reg=0.f;f32x16 o[2];o[0]=f32x16{};o[1]=f32x16{};f32x16 negm=f32x16{};asm volatile("":"+v"(negm));
  const int qrel=wid*QBLK+r32;
  #define CMASK(P0,P1,t) do{}while(0)
  bool resc=false;
  #define START(P0,P1) do{ const float rm=rowmax(P0,P1); resc=false; \
    { const float dl=rm; mhat=fadd_s(mhat,dl); \
      _Pragma("unroll") for(int r=0;r<16;++r){P0[r]=fsub_s(P0[r],dl);P1[r]=fsub_s(P1[r],dl);} \
      _Pragma("unroll") for(int r=0;r<16;++r)negm[r]=-mhat; asm volatile("":"+v"(negm)); } \
    _Pragma("unroll") for(int r=0;r<16;++r)P0[r]=__builtin_amdgcn_exp2f(P0[r]); }while(0)
  #define RESC() do{ if(resc){ asm volatile("s_waitcnt lgkmcnt(0)":::"memory"); \
      _Pragma("unroll") for(int d_=0;d_<2;++d_) _Pragma("unroll") for(int r=0;r<16;++r)o[d_][r]*=wsf[crow(r,hi)]; } }while(0)
  f32x16 pA0,pA1,pB0,pB1;
  int sl_prev=0,sl_cur=0,sl_next=SLOTB;
  #define ROT() do{sl_prev=sl_cur;sl_cur=sl_next;sl_next=(sl_next==(NSLOT-1)*SLOTB)?0:sl_next+SLOTB;}while(0)
  DMA_K(2,2*SLOTB);
  WAIT_BAR(3);
  qkt(pA0,pA1,Kbase,qr,negm,r32,hi);asm volatile("s_nop 15\n\ts_nop 7":"+v"(pA0),"+v"(pA1));CMASK(pA0,pA1,0);
  START(pA0,pA1);
  _Pragma("unroll") for(int r=0;r<16;++r)pA1[r]=__builtin_amdgcn_exp2f(pA1[r]);
  WAIT_BAR(0);
  DMA_K(3,0);DMA_V(1,SLOTB);
  ROT();
  kload8(kf,kp0+sl_cur);
  WAIT_BAR(2);
  s16x4 vlo[8],vhi[8]; u32x4 pw0,pw1,pw2,pw3;
  #define PKW(P,B) cvtpk_s(P[B],P[B+1])
  #define PAF(k) __builtin_bit_cast(bf16x8,pw##k)
  #define VFR(i) (bf16x8){vlo[i][0],vlo[i][1],vlo[i][2],vlo[i][3],vhi[i][0],vhi[i][1],vhi[i][2],vhi[i][3]}
  #define PIN(x) asm volatile("":"+v"(x))
  #define MX3(a,b,c) __builtin_fmaxf(__builtin_fmaxf((a),(b)),(c))
  #define GAPA(MF,A0,A1,A2,A3,W0,W1,PW) do{ MF; sacc+=A0; sacc+=A1; sacc+=A2; sacc+=A3; PIN(sacc); W0; W1; PIN(PW); SBAR(); }while(0)
  #define EX(v) __builtin_amdgcn_exp2f(v)
  #define GAPB(MF,X,B) do{ MF; X[B]=EX(X[B]); X[B+1]=EX(X[B+1]); X[B+2]=EX(X[B+2]); X[B+3]=EX(X[B+3]); PIN(X); SBAR(); }while(0)
  #define VRD(i) do{ vlo[i]=vtr(vp_+(((i)>>2)*4096+((i)&3)*1024)); vhi[i]=vtr(vp_+(((i)>>2)*4096+((i)&3)*1024+512)); }while(0)
  #define KRD(G,j) do{ if(G){ kload2(kf,kp0+sl_next,j); SBAR(); } }while(0)
  #define STEP(C0,C1,P0,P1,t,GK,GV,GL) do{ SBAR(); \
    const lds_cptr vp_=vp0+sl_prev; \
    VRD(0); SBAR(); float sacc=(P0[0]+P0[1]); \
    GAPA(C0=__builtin_amdgcn_mfma_f32_32x32x16_bf16(kf[0],qr[0],negm,0,0,0), P0[2],P0[3],P0[4],P0[5],     pw0[0]=PKW(P0,0), pw0[1]=PKW(P0,2), pw0); \
    VRD(4); SBAR(); GAPA(C1=__builtin_amdgcn_mfma_f32_32x32x16_bf16(kf[1],qr[0],negm,0,0,0), P0[6],P0[7],P0[8],P0[9],     pw0[2]=PKW(P0,4), pw0[3]=PKW(P0,6), pw0); \
    VRD(1); SBAR(); GAPA(C0=__builtin_amdgcn_mfma_f32_32x32x16_bf16(kf[2],qr[1],C0,0,0,0),   P0[10],P0[11],P0[12],P0[13], pw1[0]=PKW(P0,8), pw1[1]=PKW(P0,10), pw1); \
    VRD(5); SBAR(); GAPA(C1=__builtin_amdgcn_mfma_f32_32x32x16_bf16(kf[3],qr[1],C1,0,0,0),   P0[14],P0[15],P1[0],P1[1],   pw1[2]=PKW(P0,12),pw1[3]=PKW(P0,14), pw1); \
    VRD(2); SBAR(); GAPA(C0=__builtin_amdgcn_mfma_f32_32x32x16_bf16(kf[4],qr[2],C0,0,0,0),   P1[2],P1[3],P1[4],P1[5],     pw2[0]=PKW(P1,0), pw2[1]=PKW(P1,2), pw2); \
    VRD(6); SBAR(); GAPA(C1=__builtin_amdgcn_mfma_f32_32x32x16_bf16(kf[5],qr[2],C1,0,0,0),   P1[6],P1[7],P1[8],P1[9],     pw2[2]=PKW(P1,4), pw2[3]=PKW(P1,6), pw2); \
    VRD(3); SBAR(); GAPA(C0=__builtin_amdgcn_mfma_f32_32x32x16_bf16(kf[6],qr[3],C0,0,0,0),   P1[10],P1[11],P1[12],P1[13], pw3[0]=PKW(P1,8), pw3[1]=PKW(P1,10), pw3); \
    VRD(7); SBAR(); GAPA(C1=__builtin_amdgcn_mfma_f32_32x32x16_bf16(kf[7],qr[3],C1,0,0,0),   P1[14],P1[15],0.f,0.f,       pw3[2]=PKW(P1,12),pw3[3]=PKW(P1,14), pw3); \
    l_reg+=sacc; \
    if(GK){DMA_K((t)+3,sl_cur);} if(GV){DMA_V((t)+1,sl_next);} \
    CMASK(C0,C1,t); \
    { float a=MX3(C0[0],C0[1],C1[0]),b=MX3(C0[2],C0[3],C1[1]); a=MX3(a,C1[2],C1[3]); \
      _Pragma("unroll") for(int r=4;r<16;r+=4){a=MX3(a,C0[r],C0[r+1]);b=MX3(b,C0[r+2],C0[r+3]);a=MX3(a,C1[r],C1[r+1]);b=MX3(b,C1[r+2],C1[r+3]);} \
      float rm=__builtin_fmaxf(a,b); { auto rr=__builtin_amdgcn_permlane32_swap(__float_as_uint(rm),__float_as_uint(rm),false,false); rm=__builtin_fmaxf(__uint_as_float(rr[0]),__uint_as_float(rr[1])); } \
      resc=false; \
      if(__builtin_expect(__any(rm>(float)THRL),0)){ const float dl=__builtin_fmaxf(rm,0.f); mhat+=dl; \
        _Pragma("unroll") for(int r=0;r<16;++r){C0[r]-=dl;C1[r]-=dl;} \
        _Pragma("unroll") for(int r=0;r<16;++r)negm[r]=-mhat; asm volatile("":"+v"(negm)); \
        const float f=__builtin_amdgcn_exp2f(-dl); l_reg*=f; if(hi==0)wsf[r32]=f; resc=true; } } \
    SBAR(); \
    GAPB(o[0]=__builtin_amdgcn_mfma_f32_32x32x16_bf16(PAF(0),VFR(0),o[0],0,0,0), C0,0); \
    GAPB(o[1]=__builtin_amdgcn_mfma_f32_32x32x16_bf16(PAF(0),VFR(4),o[1],0,0,0), C0,4); \
    KRD(GL,0); GAPB(o[0]=__builtin_amdgcn_mfma_f32_32x32x16_bf16(PAF(1),VFR(1),o[0],0,0,0), C0,8); \
    KRD(GL,1); GAPB(o[1]=__builtin_amdgcn_mfma_f32_32x32x16_bf16(PAF(1),VFR(5),o[1],0,0,0), C0,12); \
    KRD(GL,2); GAPB(o[0]=__builtin_amdgcn_mfma_f32_32x32x16_bf16(PAF(2),VFR(2),o[0],0,0,0), C1,0); \
    KRD(GL,3); GAPB(o[1]=__builtin_amdgcn_mfma_f32_32x32x16_bf16(PAF(2),VFR(6),o[1],0,0,0), C1,4); \
    GAPB(o[0]=__builtin_amdgcn_mfma_f32_32x32x16_bf16(PAF(3),VFR(3),o[0],0,0,0), C1,8); \
    GAPB(o[1]=__builtin_amdgcn_mfma_f32_32x32x16_bf16(PAF(3),VFR(7),o[1],0,0,0), C1,12); \
    }while(0)
  int t=1;
  #undef CMASK
  #define CMASK(P0,P1,t) do{}while(0)
  for(;t+5<NT;t+=2){
    STEP(pB0,pB1,pA0,pA1,t,true,true,true);     WAIT_BAR(2); RESC(); ROT();
    STEP(pA0,pA1,pB0,pB1,t+1,true,true,true);   WAIT_BAR(2); RESC(); ROT();
  }
  #undef CMASK
  #define CMASK(P0,P1,t) do{}while(0)
  #define ENDW(tt) do{ if((tt)+3<NT){WAIT_BAR(2);} else if((tt)+2<NT){WAIT_BAR(1);} else {WAIT_BAR(0);} }while(0)
  for(;t+1<NT;t+=2){
    STEP(pB0,pB1,pA0,pA1,t,(t+3<NT),(t+1<NT),(t+1<NT));       ENDW(t);   RESC(); ROT();
    STEP(pA0,pA1,pB0,pB1,t+1,(t+4<NT),(t+2<NT),(t+2<NT));     ENDW(t+1); RESC(); ROT();
  }
  STEP(pB0,pB1,pA0,pA1,NT-1,false,false,false); RESC();
  { float sacc=pB0[0]+pB0[1]; _Pragma("unroll") for(int r=2;r<16;++r)sacc+=pB0[r]; _Pragma("unroll") for(int r=0;r<16;++r)sacc+=pB1[r]; l_reg+=sacc;
    pw0=(u32x4){PKW(pB0,0),PKW(pB0,2),PKW(pB0,4),PKW(pB0,6)};pw1=(u32x4){PKW(pB0,8),PKW(pB0,10),PKW(pB0,12),PKW(pB0,14)};pw2=(u32x4){PKW(pB1,0),PKW(pB1,2),PKW(pB1,4),PKW(pB1,6)};pw3=(u32x4){PKW(pB1,8),PKW(pB1,10),PKW(pB1,12),PKW(pB1,14)};
    SBAR(); pv(o,vb0+sl_cur,PAF(0),PAF(1),PAF(2),PAF(3)); }
  #undef PKW
  #undef PAF
  #undef VFR
  #undef PIN
  #undef MX3
  #undef GAPA
  #undef GAPB
  #undef EX
  #undef VRD
  #undef KRD
  #undef STEP
  #undef ENDW
  {auto rr=__builtin_amdgcn_permlane32_swap(__float_as_uint(l_reg),__float_as_uint(l_reg),false,false);l_reg=__uint_as_float(rr[0])+__uint_as_float(rr[1]);}
  if(hi==0)wsf[32+r32]=l_reg;asm volatile("s_waitcnt lgkmcnt(0)":::"memory");
  float rli[16];
  #pragma unroll
  for(int r=0;r<16;++r)rli[r]=__builtin_amdgcn_rcpf(wsf[32+crow(r,hi)]);
  bf16*Ow=O+(rowbase+q0+wid*QBLK)*OP+h*D;
  { bf16*stg=(bf16*)(shm+LDS_OST)+wid*2048;
    #pragma unroll
    for(int r=0;r<16;++r){const int orow=crow(r,hi);
      #pragma unroll
      for(int d0=0;d0<2;++d0)stg[orow*64+d0*32+r32]=__float2bfloat16(o[d0][r]*rli[r]);}
    asm volatile("s_waitcnt lgkmcnt(0)":::"memory");
    #pragma unroll
    for(int i=0;i<4;++i){const int row=i*8+(lane>>3),ch=lane&7; const u32x4 v=*(const u32x4*)(stg+row*64+ch*8); ATTN_STORE16(Ow+(long)row*OP+ch*8,v);} }
  asm volatile("s_waitcnt lgkmcnt(0)\n\ts_barrier":::"memory");
  #undef DMA_K
  #undef DMA_V
  #undef CMASK
  #undef START
  #undef RESC
  #undef ROT
}
constexpr int ATTN_LDS_BYTES=LDS_BYTES;
struct AttnTensors { const bf16* Q; const bf16* K; const bf16* V; bf16* O; };
struct AttnUnit { int bh; int qb; };
struct StaticOrder {
  int vcu,G;
  __device__ __forceinline__ explicit StaticOrder(int grid,int block):vcu((grid%8==0)?(block%8)*(grid/8)+block/8:block),G(grid){}
  __device__ __forceinline__ bool next(int i,AttnUnit&u)const{ const int U=vcu+G*i; if(U>=BATCH*NHEAD*NQB)return false; u.bh=U/NQB; u.qb=U%NQB; return true; }
  __device__ __forceinline__ void a_ready(const AttnUnit&)const{}
  __device__ __forceinline__ void done(const AttnUnit&)const{}
};
template<class Sched,int THRL=8> __device__ __forceinline__ void attn_phase(char*lds,const AttnTensors&T,const Sched&S){
  AttnUnit u;
  for(int i=0;S.next(i,u);++i){ S.a_ready(u); attn_unit<THRL>(u.bh/NHEAD,u.bh%NHEAD,u.qb,T.Q,T.K,T.V,T.O,lds); S.done(u); }
}
#undef SBAR
#undef WAIT_BAR
}
namespace cg = cooperative_groups;
#define LAS __attribute__((address_space(3)))
typedef unsigned short bf16;
typedef float f32x4 __attribute__((ext_vector_type(4)));
typedef float f32x16 __attribute__((ext_vector_type(16)));
typedef short bf16x8 __attribute__((ext_vector_type(8)));
typedef short s16x4 __attribute__((ext_vector_type(4)));
typedef unsigned v4u __attribute__((ext_vector_type(4)));
typedef unsigned v2u __attribute__((ext_vector_type(2)));

constexpr int NB = 8, SEQ = 8192, DM = 1024, M = NB * SEQ, NPROJ = 2816, NPAD = 3072, FF = 2816, NWAVES = 8;
constexpr float EPS = 1e-6f;
constexpr size_t MiB = 1u << 20;
constexpr size_t WS_SS = 0;
constexpr size_t WS_BA = 1 * MiB;
constexpr size_t WS_EG = 5 * MiB;
constexpr size_t WS_WIN = 10 * MiB, WS_WOUT = 16 * MiB, WS_WGU = 18 * MiB, WS_WDN = 30 * MiB, WS_WPG = 36 * MiB, WS_WPL = 38 * MiB;
constexpr size_t WS_PB = 48 * MiB;
constexpr size_t WS_B = 80 * MiB;
constexpr size_t WS_C = 208 * MiB;
constexpr size_t WS_W = WS_C, WS_UT = WS_C + 128 * MiB, WS_QKM = WS_C + 256 * MiB;
constexpr size_t WS_D = 560 * MiB;
constexpr size_t WS_QA = WS_D, WS_KA = WS_D + 64 * MiB, WS_VA = WS_D + 80 * MiB, WS_DQ = WS_D + 96 * MiB, WS_DK = WS_D + 160 * MiB, WS_KT = WS_D + 224 * MiB, WS_VT = WS_D + 288 * MiB, WS_Z = WS_D + 352 * MiB;
constexpr size_t WS_OF = WS_QA, WS_OB = WS_DK, WS_HB1 = WS_D;
constexpr size_t WS_END = 1024 * MiB;
static_assert(WS_Z + 64 * MiB <= WS_END, "ws map");
constexpr int LDS_BYTES = 147456;
constexpr int SAP = 68;

struct Args { const float* in[19]; float* out; unsigned char* ws; int ph_lo, ph_hi; };

struct Frame {
    LAS unsigned char* lds; int tid, lane, wave, vcu, G;
    const float *x, *p, *norm_mix, *w_in, *conv_w, *q_norm, *k_norm, *a_log, *dt_bias, *dn_norm, *w_out, *norm_ffn, *w_gate, *w_up, *w_down, *norm_ple, *w_ple_gate, *w_ple, *norm_final;
    float* out; float *SS, *BA, *EG;
    bf16 *Wt_in, *Wt_out, *Wt_gu, *Wt_dn, *Wt_pg, *Wt_pl, *PB, *XN, *MIXED, *HB2, *PROJ, *W, *UT, *QKM, *ACT, *PE, *QA, *KA, *VA, *DQ, *DK, *KT, *VT, *Z, *OF, *OB, *HB1;
};
#define LDS_FENCE() asm volatile("s_waitcnt lgkmcnt(0)" ::: "memory")
__device__ __forceinline__ unsigned pk2(float lo, float hi) { return attn_body::cvtpk_s(lo, hi); }
__device__ __forceinline__ float bflo(unsigned w) { return __uint_as_float(w << 16); }
__device__ __forceinline__ float bfhi(unsigned w) { return __uint_as_float(w & 0xffff0000u); }
__device__ __forceinline__ float bf2f(short s) { return __uint_as_float(((unsigned)(unsigned short)s) << 16); }
__device__ __forceinline__ bf16 f2bf(float f) { return (bf16)(pk2(f, 0.f) & 0xffffu); }
__device__ __forceinline__ float wave_sum(float v) {
#pragma unroll
    for (int o = 1; o < 64; o <<= 1) v += __shfl_xor(v, o);
    return v;
}
__device__ __forceinline__ int crow(int r, int hi) { return (r & 3) + 8 * (r >> 2) + 4 * hi; }
__device__ __forceinline__ float fast_sig(float v) { return __builtin_amdgcn_rcpf(1.f + __expf(-v)); }
#define MFMA32(a, b, c) __builtin_amdgcn_mfma_f32_32x32x16_bf16((a), (b), (c), 0, 0, 0)

__device__ __forceinline__ void p0_transpose_item(const float* W, int ldw, int K, int ncols, int nvalid, bf16* WT, int rb, int rstride, int roff, const float* gain, LAS float* scr, int item, int lane) {
    const int nblk = ncols / 32, kb = item / nblk, nb = item % nblk, k0 = 64 * kb, n0 = 32 * nb;
#pragma unroll 8
    for (int i = 0; i < 32; ++i) { const int kk = 2 * i + (lane >> 5), n = n0 + (lane & 31);
        float v = (n < nvalid) ? W[(size_t)(k0 + kk) * ldw + n] : 0.f; if (gain) v *= gain[k0 + kk]; scr[kk * 33 + (lane & 31)] = v; }
    LDS_FENCE();
    const int c = lane & 7;
#pragma unroll
    for (int j = 0; j < 4; ++j) { const int nl = (lane >> 3) + 8 * j, n = n0 + nl; const LAS float* s = scr + (8 * c) * 33 + nl;
        v4u o; o.x = pk2(s[0 * 33], s[1 * 33]); o.y = pk2(s[2 * 33], s[3 * 33]); o.z = pk2(s[4 * 33], s[5 * 33]); o.w = pk2(s[6 * 33], s[7 * 33]);
        const int drow = (n / rb) * rstride + roff + (n % rb);
        *(v4u*)(WT + (size_t)drow * K + k0 + 8 * c) = o; }
    LDS_FENCE();
}
__device__ __forceinline__ void p0_prologue(Frame& F) {
    LAS float* scr = (LAS float*)(F.lds + F.wave * 16384);
    const int gw = F.vcu * NWAVES + F.wave, NGW = F.G * NWAVES;
    constexpr int I_IN = 16 * (NPAD / 32), I_OUT = 16 * 32, I_G = 16 * (FF / 32), I_DN = (FF / 64) * 32, I_PG = 16 * 32, I_PL = 4 * 32;
    constexpr int NITEMS = I_IN + I_OUT + 2 * I_G + I_DN + I_PG + I_PL;
    constexpr int BIG = 1 << 30;
    for (int it = gw; it < NITEMS; it += NGW) {
        int r = it;
        if (r < I_IN) { p0_transpose_item(F.w_in, 2832, 1024, NPAD, 2832, F.Wt_in, BIG, 0, 0, nullptr, scr, r, F.lane); continue; } r -= I_IN;
        if (r < I_OUT) { p0_transpose_item(F.w_out, 1024, 1024, 1024, 1024, F.Wt_out, BIG, 0, 0, nullptr, scr, r, F.lane); continue; } r -= I_OUT;
        if (r < I_G) { p0_transpose_item(F.w_gate, FF, 1024, FF, FF, F.Wt_gu, 128, 256, 0, F.norm_ffn, scr, r, F.lane); continue; } r -= I_G;
        if (r < I_G) { p0_transpose_item(F.w_up, FF, 1024, FF, FF, F.Wt_gu, 128, 256, 128, F.norm_ffn, scr, r, F.lane); continue; } r -= I_G;
        if (r < I_DN) { p0_transpose_item(F.w_down, 1024, FF, 1024, 1024, F.Wt_dn, BIG, 0, 0, nullptr, scr, r, F.lane); continue; } r -= I_DN;
        if (r < I_PG) { p0_transpose_item(F.w_ple_gate, 1024, 1024, 1024, 1024, F.Wt_pg, BIG, 0, 0, F.norm_ple, scr, r, F.lane); continue; } r -= I_PG;
        p0_transpose_item(F.w_ple, 1024, 256, 1024, 1024, F.Wt_pl, BIG, 0, 0, nullptr, scr, r, F.lane);
    }
    f32x4 gn[4];
#pragma unroll
    for (int j = 0; j < 4; ++j) gn[j] = ((const f32x4*)F.norm_mix)[F.lane + 64 * j];
    for (int m = gw; m < M; m += NGW) {
        const f32x4* xr = (const f32x4*)(F.x + (size_t)m * DM) + F.lane; f32x4 v[4]; float s = 0.f;
#pragma unroll
        for (int j = 0; j < 4; ++j) { v[j] = xr[64 * j]; s += (v[j].x * v[j].x + v[j].y * v[j].y) + (v[j].z * v[j].z + v[j].w * v[j].w); }
        const float rstd = rsqrtf(wave_sum(s) * (1.f / DM) + EPS);
        v2u* o8 = (v2u*)(F.XN + (size_t)m * DM) + F.lane;
#pragma unroll
        for (int j = 0; j < 4; ++j) { const f32x4 y = v[j] * rstd * gn[j]; v2u w; w.x = pk2(y.x, y.y); w.y = pk2(y.z, y.w); o8[64 * j] = w; }
    }
    const size_t gt = (size_t)F.vcu * 512 + F.tid, NGT = (size_t)F.G * 512;
    for (size_t i = gt; i < (size_t)M * 256 / 4; i += NGT) { const f32x4 v = ((const f32x4*)F.p)[i]; v2u w; w.x = pk2(v.x, v.y); w.y = pk2(v.z, v.w); ((v2u*)F.PB)[i] = w; }
    for (size_t i = gt; i < (size_t)3 * M; i += NGT) F.SS[i] = 0.f;
}

__device__ __forceinline__ void p2_attn_rows(Frame& F) {
    const int gw = F.vcu * NWAVES + F.wave, NGW = F.G * NWAVES, lane = F.lane;
    constexpr float C2 = 0.125f * 1.4426950408889634f;
    for (int m = gw; m < M; m += NGW) {
        const bf16* pr = F.PROJ + (size_t)m * NPROJ; const int s = m & (SEQ - 1); const float frow = (float)(s >> 6), fcol = (float)(s & 63);
#pragma unroll
        for (int it = 0; it < 3; ++it) { const int idx = it * 64 + lane, head = idx >> 4, j = idx & 15;
            if (head < 10) {
                const bf16* hp = pr + head * 64;
                float x0 = bf2f(hp[j]), x1 = bf2f(hp[j + 16]), x2 = bf2f(hp[32 + j]), x3 = bf2f(hp[48 + j]);
                float ss = (x0 * x0 + x1 * x1) + (x2 * x2 + x3 * x3);
                ss += __shfl_xor(ss, 1); ss += __shfl_xor(ss, 2); ss += __shfl_xor(ss, 4); ss += __shfl_xor(ss, 8);
                const float rs = rsqrtf(ss * (1.f / 64.f) + EPS); const float* gp = head < 8 ? F.q_norm : F.k_norm;
                x0 *= rs * gp[j]; x1 *= rs * gp[j + 16]; x2 *= rs * gp[32 + j]; x3 *= rs * gp[48 + j];
                const float inv = powf(10000.0f, -(float)j * (1.f / 16.f));
                float sr, cr, sc, cc; sincosf(frow * inv, &sr, &cr); sincosf(fcol * inv, &sc, &cc);
                float o0 = x0 * cr - x1 * sr, o1 = x1 * cr + x0 * sr, o2 = x2 * cc - x3 * sc, o3 = x3 * cc + x2 * sc;
                bf16* op;
                if (head < 8) { o0 *= C2; o1 *= C2; o2 *= C2; o3 *= C2; op = F.QA + (size_t)m * 512 + head * 64; } else op = F.KA + (size_t)m * 128 + (head - 8) * 64;
                op[j] = f2bf(o0); op[j + 16] = f2bf(o1); op[32 + j] = f2bf(o2); op[48 + j] = f2bf(o3);
            } }
        ((unsigned*)(F.VA + (size_t)m * 128))[lane] = ((const unsigned*)(pr + 640))[lane];
        ((v4u*)(F.Z + (size_t)m * 512))[lane] = ((const v4u*)(pr + 2304))[lane];
    }
}
__device__ __forceinline__ void p2_dn_conv(Frame& F) {
    LAS bf16* tl = (LAS bf16*)F.lds;
    const int lane = F.lane, wid = F.wave;
    for (int item = F.vcu; item < NB * 128 * 12; item += F.G) {
        const int type = item % 3, h4 = (item / 3) & 3, n = (item / 12) & 127, b = item / (12 * 128);
        const int ch = type * 512 + h4 * 128 + 2 * lane;
        float w0[5], w1[5];
#pragma unroll
        for (int j = 0; j < 5; ++j) { w0[j] = F.conv_w[j * 1536 + ch]; w1[j] = F.conv_w[j * 1536 + ch + 1]; }
        const bf16* src = F.PROJ + (size_t)b * SEQ * NPROJ + 768 + ch;
#pragma unroll 2
        for (int i = 0; i < 8; ++i) { const int tl_ = 8 * wid + i, s = n * 64 + tl_; float a0 = 0.f, a1 = 0.f;
#pragma unroll
            for (int j = 0; j < 5; ++j) { const int sj = s + j - 2; if (sj >= 0 && sj < SEQ) { const unsigned w = *(const unsigned*)(src + (size_t)sj * NPROJ); a0 += w0[j] * bflo(w); a1 += w1[j] * bfhi(w); } }
            a0 = a0 * fast_sig(a0); a1 = a1 * fast_sig(a1);
            if (type < 2) { const float ss = wave_sum(a0 * a0 + a1 * a1); float rs = rsqrtf(ss + EPS); if (type == 0) rs *= 0.08838834764831845f; a0 *= rs; a1 *= rs; }
            const size_t row = (size_t)b * SEQ + s;
            if (type == 0) *(unsigned*)(F.DQ + row * 512 + h4 * 128 + 2 * lane) = pk2(a0, a1);
            else { if (type == 1) *(unsigned*)(F.DK + row * 512 + h4 * 128 + 2 * lane) = pk2(a0, a1);
                   tl[(2 * lane) * 66 + tl_] = f2bf(a0); tl[(2 * lane + 1) * 66 + tl_] = f2bf(a1); }
        }
        if (type != 0) {
            LDS_FENCE(); __syncthreads();
            bf16* dst = (type == 1 ? F.KT : F.VT) + ((size_t)(b * 4 + h4) * 128 + n) * 8192;
            const int d = F.tid >> 2, c = F.tid & 3; const LAS unsigned* sp = (const LAS unsigned*)(tl + d * 66 + 16 * c);
            v4u o0, o1; o0.x = sp[0]; o0.y = sp[1]; o0.z = sp[2]; o0.w = sp[3]; o1.x = sp[4]; o1.y = sp[5]; o1.z = sp[6]; o1.w = sp[7];
            *(v4u*)(dst + d * 64 + 16 * c) = o0; *(v4u*)(dst + d * 64 + 16 * c + 8) = o1;
            LDS_FENCE(); __syncthreads();
        }
    }
}
__device__ __forceinline__ bf16x8 ld8(const bf16* p) { return *(const bf16x8*)p; }
__device__ __forceinline__ bf16x8 ld44(const bf16* p) { const s16x4 a = *(const s16x4*)p, b = *(const s16x4*)(p + 8); return (bf16x8){a[0], a[1], a[2], a[3], b[0], b[1], b[2], b[3]}; }
__device__ __forceinline__ bf16x8 pack8(float a0, float a1, float a2, float a3, float a4, float a5, float a6, float a7) {
    v4u w; w.x = pk2(a0, a1); w.y = pk2(a2, a3); w.z = pk2(a4, a5); w.w = pk2(a6, a7); return __builtin_bit_cast(bf16x8, w); }
__device__ __forceinline__ void dn_prep_item(Frame& F, int item, LAS float* SA, LAS float* sv, int lane) {
    const int n = item & 127, h8 = (item >> 7) & 7, b = item >> 10, dir = h8 >> 2, h4 = h8 & 3;
    const size_t tok0 = (size_t)b * SEQ + n * 64; const int r32 = lane & 31, hi = lane >> 5;
    { const float* ba = F.BA + (tok0 + lane) * 16; const float braw = ba[h8], araw = ba[8 + h8];
      const float beta = 1.f / (1.f + __expf(-braw)); const float xx = araw + F.dt_bias[h8];
      const float sp = fmaxf(xx, 0.f) + log1pf(__expf(-fabsf(xx))); const float g = -__expf(F.a_log[h8]) * sp;
      float gc = dir ? __shfl(g, 63 - lane) : g;
#pragma unroll
      for (int o = 1; o < 64; o <<= 1) { const float t = __shfl_up(gc, o); if (lane >= o) gc += t; }
      const float Gtot = __shfl(gc, 63); const float G = dir ? __shfl(gc, 63 - lane) : gc; const float eg = __expf(G);
      sv[lane] = G; sv[64 + lane] = beta; sv[128 + lane] = beta * eg;
      F.EG[(size_t)item * 128 + lane] = eg; F.EG[(size_t)item * 128 + 64 + lane] = __expf(Gtot - G); }
    LDS_FENCE();
#ifndef PREP_NO_GRAM
    const bf16* Kp = F.DK + tok0 * 512 + h4 * 128; const bf16* Qp = F.DQ + tok0 * 512 + h4 * 128;
#pragma unroll 1
    for (int tt = 0; tt < 4; ++tt) { const int ti = tt >> 1, tj = tt & 1; f32x16 acc = {}, acq = {};
        const bf16* ka = Kp + (size_t)(32 * ti + r32) * 512 + 8 * hi; const bf16* kb_ = Kp + (size_t)(32 * tj + r32) * 512 + 8 * hi; const bf16* qa = Qp + (size_t)(32 * ti + r32) * 512 + 8 * hi;
#pragma unroll
        for (int kb = 0; kb < 8; ++kb) { const bf16x8 fb = ld8(kb_ + 16 * kb); acc = MFMA32(ld8(ka + 16 * kb), fb, acc); acq = MFMA32(ld8(qa + 16 * kb), fb, acq); }
        const int j = 32 * tj + r32, cj = dir ? 63 - j : j; const float Gj = sv[j];
#pragma unroll
        for (int r = 0; r < 16; ++r) { const int i = 32 * ti + crow(r, hi), ci = dir ? 63 - i : i; const float Gi = sv[i], bi = sv[64 + i]; const float dec = __expf(fminf(Gi - Gj, 0.f));
            SA[ci * SAP + cj] = (ci > cj) ? bi * acc[r] * dec : 0.f;
            F.QKM[(size_t)item * 4096 + i * 64 + j] = f2bf((ci >= cj) ? acq[r] * dec : 0.f); }
        asm volatile("" ::: "memory"); }
#endif
    LDS_FENCE();
#ifndef PREP_NO_SOLVE
    SA[lane] = (lane == 0) ? 1.f : 0.f; LDS_FENCE();
    for (int i = 1; i < 64; ++i) { float a = (lane == i) ? 1.f : 0.f; const int nq = (i + 3) >> 2;
        for (int jq = 0; jq < nq; ++jq) { const f32x4 a4 = *(const LAS f32x4*)(SA + i * SAP + 4 * jq); const LAS float* tp = SA + (4 * jq) * SAP + lane;
            a -= a4.x * tp[0]; a -= a4.y * tp[SAP]; a -= a4.z * tp[2 * SAP]; a -= a4.w * tp[3 * SAP]; }
        LDS_FENCE();
        SA[i * SAP + lane] = a;
        LDS_FENCE(); }
#endif
#ifndef PREP_NO_UW
    const bf16* VTp = F.VT + ((size_t)(b * 4 + h4) * 128 + n) * 8192; const bf16* KTp = F.KT + ((size_t)(b * 4 + h4) * 128 + n) * 8192;
#pragma unroll 1
    for (int pass = 0; pass < 2; ++pass) {
        bf16x8 tb[2][4];
#pragma unroll
        for (int ti = 0; ti < 2; ++ti) { const int i = 32 * ti + r32, ci = dir ? 63 - i : i;
#pragma unroll
            for (int kb = 0; kb < 4; ++kb) { float a[8];
#pragma unroll
                for (int e = 0; e < 8; ++e) { const int j = 16 * kb + 8 * hi + e, cj = dir ? 63 - j : j; a[e] = SA[ci * SAP + cj] * sv[64 + 64 * pass + j]; }
                tb[ti][kb] = pack8(a[0], a[1], a[2], a[3], a[4], a[5], a[6], a[7]); asm volatile("" ::: "memory"); } }
        const bf16* src = (pass ? KTp : VTp) + r32 * 64 + 8 * hi;
#pragma unroll 1
        for (int td = 0; td < 4; ++td) { f32x16 a0 = {}, a1 = {};
            if (pass == 0) {
#pragma unroll
                for (int kb = 0; kb < 4; ++kb) { const bf16x8 vf = ld8(src + td * 2048 + 16 * kb); a0 = MFMA32(vf, tb[0][kb], a0); a1 = MFMA32(vf, tb[1][kb], a1); }
                bf16* up = F.UT + (size_t)item * 8192 + (32 * td + 4 * hi) * 64 + r32;
#pragma unroll
                for (int r = 0; r < 16; ++r) { const int dv = (r & 3) + 8 * (r >> 2); up[dv * 64] = f2bf(a0[r]); up[dv * 64 + 32] = f2bf(a1[r]); }
            } else {
#pragma unroll
                for (int kb = 0; kb < 4; ++kb) { const bf16x8 kt = ld8(src + td * 2048 + 16 * kb); a0 = MFMA32(tb[0][kb], kt, a0); a1 = MFMA32(tb[1][kb], kt, a1); }
                bf16* wp = F.W + (size_t)item * 8192 + (4 * hi) * 128 + 32 * td + r32;
#pragma unroll
                for (int r = 0; r < 16; ++r) { const int i = (r & 3) + 8 * (r >> 2); wp[i * 128] = f2bf(a0[r]); wp[(32 + i) * 128] = f2bf(a1[r]); }
            }
            asm volatile("" ::: "memory"); }
    }
#endif
    LDS_FENCE();
}
__device__ __forceinline__ void dn_scan_item(Frame& F, int item, int lane) {
    const int sl = item & 3, bh8 = item >> 2, h8 = bh8 & 7, b = bh8 >> 3, dir = h8 >> 2, h4 = h8 & 3; const int r32 = lane & 31, hi = lane >> 5;
    f32x16 S[4];
#pragma unroll
    for (int t = 0; t < 4; ++t) S[t] = (f32x16){};
    bf16* Obase = (dir ? F.OB : F.OF);
    for (int step = 0; step < 128; ++step) {
        const int n = dir ? 127 - step : step; const size_t it = (size_t)bh8 * 128 + n, tok0 = (size_t)b * SEQ + n * 64;
        bf16x8 Sb[8];
#pragma unroll
        for (int kb = 0; kb < 8; ++kb) { const int tk = kb >> 1, rb = 8 * (kb & 1); Sb[kb] = pack8(S[tk][rb], S[tk][rb + 1], S[tk][rb + 2], S[tk][rb + 3], S[tk][rb + 4], S[tk][rb + 5], S[tk][rb + 6], S[tk][rb + 7]); }
        const bf16* Wp = F.W + it * 8192 + r32 * 128 + 4 * hi; const bf16* Qp = F.DQ + (tok0 + r32) * 512 + h4 * 128 + 4 * hi;
        const bf16* UTp = F.UT + it * 8192 + (32 * sl + r32) * 64 + 4 * hi; const float* EGp = F.EG + it * 128 + 4 * hi;
        const bf16* QKp = F.QKM + it * 4096 + r32 * 64 + 4 * hi; const bf16* KTp = F.KT + ((size_t)(b * 4 + h4) * 128 + n) * 8192 + r32 * 64 + 4 * hi;
        f32x16 vn[2], o[2];
#pragma unroll
        for (int tc = 0; tc < 2; ++tc) { f32x16 a1 = {}, a2 = {};
#pragma unroll
            for (int kb = 0; kb < 8; ++kb) { a1 = MFMA32(ld44(Wp + tc * 32 * 128 + 16 * kb), Sb[kb], a1); a2 = MFMA32(ld44(Qp + (size_t)tc * 32 * 512 + 16 * kb), Sb[kb], a2); }
#pragma unroll
            for (int q = 0; q < 4; ++q) { const s16x4 u4 = *(const s16x4*)(UTp + 32 * tc + 8 * q); const f32x4 e4 = *(const f32x4*)(EGp + 32 * tc + 8 * q);
#pragma unroll
                for (int e = 0; e < 4; ++e) { a1[4 * q + e] = bf2f(u4[e]) - a1[4 * q + e]; a2[4 * q + e] *= e4[e]; } }
            vn[tc] = a1; o[tc] = a2; }
        bf16x8 vb[4], vsb[4];
#pragma unroll
        for (int k2 = 0; k2 < 4; ++k2) { const int tc = k2 >> 1, rb = 8 * (k2 & 1); float l[8];
#pragma unroll
            for (int h = 0; h < 2; ++h) { const f32x4 l4 = *(const f32x4*)(EGp + 64 + 32 * tc + 8 * (2 * (k2 & 1) + h));
#pragma unroll
                for (int e = 0; e < 4; ++e) l[4 * h + e] = l4[e]; }
            vb[k2] = pack8(vn[tc][rb], vn[tc][rb + 1], vn[tc][rb + 2], vn[tc][rb + 3], vn[tc][rb + 4], vn[tc][rb + 5], vn[tc][rb + 6], vn[tc][rb + 7]);
            vsb[k2] = pack8(vn[tc][rb] * l[0], vn[tc][rb + 1] * l[1], vn[tc][rb + 2] * l[2], vn[tc][rb + 3] * l[3], vn[tc][rb + 4] * l[4], vn[tc][rb + 5] * l[5], vn[tc][rb + 6] * l[6], vn[tc][rb + 7] * l[7]); }
#pragma unroll
        for (int tc = 0; tc < 2; ++tc) {
#pragma unroll
            for (int k2 = 0; k2 < 4; ++k2) o[tc] = MFMA32(ld44(QKp + tc * 32 * 64 + 16 * k2), vb[k2], o[tc]);
            bf16* op = Obase + (tok0 + 32 * tc) * 512 + h4 * 128 + 32 * sl + r32;
#pragma unroll
            for (int r = 0; r < 16; ++r) op[(size_t)crow(r, hi) * 512] = f2bf(o[tc][r]); }
        const float gtot = F.EG[it * 128 + (dir ? 0 : 63)];
#pragma unroll
        for (int tk = 0; tk < 4; ++tk) { S[tk] = S[tk] * gtot;
#pragma unroll
            for (int k2 = 0; k2 < 4; ++k2) S[tk] = MFMA32(ld44(KTp + tk * 32 * 64 + 16 * k2), vsb[k2], S[tk]); }
    }
}
__device__ __forceinline__ void p5_mix(Frame& F) {
    const int gw = F.vcu * NWAVES + F.wave, NGW = F.G * NWAVES, lane = F.lane;
    const float g0 = F.dn_norm[2 * lane], g1 = F.dn_norm[2 * lane + 1];
    for (int u = gw; u < M * 4; u += NGW) { const size_t off = (size_t)(u >> 2) * 512 + (u & 3) * 128 + 2 * lane;
        const unsigned a = *(const unsigned*)(F.OF + off), c = *(const unsigned*)(F.OB + off), z = *(const unsigned*)(F.Z + off);
        const float o0 = bflo(a) + bflo(c), o1 = bfhi(a) + bfhi(c); const float rs = rsqrtf(wave_sum(o0 * o0 + o1 * o1) * (1.f / 128.f) + EPS);
        const float z0 = bflo(z), z1 = bfhi(z);
        *(unsigned*)(F.MIXED + (size_t)(u >> 2) * 1024 + 512 + (u & 3) * 128 + 2 * lane) = pk2(o0 * rs * g0 * z0 * fast_sig(z0), o1 * rs * g1 * z1 * fast_sig(z1)); }
}
__device__ __forceinline__ void p10_final(Frame& F) {
    const int gw = F.vcu * NWAVES + F.wave, NGW = F.G * NWAVES;
    f32x4 gn[4];
#pragma unroll
    for (int j = 0; j < 4; ++j) gn[j] = ((const f32x4*)F.norm_final)[F.lane + 64 * j];
    for (int m = gw; m < M; m += NGW) { f32x4* xr = (f32x4*)(F.out + (size_t)m * DM) + F.lane; const float rstd = rsqrtf(F.SS[2 * M + m] * (1.f / DM) + EPS);
#pragma unroll
        for (int j = 0; j < 4; ++j) xr[64 * j] = xr[64 * j] * rstd * gn[j]; }
}
constexpr int N_PHASES = 11;
__global__ void __launch_bounds__(NWAVES * 64, 2) hymba_fwd(Args args) {
    extern __shared__ __attribute__((aligned(16))) unsigned char lds[];
    cg::grid_group grid = cg::this_grid();
    Frame F;
    F.lds = (LAS unsigned char*)lds; F.tid = threadIdx.x; F.lane = F.tid & 63; F.wave = __builtin_amdgcn_readfirstlane(F.tid >> 6);
    F.G = gridDim.x; { const int bx = blockIdx.x; F.vcu = (F.G % 8 == 0) ? (bx % 8) * (F.G / 8) + bx / 8 : bx; }
    unsigned char* ws = args.ws;
    F.x = args.in[0]; F.p = args.in[1]; F.norm_mix = args.in[2]; F.w_in = args.in[3]; F.conv_w = args.in[4]; F.q_norm = args.in[5]; F.k_norm = args.in[6]; F.a_log = args.in[7]; F.dt_bias = args.in[8];
    F.dn_norm = args.in[9]; F.w_out = args.in[10]; F.norm_ffn = args.in[11]; F.w_gate = args.in[12]; F.w_up = args.in[13]; F.w_down = args.in[14]; F.norm_ple = args.in[15]; F.w_ple_gate = args.in[16];
    F.w_ple = args.in[17]; F.norm_final = args.in[18]; F.out = args.out;
    F.SS = (float*)(ws + WS_SS); F.BA = (float*)(ws + WS_BA); F.EG = (float*)(ws + WS_EG);
    F.Wt_in = (bf16*)(ws + WS_WIN); F.Wt_out = (bf16*)(ws + WS_WOUT); F.Wt_gu = (bf16*)(ws + WS_WGU); F.Wt_dn = (bf16*)(ws + WS_WDN); F.Wt_pg = (bf16*)(ws + WS_WPG); F.Wt_pl = (bf16*)(ws + WS_WPL);
    F.PB = (bf16*)(ws + WS_PB); F.XN = (bf16*)(ws + WS_B); F.MIXED = (bf16*)(ws + WS_B); F.HB2 = (bf16*)(ws + WS_B);
    F.PROJ = (bf16*)(ws + WS_C); F.W = (bf16*)(ws + WS_W); F.UT = (bf16*)(ws + WS_UT); F.QKM = (bf16*)(ws + WS_QKM); F.ACT = (bf16*)(ws + WS_C); F.PE = (bf16*)(ws + WS_C);
    F.QA = (bf16*)(ws + WS_QA); F.KA = (bf16*)(ws + WS_KA); F.VA = (bf16*)(ws + WS_VA); F.DQ = (bf16*)(ws + WS_DQ); F.DK = (bf16*)(ws + WS_DK); F.KT = (bf16*)(ws + WS_KT); F.VT = (bf16*)(ws + WS_VT);
    F.Z = (bf16*)(ws + WS_Z); F.OF = (bf16*)(ws + WS_OF); F.OB = (bf16*)(ws + WS_OB); F.HB1 = (bf16*)(ws + WS_HB1);
    const int lo = args.ph_lo, hi = args.ph_hi;
#ifndef ONLY_PH
#define ONLY_PH -1
#endif
#define IN(k) ((ONLY_PH < 0 || ONLY_PH == (k)) && lo <= (k) && (k) < hi)
#define SEAM(k) do { if (IN(k) && IN((k) + 1)) grid.sync(); } while (0)
    if (IN(0)) { p0_prologue(F); __syncthreads(); }
    SEAM(0);
    if (IN(1)) { pg8::Gemm g{F.XN, F.Wt_in, M, NPAD, DM}; pg8::StaticOrder S; S.init(M, NPAD, F.G, (int)blockIdx.x); pg8::EpiProj E{F.PROJ, F.BA};
        pg8::gemm_phase<pg8::EpiProj, pg8::StaticOrder, true, true>(F.lds, g, S, E); }
    SEAM(1);
    if (IN(2)) { p2_attn_rows(F); p2_dn_conv(F); __syncthreads(); }
    SEAM(2);
    if (IN(3)) {
        { const attn_body::AttnTensors AT{(const attn_body::bf16*)F.QA, (const attn_body::bf16*)F.KA, (const attn_body::bf16*)F.VA, (attn_body::bf16*)F.MIXED};
#ifndef NO_ATTN
          const attn_body::StaticOrder S((int)F.G, (int)blockIdx.x); attn_body::attn_phase<attn_body::StaticOrder>((char*)lds, AT, S);
#endif
        }
        __syncthreads();
        { LAS float* SA = (LAS float*)(F.lds + F.wave * 18176); LAS float* sv = SA + 64 * SAP;
#ifndef NO_PREP
          for (int it = F.vcu * NWAVES + F.wave; it < NB * 8 * 128; it += F.G * NWAVES) dn_prep_item(F, it, SA, sv, F.lane);
#endif
        }
        __syncthreads();
    }
    SEAM(3);
    if (IN(4)) {
#ifndef NO_SCAN
        if (F.wave == 0) for (int it = F.vcu; it < NB * 8 * 4; it += F.G) dn_scan_item(F, it, F.lane);
#endif
        __syncthreads(); }
    SEAM(4);
    if (IN(5)) { p5_mix(F); }
    SEAM(5);
    if (IN(6)) { pg8::Gemm g{F.MIXED, F.Wt_out, M, DM, DM}; pg8::StaticOrder S; S.init(M, DM, F.G, (int)blockIdx.x); pg8::EpiRes E{F.x, F.out, F.HB1, F.SS};
        pg8::gemm_phase<pg8::EpiRes, pg8::StaticOrder, true, true>(F.lds, g, S, E); }
    SEAM(6);
    if (IN(7)) { pg8::Gemm g{F.HB1, F.Wt_gu, M, 2 * FF, DM}; pg8::StaticOrder S; S.init(M, 2 * FF, F.G, (int)blockIdx.x); pg8::EpiGU E{F.SS, F.ACT};
        pg8::gemm_phase<pg8::EpiGU, pg8::StaticOrder, true, true>(F.lds, g, S, E); }
    SEAM(7);
    if (IN(8)) { pg8::Gemm g{F.ACT, F.Wt_dn, M, DM, FF}; pg8::StaticOrder S; S.init(M, DM, F.G, (int)blockIdx.x); pg8::EpiRes E{F.out, F.out, F.HB2, F.SS + M};
        pg8::gemm_phase<pg8::EpiRes, pg8::StaticOrder, true, true>(F.lds, g, S, E); }
    SEAM(8);
    if (IN(9)) {
#ifndef NO_G9A
        { int kpe = 256; asm volatile("" : "+s"(kpe)); pg8::Gemm g{F.PB, F.Wt_pl, M, DM, kpe}; pg8::StaticOrder S; S.init(M, DM, F.G, (int)blockIdx.x); pg8::EpiStore E{F.PE, DM};
          pg8::gemm_phase<pg8::EpiStore, pg8::StaticOrder, true, true>(F.lds, g, S, E); }
#endif
        asm volatile("s_waitcnt vmcnt(0)" ::: "memory"); __syncthreads();
#ifndef NO_G9B
        { pg8::Gemm g{F.HB2, F.Wt_pg, M, DM, DM}; pg8::StaticOrder S; S.init(M, DM, F.G, (int)blockIdx.x); pg8::EpiPle E{F.out, F.PE, F.SS + M, F.SS + 2 * M};
          pg8::gemm_phase<pg8::EpiPle, pg8::StaticOrder, true, true>(F.lds, g, S, E); }
#endif
    }
    SEAM(9);
    if (IN(10)) { p10_final(F); }
#undef IN
#undef SEAM
}

#ifndef MK_PER_PHASE
#define MK_PER_PHASE 0
#endif
extern "C" void kernel_launch(void* const* d_in, const int* in_sizes, int n_in, void* d_out, int out_size, void* d_ws, size_t ws_size, hipStream_t stream) {
    static int grid = 0;
    if (grid == 0) {
        if (n_in != 19 || in_sizes[0] != M * DM || out_size != M * DM || ws_size < WS_END) { fprintf(stderr, "kernel_launch: unexpected shapes / workspace (n_in %d, ws %zu); nothing launched\n", n_in, ws_size); grid = -1; return; }
        int dev = 0, cus = 0, per_cu = 0;
        (void)hipGetDevice(&dev); (void)hipDeviceGetAttribute(&cus, hipDeviceAttributeMultiprocessorCount, dev);
        (void)hipFuncSetAttribute((const void*)hymba_fwd, hipFuncAttributeMaxDynamicSharedMemorySize, LDS_BYTES);
        (void)hipOccupancyMaxActiveBlocksPerMultiprocessor(&per_cu, (const void*)hymba_fwd, NWAVES * 64, LDS_BYTES);
        (void)hipGetLastError();
        if (per_cu < 1) { fprintf(stderr, "kernel_launch: occupancy query says %d blocks per CU\n", per_cu); per_cu = 1; }
        grid = cus;
    }
    if (grid < 0) return;
    Args a{};
    for (int i = 0; i < 19; ++i) a.in[i] = (const float*)d_in[i];
    a.out = (float*)d_out; a.ws = (unsigned char*)d_ws;
#if MK_PER_PHASE
    for (int ph = 0; ph < N_PHASES; ++ph) { a.ph_lo = ph; a.ph_hi = ph + 1; hipLaunchKernelGGL(hymba_fwd, dim3(grid), dim3(NWAVES * 64), LDS_BYTES, stream, a); }
#else
    a.ph_lo = 0; a.ph_hi = N_PHASES;
    void* kargs[] = {&a};
    hipError_t e = hipLaunchCooperativeKernel((const void*)hymba_fwd, dim3(grid), dim3(NWAVES * 64), kargs, LDS_BYTES, stream);
    if (e != hipSuccess) fprintf(stderr, "cooperative launch failed: %s (grid %d)\n", hipGetErrorString(e), grid);
#endif
}
```

```cpp
#include <hip/hip_runtime.h>
#include <hip/hip_cooperative_groups.h>
#include <cstdio>
#include <cstdint>
namespace pg8 {
#define PG8_LAS __attribute__((address_space(3)))
typedef unsigned short bf16_t;
typedef short bf16x8 __attribute__((ext_vector_type(8)));
typedef float f32x4 __attribute__((ext_vector_type(4)));
typedef unsigned u32x4 __attribute__((ext_vector_type(4)));
constexpr int BM = 256, BK = 64, HALF = 128, HTB = HALF * BK * 2  , STAGE_BYTES = 8 * HTB, NXCD = 8, WGM = 8;

__host__ __device__ __forceinline__ int lds_byte(int r, int c) { const int st = (r >> 4) * 2 + (c >> 5), rr = r & 15, cc = c & 31, ob = rr * 64 + cc * 2; return st * 1024 + (ob ^ (((ob >> 9) & 1) << 5)); }
__host__ __device__ __forceinline__ void stage_rc(int b, int& R, int& C) { const int st = b / 1024, sb = b % 1024, swz = sb ^ (((sb >> 9) & 1) << 5); R = (st >> 1) * 16 + swz / 64; C = (st & 1) * 32 + (swz % 64) / 2; }
__host__ __device__ __forceinline__ int perm32(int rho) { const int n = rho >> 4, i = rho & 15; return 8 * (i >> 2) + 4 * n + (i & 3); }

struct Unit { int pm, pn; };
struct Gemm { const bf16_t* A; const bf16_t* Bt; int M, N, K; };

struct StaticOrder {
    int nM, nN, nwg, G, c;
    __host__ __device__ void init(int M, int N, int G_, int c_) { nM = M / BM; nN = N / BM; nwg = nM * nN; G = G_; c = c_; }
    __host__ __device__ bool next(int i, Unit& u) const {
        const long L = (long)i * G + c; if (L >= nwg) return false;
        int wgid = (int)L; { const int q = nwg / NXCD, r = nwg % NXCD, xcd = wgid % NXCD, off = wgid / NXCD; wgid = (xcd < r ? xcd * (q + 1) : r * (q + 1) + (xcd - r) * q) + off; }
        const int nig = WGM * nN, gid = wgid / nig, fm = gid * WGM, gsz = (nM - fm) < WGM ? (nM - fm) : WGM;
        u.pm = fm + ((wgid % nig) % gsz); u.pn = (wgid % nig) / gsz; return true;
    }
    __device__ __forceinline__ void a_ready(const Unit&) const {}
    __device__ __forceinline__ void done(const Unit&) const {}
};

__device__ __forceinline__ unsigned cvt_pk_bf16(float lo, float hi) { unsigned r; asm volatile("v_cvt_pk_bf16_f32 %0, %1, %2" : "=v"(r) : "v"(lo), "v"(hi)); return r; }
typedef float f32x2 __attribute__((ext_vector_type(2)));
typedef unsigned u32x2 __attribute__((ext_vector_type(2)));
__device__ __forceinline__ float fast_sigmoid(float v) { return __builtin_amdgcn_rcpf(1.f + __expf(-v)); }
struct EpiProj {
    static constexpr bool PERM = true, AFTER_DRAIN = false;
    bf16_t* O; float* BA;
    __device__ __forceinline__ void operator()(const f32x4 (&acc)[2][2][4][2], const Unit& u, int wr, int wc, int fr, int fq) const {
        const int row0 = u.pm * BM + wr * 64 + fr;
        if (u.pn < 11) {
            const int col0 = u.pn * BM + wc * 32 + 8 * fq;
#pragma unroll
            for (int ai = 0; ai < 2; ++ai)
#pragma unroll
                for (int m = 0; m < 4; ++m) { bf16_t* rowp = O + (size_t)(row0 + ai * HALF + m * 16) * 2816 + col0;
#pragma unroll
                    for (int bj = 0; bj < 2; ++bj) { const f32x4 v0 = acc[ai][bj][m][0], v1 = acc[ai][bj][m][1];
                        u32x4 w; w.x = cvt_pk_bf16(v0[0], v0[1]); w.y = cvt_pk_bf16(v0[2], v0[3]); w.z = cvt_pk_bf16(v1[0], v1[1]); w.w = cvt_pk_bf16(v1[2], v1[3]);
                        *(u32x4*)(rowp + bj * HALF) = w; } }
        } else if (wc == 0 && fq < 2) {
#pragma unroll
            for (int ai = 0; ai < 2; ++ai)
#pragma unroll
                for (int m = 0; m < 4; ++m) { float* rowp = BA + (size_t)(row0 + ai * HALF + m * 16) * 16 + 8 * fq;
                    *(f32x4*)(rowp) = acc[ai][0][m][0]; *(f32x4*)(rowp + 4) = acc[ai][0][m][1]; }
        }
    }
};
struct EpiStore {
    static constexpr bool PERM = true, AFTER_DRAIN = false;
    bf16_t* O; int ldc;
    __device__ __forceinline__ void operator()(const f32x4 (&acc)[2][2][4][2], const Unit& u, int wr, int wc, int fr, int fq) const {
        const int row0 = u.pm * BM + wr * 64 + fr; const int col0 = u.pn * BM + wc * 32 + 8 * fq;
#pragma unroll
        for (int ai = 0; ai < 2; ++ai)
#pragma unroll
            for (int m = 0; m < 4; ++m) { bf16_t* rowp = O + (size_t)(row0 + ai * HALF + m * 16) * ldc + col0;
#pragma unroll
                for (int bj = 0; bj < 2; ++bj) { const f32x4 v0 = acc[ai][bj][m][0], v1 = acc[ai][bj][m][1];
                    u32x4 w; w.x = cvt_pk_bf16(v0[0], v0[1]); w.y = cvt_pk_bf16(v0[2], v0[3]); w.z = cvt_pk_bf16(v1[0], v1[1]); w.w = cvt_pk_bf16(v1[2], v1[3]);
                    *(u32x4*)(rowp + bj * HALF) = w; } }
    }
};
struct EpiRes {
    static constexpr bool PERM = false, AFTER_DRAIN = false;
    const float* base; float* out; bf16_t* hb; float* ss;
    __device__ __forceinline__ void operator()(const f32x4 (&acc)[2][2][4][2], const Unit& u, int wr, int wc, int fr, int fq) const {
        const int col0 = u.pn * BM + wc * 32 + 4 * fq;
#pragma unroll
        for (int ai = 0; ai < 2; ++ai)
#pragma unroll
            for (int m = 0; m < 4; ++m) { const int row = u.pm * BM + ai * HALF + wr * 64 + m * 16 + fr; const size_t off = (size_t)row * 1024 + col0; float s = 0.f;
#pragma unroll
                for (int bj = 0; bj < 2; ++bj)
#pragma unroll
                    for (int n = 0; n < 2; ++n) { const f32x4 bs = *(const f32x4*)(base + off + bj * HALF + n * 16); const f32x4 o = bs + acc[ai][bj][m][n];
                        *(f32x4*)(out + off + bj * HALF + n * 16) = o; s += (o[0] * o[0] + o[1] * o[1]) + (o[2] * o[2] + o[3] * o[3]);
                        u32x2 w; w.x = cvt_pk_bf16(o[0], o[1]); w.y = cvt_pk_bf16(o[2], o[3]); *(u32x2*)(hb + off + bj * HALF + n * 16) = w; }
                s += __shfl_xor(s, 16); s += __shfl_xor(s, 32);
                if (fq == 0) unsafeAtomicAdd(ss + row, s); }
    }
};
struct EpiGU {
    static constexpr bool PERM = true, AFTER_DRAIN = false;
    const float* ss; bf16_t* act;
    __device__ __forceinline__ void operator()(const f32x4 (&acc)[2][2][4][2], const Unit& u, int wr, int wc, int fr, int fq) const {
        const int col0 = u.pn * HALF + wc * 32 + 8 * fq;
#pragma unroll
        for (int ai = 0; ai < 2; ++ai)
#pragma unroll
            for (int m = 0; m < 4; ++m) { const int row = u.pm * BM + ai * HALF + wr * 64 + m * 16 + fr;
                const float rstd = rsqrtf(ss[row] * (1.0f / 1024.0f) + 1e-6f); float a[8];
#pragma unroll
                for (int n = 0; n < 2; ++n)
#pragma unroll
                    for (int e = 0; e < 4; ++e) { const float g = acc[ai][0][m][n][e] * rstd, up = acc[ai][1][m][n][e] * rstd; a[4 * n + e] = g * fast_sigmoid(g) * up; }
                u32x4 w; w.x = cvt_pk_bf16(a[0], a[1]); w.y = cvt_pk_bf16(a[2], a[3]); w.z = cvt_pk_bf16(a[4], a[5]); w.w = cvt_pk_bf16(a[6], a[7]);
                *(u32x4*)(act + (size_t)row * 2816 + col0) = w; }
    }
};
struct EpiPle {
    static constexpr bool PERM = false, AFTER_DRAIN = false;
    float* h; const bf16_t* pe; const float* ss2; float* ss3;
    __device__ __forceinline__ void operator()(const f32x4 (&acc)[2][2][4][2], const Unit& u, int wr, int wc, int fr, int fq) const {
        const int col0 = u.pn * BM + wc * 32 + 4 * fq;
#pragma unroll
        for (int ai = 0; ai < 2; ++ai)
#pragma unroll
            for (int m = 0; m < 4; ++m) { const int row = u.pm * BM + ai * HALF + wr * 64 + m * 16 + fr; const size_t off = (size_t)row * 1024 + col0; float s = 0.f;
                const float rstd = rsqrtf(ss2[row] * (1.0f / 1024.0f) + 1e-6f);
#pragma unroll
                for (int bj = 0; bj < 2; ++bj)
#pragma unroll
                    for (int n = 0; n < 2; ++n) { const size_t o2 = off + bj * HALF + n * 16; const f32x4 bs = *(const f32x4*)(h + o2); const u32x2 pw = *(const u32x2*)(pe + o2);
                        const f32x4 a = acc[ai][bj][m][n]; f32x4 o;
                        o[0] = bs[0] + fast_sigmoid(a[0] * rstd) * __uint_as_float(pw.x << 16); o[1] = bs[1] + fast_sigmoid(a[1] * rstd) * __uint_as_float(pw.x & 0xffff0000u);
                        o[2] = bs[2] + fast_sigmoid(a[2] * rstd) * __uint_as_float(pw.y << 16); o[3] = bs[3] + fast_sigmoid(a[3] * rstd) * __uint_as_float(pw.y & 0xffff0000u);
                        *(f32x4*)(h + o2) = o; s += (o[0] * o[0] + o[1] * o[1]) + (o[2] * o[2] + o[3] * o[3]); asm volatile("" ::: "memory"); }
                s += __shfl_xor(s, 16); s += __shfl_xor(s, 32);
                if (fq == 0) unsafeAtomicAdd(ss3 + row, s);
                asm volatile("" ::: "memory"); }
    }
};
template <class Epi, class Sched, bool ALIGN_EPI = false, bool SP2 = false>
__device__ __forceinline__ void gemm_phase(PG8_LAS unsigned char* lds, const Gemm g, const Sched& S, const Epi& E) {
    const int tid = threadIdx.x, wid = __builtin_amdgcn_readfirstlane(tid >> 6), lane = tid & 63, wr = wid >> 2, wc = wid & 3, fr = lane & 15, fq = lane >> 4;
    const int K = g.K, nt = K / BK;
    unsigned voffA[2], voffB[2];
#pragma unroll
    for (int i = 0; i < 2; ++i) { int R, C; stage_rc(tid * 16 + i * 8192, R, C); const int Rb = Epi::PERM ? ((R & ~31) + perm32(R & 31)) : R;
        voffA[i] = (unsigned)(R * K + C) * 2u; voffB[i] = (unsigned)(Rb * K + C) * 2u; }
    const size_t kstep = (size_t)(BK * 2);
    const size_t hstep = (size_t)HALF * K * 2;
    const size_t tstep = 2 * hstep;
    const unsigned ldsw = (unsigned)wid * 1024u;
    const int aoff = lds_byte(wr * 64 + fr, fq * 8), boff = lds_byte(wc * 32 + fr, fq * 8);
#define PG8_SA(b, h) (((b) * 2 + (h)) * HTB)
#define PG8_SB(b, h) ((4 + (b) * 2 + (h)) * HTB)
#define PG8_STAGE(bufoff, gbase, voff) do { _Pragma("unroll") for (int _i = 0; _i < 2; ++_i) \
        __builtin_amdgcn_global_load_lds((const unsigned*)((const char*)(gbase) + (voff)[_i]), (PG8_LAS unsigned*)(lds + (bufoff) + ldsw + _i * 8192), 16, 0, 0); } while (0)
#define PG8_LDA(dst, b, h) do { _Pragma("unroll") for (int m = 0; m < 4; ++m) _Pragma("unroll") for (int k = 0; k < 2; ++k) dst[m][k] = *(const PG8_LAS bf16x8*)(lds + PG8_SA(b, h) + aoff + m * 2048 + k * 1024); } while (0)
#define PG8_LDB(dst, b, h) do { _Pragma("unroll") for (int n = 0; n < 2; ++n) _Pragma("unroll") for (int k = 0; k < 2; ++k) dst[n][k] = *(const PG8_LAS bf16x8*)(lds + PG8_SB(b, h) + boff + n * 2048 + k * 1024); } while (0)
#define PG8_MMA(ai, bj, At, Bt) do { __builtin_amdgcn_s_setprio(1); _Pragma("unroll") for (int m = 0; m < 4; ++m) _Pragma("unroll") for (int n = 0; n < 2; ++n) _Pragma("unroll") for (int k = 0; k < 2; ++k) \
        acc[ai][bj][m][n] = __builtin_amdgcn_mfma_f32_16x16x32_bf16(Bt[n][k], At[m][k], acc[ai][bj][m][n], 0, 0, 0); __builtin_amdgcn_s_setprio(0); } while (0)
#define PG8_WAIT_V(n) asm volatile("s_waitcnt vmcnt(" #n ")" ::: "memory")
#define PG8_WAIT_L(n) asm volatile("s_waitcnt lgkmcnt(" #n ")" ::: "memory")
#define PG8_BAR __builtin_amdgcn_s_barrier()
#define PG8_SCHED __builtin_amdgcn_sched_barrier(0)
    Unit cur, nxt; int ui = 0;
    if (!S.next(0, cur)) return;
    f32x4 acc[2][2][4][2];
#pragma unroll
    for (int a = 0; a < 2; ++a)
#pragma unroll
        for (int b = 0; b < 2; ++b)
#pragma unroll
            for (int m = 0; m < 4; ++m)
#pragma unroll
                for (int n = 0; n < 2; ++n) acc[a][b][m][n] = (f32x4){0.f, 0.f, 0.f, 0.f};
    bf16x8 At[4][2], B0[2][2], B1[2][2];
    const char* cA = (const char*)g.A + (size_t)cur.pm * tstep; const char* cB = (const char*)g.Bt + (size_t)cur.pn * tstep;
    S.a_ready(cur);
    if constexpr (SP2) {
        PG8_STAGE(PG8_SB(0, 0), cB, voffB); PG8_STAGE(PG8_SB(0, 1), cB + hstep, voffB); PG8_STAGE(PG8_SA(0, 0), cA, voffA); PG8_STAGE(PG8_SA(0, 1), cA + hstep, voffA);
        if (wr == 1) PG8_BAR;
        PG8_WAIT_V(2); PG8_BAR;
        PG8_STAGE(PG8_SB(1, 0), cB + kstep, voffB); PG8_STAGE(PG8_SA(1, 0), cA + kstep, voffA); PG8_STAGE(PG8_SB(1, 1), cB + hstep + kstep, voffB);
        PG8_WAIT_V(6); PG8_BAR;
    } else {
        PG8_STAGE(PG8_SB(0, 0), cB, voffB); PG8_STAGE(PG8_SA(0, 0), cA, voffA); PG8_STAGE(PG8_SB(0, 1), cB + hstep, voffB); PG8_STAGE(PG8_SA(0, 1), cA + hstep, voffA);
        if (wr == 1) PG8_BAR;
        PG8_WAIT_V(4); PG8_BAR;
        PG8_STAGE(PG8_SB(1, 0), cB + kstep, voffB); PG8_STAGE(PG8_SA(1, 0), cA + kstep, voffA); PG8_STAGE(PG8_SB(1, 1), cB + hstep + kstep, voffB);
        PG8_WAIT_V(6); PG8_BAR;
    }
    for (;;) {
        const bool has_next = S.next(ui + 1, nxt);
        const char* nA = has_next ? (const char*)g.A + (size_t)nxt.pm * tstep : cA; const char* nB = has_next ? (const char*)g.Bt + (size_t)nxt.pn * tstep : cB;
        for (int t = 0; t < nt; t += 2) {
            const bool last = (t == nt - 2);
            const char* a1 = cA + (size_t)(t + 1) * kstep;
            const char* a2 = last ? nA : cA + (size_t)(t + 2) * kstep; const char* b2 = last ? nB : cB + (size_t)(t + 2) * kstep;
            const char* a3 = a2 + kstep; const char* b3 = b2 + kstep;
            if (last && has_next) S.a_ready(nxt);
            if constexpr (SP2) {
            PG8_LDB(B0, 0, 0); PG8_LDB(B1, 0, 1); PG8_SCHED; PG8_LDA(At, 0, 0); PG8_STAGE(PG8_SA(1, 1), a1 + hstep, voffA);
            PG8_WAIT_V(8); PG8_WAIT_L(0); PG8_BAR; PG8_MMA(0, 0, At, B0); PG8_MMA(0, 1, At, B1); PG8_BAR; PG8_SCHED;
            PG8_LDA(At, 0, 1); PG8_STAGE(PG8_SB(0, 0), b2, voffB); PG8_STAGE(PG8_SB(0, 1), b2 + hstep, voffB); PG8_STAGE(PG8_SA(0, 0), a2, voffA);
            PG8_WAIT_V(8); PG8_WAIT_L(0); PG8_BAR; PG8_MMA(1, 0, At, B0); PG8_MMA(1, 1, At, B1); PG8_BAR; PG8_SCHED;
            PG8_LDB(B0, 1, 0); PG8_LDB(B1, 1, 1); PG8_SCHED; PG8_LDA(At, 1, 0); PG8_STAGE(PG8_SA(0, 1), a2 + hstep, voffA);
            PG8_WAIT_V(8); PG8_WAIT_L(0); PG8_BAR; PG8_MMA(0, 0, At, B0); PG8_MMA(0, 1, At, B1); PG8_BAR; PG8_SCHED;
            PG8_LDA(At, 1, 1); PG8_STAGE(PG8_SB(1, 0), b3, voffB); PG8_STAGE(PG8_SB(1, 1), b3 + hstep, voffB); PG8_STAGE(PG8_SA(1, 0), a3, voffA);
            PG8_WAIT_V(8); PG8_WAIT_L(0); PG8_BAR; PG8_MMA(1, 0, At, B0); PG8_MMA(1, 1, At, B1); PG8_BAR; PG8_SCHED;
            } else {
            PG8_LDB(B0, 0, 0); PG8_SCHED; PG8_LDA(At, 0, 0); PG8_STAGE(PG8_SA(1, 1), a1 + hstep, voffA);
            PG8_WAIT_L(8); PG8_BAR; PG8_WAIT_L(0); PG8_MMA(0, 0, At, B0); PG8_BAR; PG8_SCHED;
            PG8_LDB(B1, 0, 1); PG8_STAGE(PG8_SB(0, 0), b2, voffB);
            PG8_BAR; PG8_WAIT_L(0); PG8_MMA(0, 1, At, B1); PG8_BAR;
            PG8_LDA(At, 0, 1); PG8_STAGE(PG8_SA(0, 0), a2, voffA);
            PG8_BAR; PG8_WAIT_L(0); PG8_MMA(1, 0, At, B0); PG8_BAR; PG8_SCHED;
            PG8_STAGE(PG8_SB(0, 1), b2 + hstep, voffB);
            PG8_WAIT_V(6); PG8_BAR; PG8_MMA(1, 1, At, B1); PG8_BAR;
            PG8_LDB(B0, 1, 0); PG8_SCHED; PG8_LDA(At, 1, 0); PG8_STAGE(PG8_SA(0, 1), a2 + hstep, voffA);
            PG8_WAIT_L(8); PG8_BAR; PG8_WAIT_L(0); PG8_MMA(0, 0, At, B0); PG8_BAR; PG8_SCHED;
            PG8_LDB(B1, 1, 1); PG8_STAGE(PG8_SB(1, 0), b3, voffB);
            PG8_BAR; PG8_WAIT_L(0); PG8_MMA(0, 1, At, B1); PG8_BAR;
            PG8_LDA(At, 1, 1); PG8_STAGE(PG8_SA(1, 0), a3, voffA);
            PG8_BAR; PG8_WAIT_L(0); PG8_MMA(1, 0, At, B0); PG8_BAR; PG8_SCHED;
            PG8_STAGE(PG8_SB(1, 1), b3 + hstep, voffB);
            PG8_WAIT_V(6); PG8_BAR; PG8_MMA(1, 1, At, B1); PG8_BAR;
            }
        }
        if constexpr (ALIGN_EPI) { if (wr == 0) PG8_BAR; }
        if constexpr (!Epi::AFTER_DRAIN) { E(acc, cur, wr, wc, fr, fq); S.done(cur); }
        if (!has_next) break;
#pragma unroll
        for (int a = 0; a < 2; ++a)
#pragma unroll
            for (int b = 0; b < 2; ++b)
#pragma unroll
                for (int m = 0; m < 4; ++m)
#pragma unroll
                    for (int n = 0; n < 2; ++n) acc[a][b][m][n] = (f32x4){0.f, 0.f, 0.f, 0.f};
        cur = nxt; cA = nA; cB = nB; ++ui;
        if constexpr (ALIGN_EPI) { if (wr == 1) PG8_BAR; }
    }
    PG8_WAIT_V(0);
    if constexpr (!ALIGN_EPI) { if (wr == 0) PG8_BAR; }
    PG8_BAR;
    if constexpr (Epi::AFTER_DRAIN) { E.fused(acc, cur, wr, wc, fr, fq, lds, wid, lane); S.done(cur); }
#undef PG8_SA
#undef PG8_SB
#undef PG8_STAGE
#undef PG8_LDA
#undef PG8_LDB
#undef PG8_MMA
#undef PG8_WAIT_V
#undef PG8_WAIT_L
#undef PG8_BAR
#undef PG8_SCHED
}
}
#include <hip/hip_bf16.h>
#include <cmath>
namespace attn_body {
using bf16=__hip_bfloat16;
using bf16x8=__attribute__((ext_vector_type(8)))short;
using s16x4=__attribute__((ext_vector_type(4)))short;
using f32x16=__attribute__((ext_vector_type(16)))float;
using u32x4=__attribute__((ext_vector_type(4)))unsigned;
constexpr int BATCH=8,NHEAD=8,SEQ=8192,D=64,QP=512,KP=128,OP=1024,GQ=4;
constexpr int NW=8,QBLK=32,QB=QBLK*NW,KVBLK=64,NQB=SEQ/QB;
constexpr int ATTN_UNIT_ROWS=QB;
__device__ __forceinline__ int crow(int r,int hi){return (r&3)+8*(r>>2)+4*hi;}
#define SBAR() __builtin_amdgcn_sched_barrier(0)
__device__ __forceinline__ void cmask(f32x16&p0,f32x16&p1,int jb,int qrel,int hi){
  const float NEG=-INFINITY; int kb=64*jb+4*hi;
  #pragma unroll
  for(int r=0;r<16;++r){int kv=kb+(r&3)+8*(r>>2); if(kv>qrel)p0[r]=NEG; if(kv+32>qrel)p1[r]=NEG;}
}

constexpr int NSLOT=3, SLOTB=8192;
constexpr int LDS_K=0, LDS_V=NSLOT*SLOTB, LDS_WS=2*NSLOT*SLOTB, LDS_OST=LDS_WS+NW*64*4, LDS_BYTES=LDS_OST+NW*4096;
constexpr float C2=0.125f*1.4426950408889634f;
__device__ __forceinline__ void glds16(const void*gsrc,unsigned lds_dst){unsigned keep;
  asm volatile("s_mov_b32 %0, m0\n\ts_mov_b32 m0, %2\n\ts_nop 0\n\tglobal_load_lds_dwordx4 %1, off\n\ts_mov_b32 m0, %0":"=&s"(keep):"v"(gsrc),"s"(lds_dst):"memory");}
__device__ __forceinline__ float max3f(float a,float b,float c){float r;asm("v_max3_f32 %0, %1, %2, %3":"=v"(r):"v"(a),"v"(b),"v"(c));return r;}
__device__ __forceinline__ float max2f(float a,float b){float r;asm("v_max_f32_e32 %0, %1, %2":"=v"(r):"v"(a),"v"(b));return r;}
__device__ __forceinline__ float fadd_s(float a,float b){float r;asm("v_add_f32_e32 %0, %1, %2":"=v"(r):"v"(a),"v"(b));return r;}
__device__ __forceinline__ float fsub_s(float a,float b){float r;asm("v_sub_f32_e32 %0, %1, %2":"=v"(r):"v"(a),"v"(b));return r;}
typedef float f32x2_t __attribute__((ext_vector_type(2))); typedef __bf16 bf16x2_t __attribute__((ext_vector_type(2)));
__device__ __forceinline__ unsigned cvtpk_s(float lo,float hi){f32x2_t v={lo,hi};bf16x2_t b=__builtin_convertvector(v,bf16x2_t);return __builtin_bit_cast(unsigned,b);}
#define WAIT_BAR(N) asm volatile("s_waitcnt vmcnt(" #N ") lgkmcnt(0)\n\ts_barrier":::"memory")

__device__ __forceinline__ void qkt(f32x16&p0,f32x16&p1,const char*Kslot,const bf16x8*qr,const f32x16&negm,int r32,int hi){
  const char*kb=Kslot+hi*1024+r32*16;
  #pragma unroll
  for(int d0=0;d0<4;++d0){
    const bf16x8 b0=*reinterpret_cast<const bf16x8*>(kb+d0*2048);
    const bf16x8 b1=*reinterpret_cast<const bf16x8*>(kb+d0*2048+512);
    if(d0==0){p0=__builtin_amdgcn_mfma_f32_32x32x16_bf16(b0,qr[0],negm,0,0,0);p1=__builtin_amdgcn_mfma_f32_32x32x16_bf16(b1,qr[0],negm,0,0,0);}
    else{p0=__builtin_amdgcn_mfma_f32_32x32x16_bf16(b0,qr[d0],p0,0,0,0);p1=__builtin_amdgcn_mfma_f32_32x32x16_bf16(b1,qr[d0],p1,0,0,0);}}
}
typedef __attribute__((address_space(3))) const char* lds_cptr;
typedef short v4i16_t __attribute__((ext_vector_type(4)));
__device__ __forceinline__ void kload8(bf16x8*kf,lds_cptr kp){
  kf[0]=*(const __attribute__((address_space(3))) bf16x8*)(kp);      kf[1]=*(const __attribute__((address_space(3))) bf16x8*)(kp+512);
  kf[2]=*(const __attribute__((address_space(3))) bf16x8*)(kp+2048); kf[3]=*(const __attribute__((address_space(3))) bf16x8*)(kp+2560);
  kf[4]=*(const __attribute__((address_space(3))) bf16x8*)(kp+4096); kf[5]=*(const __attribute__((address_space(3))) bf16x8*)(kp+4608);
  kf[6]=*(const __attribute__((address_space(3))) bf16x8*)(kp+6144); kf[7]=*(const __attribute__((address_space(3))) bf16x8*)(kp+6656);
}
__device__ __forceinline__ void kload2(bf16x8*kf,lds_cptr kp,int j){ kf[2*j]=*(const __attribute__((address_space(3))) bf16x8*)(kp+j*2048); kf[2*j+1]=*(const __attribute__((address_space(3))) bf16x8*)(kp+j*2048+512); }
__device__ __forceinline__ s16x4 vtr(lds_cptr p){ return __builtin_bit_cast(s16x4,__builtin_amdgcn_ds_read_tr16_b64_v4i16((__attribute__((address_space(3))) v4i16_t*)p)); }
__device__ __forceinline__ float rowmax(const f32x16&p0,const f32x16&p1){
  float a=max3f(p0[0],p0[1],p1[0]),b=max3f(p0[2],p0[3],p1[1]);a=max3f(a,p1[2],p1[3]);
  #pragma unroll
  for(int r=4;r<16;r+=4){a=max3f(a,p0[r],p0[r+1]);b=max3f(b,p0[r+2],p0[r+3]);a=max3f(a,p1[r],p1[r+1]);b=max3f(b,p1[r+2],p1[r+3]);}
  const float m=max2f(a,b);
  auto rr=__builtin_amdgcn_permlane32_swap(__float_as_uint(m),__float_as_uint(m),false,false);
  return max2f(__uint_as_float(rr[0]),__uint_as_float(rr[1]));
}
__device__ __forceinline__ void pv(f32x16*o,int vb,bf16x8 pa0,bf16x8 pa1,bf16x8 pa2,bf16x8 pa3){
  #pragma unroll
  for(int d0=0;d0<2;++d0){s16x4 lo[4],hi[4];
    #pragma unroll
    for(int ks=0;ks<4;++ks){
      asm volatile("ds_read_b64_tr_b16 %0,%1 offset:%c2":"=&v"(lo[ks]):"v"(vb),"i"(d0*4096+ks*1024):"memory");
      asm volatile("ds_read_b64_tr_b16 %0,%1 offset:%c2":"=&v"(hi[ks]):"v"(vb),"i"(d0*4096+ks*1024+512):"memory");}
    asm volatile("s_waitcnt lgkmcnt(0)":::"memory");SBAR();
    #define PK(k) (bf16x8){lo[k][0],lo[k][1],lo[k][2],lo[k][3],hi[k][0],hi[k][1],hi[k][2],hi[k][3]}
    o[d0]=__builtin_amdgcn_mfma_f32_32x32x16_bf16(pa0,PK(0),o[d0],0,0,0);
    o[d0]=__builtin_amdgcn_mfma_f32_32x32x16_bf16(pa1,PK(1),o[d0],0,0,0);
    o[d0]=__builtin_amdgcn_mfma_f32_32x32x16_bf16(pa2,PK(2),o[d0],0,0,0);
    o[d0]=__builtin_amdgcn_mfma_f32_32x32x16_bf16(pa3,PK(3),o[d0],0,0,0);
    #undef PK
  }
}

#ifndef ATTN_STORE16
#define ATTN_STORE16(p,v) (*(u32x4*)(p)=(v))
#endif
template<int THRL> __device__ __forceinline__ void attn_unit(int b,int h,int qb,const bf16*Q,const bf16*__restrict__ K,const bf16*__restrict__ V,bf16*O,char*shm){
  const int tid=threadIdx.x,lane=tid&63,r32=lane&31,hi=lane>>5; const int wid=__builtin_amdgcn_readfirstlane(tid>>6);
  const long rowbase=(long)b*SEQ; const int q0=qb*QB;
  const bf16*Qw=Q+(rowbase+q0+wid*QBLK)*QP+h*D;
  const bf16*Kh=K+rowbase*KP+(h/GQ)*D,*Vh=V+rowbase*KP+(h/GQ)*D;
  const unsigned lds0=(unsigned)(uintptr_t)shm;
  float*wsf=(float*)(shm+LDS_WS)+wid*64;
  const bf16*ksrc=Kh+(long)lane*KP+wid*8;
  const bf16*vsrc=Vh+(long)(16*(wid&3)+(lane>>2))*KP+(wid>>2)*32+(lane&3)*8;
  const unsigned kdst=lds0+LDS_K+wid*1024, vdst=lds0+LDS_V+wid*1024;
  #define DMA_K(t,slot) glds16(ksrc+(long)(t)*KVBLK*KP,(unsigned)__builtin_amdgcn_readfirstlane(kdst+(slot)))
  #define DMA_V(t,slot) glds16(vsrc+(long)(t)*KVBLK*KP,(unsigned)__builtin_amdgcn_readfirstlane(vdst+(slot)))
  const int vb0=(int)(lds0+LDS_V)+((lane>>4)&1)*32+(lane&3)*8+(4*hi+((lane&15)>>2))*64;
  const char*Kbase=shm+LDS_K; bf16x8 kf[8];
  const lds_cptr shm3=(lds_cptr)shm; const lds_cptr kp0=shm3+LDS_K+hi*1024+r32*16; const lds_cptr vp0=shm3+LDS_V+((lane>>4)&1)*32+(lane&3)*8+(4*hi+((lane&15)>>2))*64;
  const int NT=SEQ/KVBLK;
  DMA_K(0,0);DMA_V(0,0);DMA_K(1,SLOTB);
  bf16x8 qr[4];
  #pragma unroll
  for(int d0=0;d0<4;++d0)qr[d0]=*reinterpret_cast<const bf16x8*>(&Qw[(long)r32*QP+d0*16+hi*8]);
  float mhat=0.f,l_reg=0.f;f32x16 o[2];o[0]=f32x16{};o[1]=f32x16{};f32x16 negm=f32x16{};asm volatile("":"+v"(negm));
  const int qrel=wid*QBLK+r32;
  #define CMASK(P0,P1,t) do{}while(0)
  bool resc=false;
  #define START(P0,P1) do{ const float rm=rowmax(P0,P1); resc=false; \
    { const float dl=rm; mhat=fadd_s(mhat,dl); \
      _Pragma("unroll") for(int r=0;r<16;++r){P0[r]=fsub_s(P0[r],dl);P1[r]=fsub_s(P1[r],dl);} \
      _Pragma("unroll") for(int r=0;r<16;++r)negm[r]=-mhat; asm volatile("":"+v"(negm)); } \
    _Pragma("unroll") for(int r=0;r<16;++r)P0[r]=__builtin_amdgcn_exp2f(P0[r]); }while(0)
  #define RESC() do{ if(resc){ asm volatile("s_waitcnt lgkmcnt(0)":::"memory"); \
      _Pragma("unroll") for(int d_=0;d_<2;++d_) _Pragma("unroll") for(int r=0;r<16;++r)o[d_][r]*=wsf[crow(r,hi)]; } }while(0)
  f32x16 pA0,pA1,pB0,pB1;
  int sl_prev=0,sl_cur=0,sl_next=SLOTB;
  #define ROT() do{sl_prev=sl_cur;sl_cur=sl_next;sl_next=(sl_next==(NSLOT-1)*SLOTB)?0:sl_next+SLOTB;}while(0)
  DMA_K(2,2*SLOTB);
  WAIT_BAR(3);
  qkt(pA0,pA1,Kbase,qr,negm,r32,hi);asm volatile("s_nop 15\n\ts_nop 7":"+v"(pA0),"+v"(pA1));CMASK(pA0,pA1,0);
  START(pA0,pA1);
  _Pragma("unroll") for(int r=0;r<16;++r)pA1[r]=__builtin_amdgcn_exp2f(pA1[r]);
  WAIT_BAR(0);
  DMA_K(3,0);DMA_V(1,SLOTB);
  ROT();
  kload8(kf,kp0+sl_cur);
  WAIT_BAR(2);
  s16x4 vlo[8],vhi[8]; u32x4 pw0,pw1,pw2,pw3;
  #define PKW(P,B) cvtpk_s(P[B],P[B+1])
  #define PAF(k) __builtin_bit_cast(bf16x8,pw##k)
  #define VFR(i) (bf16x8){vlo[i][0],vlo[i][1],vlo[i][2],vlo[i][3],vhi[i][0],vhi[i][1],vhi[i][2],vhi[i][3]}
  #define PIN(x) asm volatile("":"+v"(x))
  #define MX3(a,b,c) __builtin_fmaxf(__builtin_fmaxf((a),(b)),(c))
  #define GAPA(MF,A0,A1,A2,A3,W0,W1,PW) do{ MF; sacc+=A0; sacc+=A1; sacc+=A2; sacc+=A3; PIN(sacc); W0; W1; PIN(PW); SBAR(); }while(0)
  #define EX(v) __builtin_amdgcn_exp2f(v)
  #define GAPB(MF,X,B) do{ MF; X[B]=EX(X[B]); X[B+1]=EX(X[B+1]); X[B+2]=EX(X[B+2]); X[B+3]=EX(X[B+3]); PIN(X); SBAR(); }while(0)
  #define VRD(i) do{ vlo[i]=vtr(vp_+(((i)>>2)*4096+((i)&3)*1024)); vhi[i]=vtr(vp_+(((i)>>2)*4096+((i)&3)*1024+512)); }while(0)
  #define KRD(G,j) do{ if(G){ kload2(kf,kp0+sl_next,j); SBAR(); } }while(0)
  #define STEP(C0,C1,P0,P1,t,GK,GV,GL) do{ SBAR(); \
    const lds_cptr vp_=vp0+sl_prev; \
    VRD(0); SBAR(); float sacc=(P0[0]+P0[1]); \
    GAPA(C0=__builtin_amdgcn_mfma_f32_32x32x16_bf16(kf[0],qr[0],negm,0,0,0), P0[2],P0[3],P0[4],P0[5],     pw0[0]=PKW(P0,0), pw0[1]=PKW(P0,2), pw0); \
    VRD(4); SBAR(); GAPA(C1=__builtin_amdgcn_mfma_f32_32x32x16_bf16(kf[1],qr[0],negm,0,0,0), P0[6],P0[7],P0[8],P0[9],     pw0[2]=PKW(P0,4), pw0[3]=PKW(P0,6), pw0); \
    VRD(1); SBAR(); GAPA(C0=__builtin_amdgcn_mfma_f32_32x32x16_bf16(kf[2],qr[1],C0,0,0,0),   P0[10],P0[11],P0[12],P0[13], pw1[0]=PKW(P0,8), pw1[1]=PKW(P0,10), pw1); \
    VRD(5); SBAR(); GAPA(C1=__builtin_amdgcn_mfma_f32_32x32x16_bf16(kf[3],qr[1],C1,0,0,0),   P0[14],P0[15],P1[0],P1[1],   pw1[2]=PKW(P0,12),pw1[3]=PKW(P0,14), pw1); \
    VRD(2); SBAR(); GAPA(C0=__builtin_amdgcn_mfma_f32_32x32x16_bf16(kf[4],qr[2],C0,0,0,0),   P1[2],P1[3],P1[4],P1[5],     pw2[0]=PKW(P1,0), pw2[1]=PKW(P1,2), pw2); \
    VRD(6); SBAR(); GAPA(C1=__builtin_amdgcn_mfma_f32_32x32x16_bf16(kf[5],qr[2],C1,0,0,0),   P1[6],P1[7],P1[8],P1[9],     pw2[2]=PKW(P1,4), pw2[3]=PKW(P1,6), pw2); \
    VRD(3); SBAR(); GAPA(C0=__builtin_amdgcn_mfma_f32_32x32x16_bf16(kf[6],qr[3],C0,0,0,0),   P1[10],P1[11],P1[12],P1[13], pw3[0]=PKW(P1,8), pw3[1]=PKW(P1,10), pw3); \
    VRD(7); SBAR(); GAPA(C1=__builtin_amdgcn_mfma_f32_32x32x16_bf16(kf[7],qr[3],C1,0,0,0),   P1[14],P1[15],0.f,0.f,       pw3[2]=PKW(P1,12),pw3[3]=PKW(P1,14), pw3); \
    l_reg+=sacc; \
    if(GK){DMA_K((t)+3,sl_cur);} if(GV){DMA_V((t)+1,sl_next);} \
    CMASK(C0,C1,t); \
    { float a=MX3(C0[0],C0[1],C1[0]),b=MX3(C0[2],C0[3],C1[1]); a=MX3(a,C1[2],C1[3]); \
      _Pragma("unroll") for(int r=4;r<16;r+=4){a=MX3(a,C0[r],C0[r+1]);b=MX3(b,C0[r+2],C0[r+3]);a=MX3(a,C1[r],C1[r+1]);b=MX3(b,C1[r+2],C1[r+3]);} \
      float rm=__builtin_fmaxf(a,b); { auto rr=__builtin_amdgcn_permlane32_swap(__float_as_uint(rm),__float_as_uint(rm),false,false); rm=__builtin_fmaxf(__uint_as_float(rr[0]),__uint_as_float(rr[1])); } \
      resc=false; \
      if(__builtin_expect(__any(rm>(float)THRL),0)){ const float dl=__builtin_fmaxf(rm,0.f); mhat+=dl; \
        _Pragma("unroll") for(int r=0;r<16;++r){C0[r]-=dl;C1[r]-=dl;} \
        _Pragma("unroll") for(int r=0;r<16;++r)negm[r]=-mhat; asm volatile("":"+v"(negm)); \
        const float f=__builtin_amdgcn_exp2f(-dl); l_reg*=f; if(hi==0)wsf[r32]=f; resc=true; } } \
    SBAR(); \
    GAPB(o[0]=__builtin_amdgcn_mfma_f32_32x32x16_bf16(PAF(0),VFR(0),o[0],0,0,0), C0,0); \
    GAPB(o[1]=__builtin_amdgcn_mfma_f32_32x32x16_bf16(PAF(0),VFR(4),o[1],0,0,0), C0,4); \
    KRD(GL,0); GAPB(o[0]=__builtin_amdgcn_mfma_f32_32x32x16_bf16(PAF(1),VFR(1),o[0],0,0,0), C0,8); \
    KRD(GL,1); GAPB(o[1]=__builtin_amdgcn_mfma_f32_32x32x16_bf16(PAF(1),VFR(5),o[1],0,0,0), C0,12); \
    KRD(GL,2); GAPB(o[0]=__builtin_amdgcn_mfma_f32_32x32x16_bf16(PAF(2),VFR(2),o[0],0,0,0), C1,0); \
    KRD(GL,3); GAPB(o[1]=__builtin_amdgcn_mfma_f32_32x32x16_bf16(PAF(2),VFR(6),o[1],0,0,0), C1,4); \
    GAPB(o[0]=__builtin_amdgcn_mfma_f32_32x32x16_bf16(PAF(3),VFR(3),o[0],0,0,0), C1,8); \
    GAPB(o[1]=__builtin_amdgcn_mfma_f32_32x32x16_bf16(PAF(3),VFR(7),o[1],0,0,0), C1,12); \
    }while(0)
  int t=1;
  #undef CMASK
  #define CMASK(P0,P1,t) do{}while(0)
  for(;t+5<NT;t+=2){
    STEP(pB0,pB1,pA0,pA1,t,true,true,true);     WAIT_BAR(2); RESC(); ROT();
    STEP(pA0,pA1,pB0,pB1,t+1,true,true,true);   WAIT_BAR(2); RESC(); ROT();
  }
  #undef CMASK
  #define CMASK(P0,P1,t) do{}while(0)
  #define ENDW(tt) do{ if((tt)+3<NT){WAIT_BAR(2);} else if((tt)+2<NT){WAIT_BAR(1);} else {WAIT_BAR(0);} }while(0)
  for(;t+1<NT;t+=2){
    STEP(pB0,pB1,pA0,pA1,t,(t+3<NT),(t+1<NT),(t+1<NT));       ENDW(t);   RESC(); ROT();
    STEP(pA0,pA1,pB0,pB1,t+1,(t+4<NT),(t+2<NT),(t+2<NT));     ENDW(t+1); RESC(); ROT();
  }
  STEP(pB0,pB1,pA0,pA1,NT-1,false,false,false); RESC();
  { float sacc=pB0[0]+pB0[1]; _Pragma("unroll") for(int r=2;r<16;++r)sacc+=pB0[r]; _Pragma("unroll") for(int r=0;r<16;++r)sacc+=pB1[r]; l_reg+=sacc;
    pw0=(u32x4){PKW(pB0,0),PKW(pB0,2),PKW(pB0,4),PKW(pB0,6)};pw1=(u32x4){PKW(pB0,8),PKW(pB0,10),PKW(pB0,12),PKW(pB0,14)};pw2=(u32x4){PKW(pB1,0),PKW(pB1,2),PKW(pB1,4),PKW(pB1,6)};pw3=(u32x4){PKW(pB1,8),PKW(pB1,10),PKW(pB1,12),PKW(pB1,14)};
    SBAR(); pv(o,vb0+sl_cur,PAF(0),PAF(1),PAF(2),PAF(3)); }
  #undef PKW
  #undef PAF
  #undef VFR
  #undef PIN
  #undef MX3
  #undef GAPA
  #undef GAPB
  #undef EX
  #undef VRD
  #undef KRD
  #undef STEP
  #undef ENDW
  {auto rr=__builtin_amdgcn_permlane32_swap(__float_as_uint(l_reg),__float_as_uint(l_reg),false,false);l_reg=__uint_as_float(rr[0])+__uint_as_float(rr[1]);}
  if(hi==0)wsf[32+r32]=l_reg;asm volatile("s_waitcnt lgkmcnt(0)":::"memory");
  float rli[16];
  #pragma unroll
  for(int r=0;r<16;++r)rli[r]=__builtin_amdgcn_rcpf(wsf[32+crow(r,hi)]);
  bf16*Ow=O+(rowbase+q0+wid*QBLK)*OP+h*D;
  { bf16*stg=(bf16*)(shm+LDS_OST)+wid*2048;
    #pragma unroll
    for(int r=0;r<16;++r){const int orow=crow(r,hi);
      #pragma unroll
      for(int d0=0;d0<2;++d0)stg[orow*64+d0*32+r32]=__float2bfloat16(o[d0][r]*rli[r]);}
    asm volatile("s_waitcnt lgkmcnt(0)":::"memory");
    #pragma unroll
    for(int i=0;i<4;++i){const int row=i*8+(lane>>3),ch=lane&7; const u32x4 v=*(const u32x4*)(stg+row*64+ch*8); ATTN_STORE16(Ow+(long)row*OP+ch*8,v);} }
  asm volatile("s_waitcnt lgkmcnt(0)\n\ts_barrier":::"memory");
  #undef DMA_K
  #undef DMA_V
  #undef CMASK
  #undef START
  #undef RESC
  #undef ROT
}
constexpr int ATTN_LDS_BYTES=LDS_BYTES;
struct AttnTensors { const bf16* Q; const bf16* K; const bf16* V; bf16* O; };
struct AttnUnit { int bh; int qb; };
struct StaticOrder {
  int vcu,G;
  __device__ __forceinline__ explicit StaticOrder(int grid,int block):vcu((grid%8==0)?(block%8)*(grid/8)+block/8:block),G(grid){}
  __device__ __forceinline__ bool next(int i,AttnUnit&u)const{ const int U=vcu+G*i; if(U>=BATCH*NHEAD*NQB)return false; u.bh=U/NQB; u.qb=U%NQB; return true; }
  __device__ __forceinline__ void a_ready(const AttnUnit&)const{}
  __device__ __forceinline__ void done(const AttnUnit&)const{}
};
template<class Sched,int THRL=8> __device__ __forceinline__ void attn_phase(char*lds,const AttnTensors&T,const Sched&S){
  AttnUnit u;
  for(int i=0;S.next(i,u);++i){ S.a_ready(u); attn_unit<THRL>(u.bh/NHEAD,u.bh%NHEAD,u.qb,T.Q,T.K,T.V,T.O,lds); S.done(u); }
}
#undef SBAR
#undef WAIT_BAR
}
namespace cg = cooperative_groups;
#define LAS __attribute__((address_space(3)))
typedef unsigned short bf16;
typedef float f32x4 __attribute__((ext_vector_type(4)));
typedef float f32x16 __attribute__((ext_vector_type(16)));
typedef short bf16x8 __attribute__((ext_vector_type(8)));
typedef short s16x4 __attribute__((ext_vector_type(4)));
typedef unsigned v4u __attribute__((ext_vector_type(4)));
typedef unsigned v2u __attribute__((ext_vector_type(2)));

constexpr int NB = 8, SEQ = 8192, DM = 1024, M = NB * SEQ, NPROJ = 2816, NPAD = 3072, FF = 2816, NWAVES = 8;
constexpr float EPS = 1e-6f;
constexpr size_t MiB = 1u << 20;
constexpr size_t WS_SS = 0;
constexpr size_t WS_BA = 1 * MiB;
constexpr size_t WS_EG = 5 * MiB;
constexpr size_t WS_WIN = 10 * MiB, WS_WOUT = 16 * MiB, WS_WGU = 18 * MiB, WS_WDN = 30 * MiB, WS_WPG = 36 * MiB, WS_WPL = 38 * MiB;
constexpr size_t WS_PB = 48 * MiB;
constexpr size_t WS_B = 80 * MiB;
constexpr size_t WS_C = 208 * MiB;
constexpr size_t WS_W = WS_C, WS_UT = WS_C + 128 * MiB, WS_QKM = WS_C + 256 * MiB;
constexpr size_t WS_D = 560 * MiB;
constexpr size_t WS_QA = WS_D, WS_KA = WS_D + 64 * MiB, WS_VA = WS_D + 80 * MiB, WS_DQ = WS_D + 96 * MiB, WS_DK = WS_D + 160 * MiB, WS_KT = WS_D + 224 * MiB, WS_VT = WS_D + 288 * MiB, WS_Z = WS_D + 352 * MiB;
constexpr size_t WS_OF = WS_QA, WS_OB = WS_DK, WS_HB1 = WS_D;
constexpr size_t WS_END = 1024 * MiB;
static_assert(WS_Z + 64 * MiB <= WS_END, "ws map");
constexpr int LDS_BYTES = 147456;
constexpr int SAP = 68;

struct Args { const float* in[19]; float* out; unsigned char* ws; int ph_lo, ph_hi; };

struct Frame {
    LAS unsigned char* lds; int tid, lane, wave, vcu, G;
    const float *x, *p, *norm_mix, *w_in, *conv_w, *q_norm, *k_norm, *a_log, *dt_bias, *dn_norm, *w_out, *norm_ffn, *w_gate, *w_up, *w_down, *norm_ple, *w_ple_gate, *w_ple, *norm_final;
    float* out; float *SS, *BA, *EG;
    bf16 *Wt_in, *Wt_out, *Wt_gu, *Wt_dn, *Wt_pg, *Wt_pl, *PB, *XN, *MIXED, *HB2, *PROJ, *W, *UT, *QKM, *ACT, *PE, *QA, *KA, *VA, *DQ, *DK, *KT, *VT, *Z, *OF, *OB, *HB1;
};
#define LDS_FENCE() asm volatile("s_waitcnt lgkmcnt(0)" ::: "memory")
__device__ __forceinline__ unsigned pk2(float lo, float hi) { return attn_body::cvtpk_s(lo, hi); }
__device__ __forceinline__ float bflo(unsigned w) { return __uint_as_float(w << 16); }
__device__ __forceinline__ float bfhi(unsigned w) { return __uint_as_float(w & 0xffff0000u); }
__device__ __forceinline__ float bf2f(short s) { return __uint_as_float(((unsigned)(unsigned short)s) << 16); }
__device__ __forceinline__ bf16 f2bf(float f) { return (bf16)(pk2(f, 0.f) & 0xffffu); }
__device__ __forceinline__ float wave_sum(float v) {
#pragma unroll
    for (int o = 1; o < 64; o <<= 1) v += __shfl_xor(v, o);
    return v;
}
__device__ __forceinline__ int crow(int r, int hi) { return (r & 3) + 8 * (r >> 2) + 4 * hi; }
__device__ __forceinline__ float fast_sig(float v) { return __builtin_amdgcn_rcpf(1.f + __expf(-v)); }
#define MFMA32(a, b, c) __builtin_amdgcn_mfma_f32_32x32x16_bf16((a), (b), (c), 0, 0, 0)

__device__ __forceinline__ void p0_transpose_item(const float* W, int ldw, int K, int ncols, int nvalid, bf16* WT, int rb, int rstride, int roff, const float* gain, LAS float* scr, int item, int lane) {
    const int nblk = ncols / 32, kb = item / nblk, nb = item % nblk, k0 = 64 * kb, n0 = 32 * nb;
#pragma unroll 8
    for (int i = 0; i < 32; ++i) { const int kk = 2 * i + (lane >> 5), n = n0 + (lane & 31);
        float v = (n < nvalid) ? W[(size_t)(k0 + kk) * ldw + n] : 0.f; if (gain) v *= gain[k0 + kk]; scr[kk * 33 + (lane & 31)] = v; }
    LDS_FENCE();
    const int c = lane & 7;
#pragma unroll
    for (int j = 0; j < 4; ++j) { const int nl = (lane >> 3) + 8 * j, n = n0 + nl; const LAS float* s = scr + (8 * c) * 33 + nl;
        v4u o; o.x = pk2(s[0 * 33], s[1 * 33]); o.y = pk2(s[2 * 33], s[3 * 33]); o.z = pk2(s[4 * 33], s[5 * 33]); o.w = pk2(s[6 * 33], s[7 * 33]);
        const int drow = (n / rb) * rstride + roff + (n % rb);
        *(v4u*)(WT + (size_t)drow * K + k0 + 8 * c) = o; }
    LDS_FENCE();
}
__device__ __forceinline__ void p0_prologue(Frame& F) {
    LAS float* scr = (LAS float*)(F.lds + F.wave * 16384);
    const int gw = F.vcu * NWAVES + F.wave, NGW = F.G * NWAVES;
    constexpr int I_IN = 16 * (NPAD / 32), I_OUT = 16 * 32, I_G = 16 * (FF / 32), I_DN = (FF / 64) * 32, I_PG = 16 * 32, I_PL = 4 * 32;
    constexpr int NITEMS = I_IN + I_OUT + 2 * I_G + I_DN + I_PG + I_PL;
    constexpr int BIG = 1 << 30;
    for (int it = gw; it < NITEMS; it += NGW) {
        int r = it;
        if (r < I_IN) { p0_transpose_item(F.w_in, 2832, 1024, NPAD, 2832, F.Wt_in, BIG, 0, 0, nullptr, scr, r, F.lane); continue; } r -= I_IN;
        if (r < I_OUT) { p0_transpose_item(F.w_out, 1024, 1024, 1024, 1024, F.Wt_out, BIG, 0, 0, nullptr, scr, r, F.lane); continue; } r -= I_OUT;
        if (r < I_G) { p0_transpose_item(F.w_gate, FF, 1024, FF, FF, F.Wt_gu, 128, 256, 0, F.norm_ffn, scr, r, F.lane); continue; } r -= I_G;
        if (r < I_G) { p0_transpose_item(F.w_up, FF, 1024, FF, FF, F.Wt_gu, 128, 256, 128, F.norm_ffn, scr, r, F.lane); continue; } r -= I_G;
        if (r < I_DN) { p0_transpose_item(F.w_down, 1024, FF, 1024, 1024, F.Wt_dn, BIG, 0, 0, nullptr, scr, r, F.lane); continue; } r -= I_DN;
        if (r < I_PG) { p0_transpose_item(F.w_ple_gate, 1024, 1024, 1024, 1024, F.Wt_pg, BIG, 0, 0, F.norm_ple, scr, r, F.lane); continue; } r -= I_PG;
        p0_transpose_item(F.w_ple, 1024, 256, 1024, 1024, F.Wt_pl, BIG, 0, 0, nullptr, scr, r, F.lane);
    }
    f32x4 gn[4];
#pragma unroll
    for (int j = 0; j < 4; ++j) gn[j] = ((const f32x4*)F.norm_mix)[F.lane + 64 * j];
    for (int m = gw; m < M; m += NGW) {
        const f32x4* xr = (const f32x4*)(F.x + (size_t)m * DM) + F.lane; f32x4 v[4]; float s = 0.f;
#pragma unroll
        for (int j = 0; j < 4; ++j) { v[j] = xr[64 * j]; s += (v[j].x * v[j].x + v[j].y * v[j].y) + (v[j].z * v[j].z + v[j].w * v[j].w); }
        const float rstd = rsqrtf(wave_sum(s) * (1.f / DM) + EPS);
        v2u* o8 = (v2u*)(F.XN + (size_t)m * DM) + F.lane;
#pragma unroll
        for (int j = 0; j < 4; ++j) { const f32x4 y = v[j] * rstd * gn[j]; v2u w; w.x = pk2(y.x, y.y); w.y = pk2(y.z, y.w); o8[64 * j] = w; }
    }
    const size_t gt = (size_t)F.vcu * 512 + F.tid, NGT = (size_t)F.G * 512;
    for (size_t i = gt; i < (size_t)M * 256 / 4; i += NGT) { const f32x4 v = ((const f32x4*)F.p)[i]; v2u w; w.x = pk2(v.x, v.y); w.y = pk2(v.z, v.w); ((v2u*)F.PB)[i] = w; }
    for (size_t i = gt; i < (size_t)3 * M; i += NGT) F.SS[i] = 0.f;
}

constexpr int P2_TAB_BYTES = 192 * 16 * 8;
__device__ __forceinline__ void p2_rope_table(Frame& F) {
    LAS float* tab = (LAS float*)F.lds;
    for (int i = F.tid; i < 192 * 16; i += NWAVES * 64) { const int pos = i >> 4, j = i & 15; const float inv = powf(10000.0f, -(float)j * (1.f / 16.f));
        float s, c; sincosf((float)(pos < 128 ? pos : pos - 128) * inv, &s, &c); tab[2 * i] = c; tab[2 * i + 1] = s; }
    LDS_FENCE(); __syncthreads();
}
__device__ __forceinline__ void p2_attn_rows(Frame& F) {
    const int gw = F.vcu * NWAVES + F.wave, NGW = F.G * NWAVES, lane = F.lane;
    constexpr float C2 = 0.125f * 1.4426950408889634f;
    const LAS float* tab = (const LAS float*)F.lds;
    const bf16* __restrict__ PROJ = F.PROJ; bf16* __restrict__ QA = F.QA; bf16* __restrict__ KA = F.KA; bf16* __restrict__ VA = F.VA; bf16* __restrict__ Z = F.Z;
    float gq[4], gk[4];
#pragma unroll
    for (int k = 0; k < 4; ++k) { gq[k] = F.q_norm[(lane & 15) + 16 * k]; gk[k] = F.k_norm[(lane & 15) + 16 * k]; }
    for (int m0 = gw * 2; m0 < M; m0 += NGW * 2) {
        bf16 xr[2][3][4]; unsigned vv[2]; v4u zz[2];
#pragma unroll
        for (int rr = 0; rr < 2; ++rr) { const bf16* pr = PROJ + (size_t)(m0 + rr) * NPROJ;
#pragma unroll
            for (int it = 0; it < 3; ++it) { const int idx = it * 64 + lane, head = idx >> 4, j = idx & 15;
                if (head < 10) { const bf16* hp = pr + head * 64 + j;
#pragma unroll
                    for (int k = 0; k < 4; ++k) xr[rr][it][k] = hp[16 * k]; } }
            vv[rr] = ((const unsigned*)(pr + 640))[lane]; zz[rr] = ((const v4u*)(pr + 2304))[lane]; }
#pragma unroll
        for (int rr = 0; rr < 2; ++rr) { const int m = m0 + rr, s = m & (SEQ - 1), prow = s >> 6, pcol = 128 + (s & 63);
#pragma unroll
            for (int it = 0; it < 3; ++it) { const int idx = it * 64 + lane, head = idx >> 4, j = idx & 15;
                if (head < 10) {
                    float x0 = __uint_as_float((unsigned)xr[rr][it][0] << 16), x1 = __uint_as_float((unsigned)xr[rr][it][1] << 16), x2 = __uint_as_float((unsigned)xr[rr][it][2] << 16), x3 = __uint_as_float((unsigned)xr[rr][it][3] << 16);
                    float ss = (x0 * x0 + x1 * x1) + (x2 * x2 + x3 * x3);
                    ss += __shfl_xor(ss, 1); ss += __shfl_xor(ss, 2); ss += __shfl_xor(ss, 4); ss += __shfl_xor(ss, 8);
                    const float rs = rsqrtf(ss * (1.f / 64.f) + EPS); const bool isq = head < 8;
                    x0 *= rs * (isq ? gq[0] : gk[0]); x1 *= rs * (isq ? gq[1] : gk[1]); x2 *= rs * (isq ? gq[2] : gk[2]); x3 *= rs * (isq ? gq[3] : gk[3]);
                    const float cr = tab[(prow * 16 + j) * 2], sr = tab[(prow * 16 + j) * 2 + 1], cc = tab[(pcol * 16 + j) * 2], sc = tab[(pcol * 16 + j) * 2 + 1];
                    float o0 = x0 * cr - x1 * sr, o1 = x1 * cr + x0 * sr, o2 = x2 * cc - x3 * sc, o3 = x3 * cc + x2 * sc;
                    bf16* op;
                    if (isq) { o0 *= C2; o1 *= C2; o2 *= C2; o3 *= C2; op = QA + (size_t)m * 512 + head * 64 + j; } else op = KA + (size_t)m * 128 + (head - 8) * 64 + j;
                    op[0] = f2bf(o0); op[16] = f2bf(o1); op[32] = f2bf(o2); op[48] = f2bf(o3);
                } }
            ((unsigned*)(VA + (size_t)m * 128))[lane] = vv[rr]; ((v4u*)(Z + (size_t)m * 512))[lane] = zz[rr]; }
    }
}
struct ConvIn { unsigned u[12]; float w0[5], w1[5]; };
__device__ __forceinline__ void p2_conv_load(Frame& F, int item, ConvIn& C, int lane, int wid) {
    const int type = item % 3, h4 = (item / 3) & 3, n = (item / 12) & 127, b = item / (12 * 128); const int ch = type * 512 + h4 * 128 + 2 * lane;
    const bf16* src = F.PROJ + (size_t)b * SEQ * NPROJ + 768 + ch; const int s0 = n * 64 + 8 * wid - 2;
#pragma unroll
    for (int k = 0; k < 12; ++k) { const int s = s0 + k; C.u[k] = (s >= 0 && s < SEQ) ? *(const unsigned*)(src + (size_t)s * NPROJ) : 0u; }
#pragma unroll
    for (int j = 0; j < 5; ++j) { C.w0[j] = F.conv_w[j * 1536 + ch]; C.w1[j] = F.conv_w[j * 1536 + ch + 1]; }
}
__device__ __forceinline__ void p2_dn_conv(Frame& F) {
    LAS bf16* tl = (LAS bf16*)(F.lds + P2_TAB_BYTES);
    const int lane = F.lane, wid = F.wave; constexpr int NIT = NB * 128 * 12;
    ConvIn C, Cn; int item = F.vcu; if (item < NIT) p2_conv_load(F, item, C, lane, wid);
    for (; item < NIT; item += F.G) {
        const int type = item % 3, h4 = (item / 3) & 3, n = (item / 12) & 127, b = item / (12 * 128);
        if (item + F.G < NIT) p2_conv_load(F, item + F.G, Cn, lane, wid);
#pragma unroll
        for (int i = 0; i < 8; ++i) { const int tl_ = 8 * wid + i, s = n * 64 + tl_; float a0 = 0.f, a1 = 0.f;
#pragma unroll
            for (int j = 0; j < 5; ++j) { a0 += C.w0[j] * bflo(C.u[i + j]); a1 += C.w1[j] * bfhi(C.u[i + j]); }
            a0 = a0 * fast_sig(a0); a1 = a1 * fast_sig(a1);
            if (type < 2) { const float ss = wave_sum(a0 * a0 + a1 * a1); float rs = rsqrtf(ss + EPS); if (type == 0) rs *= 0.08838834764831845f; a0 *= rs; a1 *= rs; }
            const size_t row = (size_t)b * SEQ + s;
            if (type == 0) *(unsigned*)(F.DQ + row * 512 + h4 * 128 + 2 * lane) = pk2(a0, a1);
            else { if (type == 1) *(unsigned*)(F.DK + row * 512 + h4 * 128 + 2 * lane) = pk2(a0, a1);
                   tl[(2 * lane) * 66 + tl_] = f2bf(a0); tl[(2 * lane + 1) * 66 + tl_] = f2bf(a1); }
        }
        if (type != 0) {
            LDS_FENCE(); __builtin_amdgcn_s_barrier(); asm volatile("" ::: "memory");
            bf16* dst = (type == 1 ? F.KT : F.VT) + ((size_t)(b * 4 + h4) * 128 + n) * 8192;
            const int d = F.tid >> 2, c = F.tid & 3; const LAS unsigned* sp = (const LAS unsigned*)(tl + d * 66 + 16 * c);
            v4u o0, o1; o0.x = sp[0]; o0.y = sp[1]; o0.z = sp[2]; o0.w = sp[3]; o1.x = sp[4]; o1.y = sp[5]; o1.z = sp[6]; o1.w = sp[7];
            *(v4u*)(dst + d * 64 + 16 * c) = o0; *(v4u*)(dst + d * 64 + 16 * c + 8) = o1;
            LDS_FENCE(); __builtin_amdgcn_s_barrier(); asm volatile("" ::: "memory");
        }
        C = Cn;
    }
}
__device__ __forceinline__ bf16x8 ld8(const bf16* p) { return *(const bf16x8*)p; }
__device__ __forceinline__ bf16x8 ld44(const bf16* p) { const s16x4 a = *(const s16x4*)p, b = *(const s16x4*)(p + 8); return (bf16x8){a[0], a[1], a[2], a[3], b[0], b[1], b[2], b[3]}; }
__device__ __forceinline__ bf16x8 pack8(float a0, float a1, float a2, float a3, float a4, float a5, float a6, float a7) {
    v4u w; w.x = pk2(a0, a1); w.y = pk2(a2, a3); w.z = pk2(a4, a5); w.w = pk2(a6, a7); return __builtin_bit_cast(bf16x8, w); }
__device__ __forceinline__ void dn_prep_item(Frame& F, int item, LAS float* SA, LAS float* sv, int lane) {
    const int n = item & 127, h8 = (item >> 7) & 7, b = item >> 10, dir = h8 >> 2, h4 = h8 & 3;
    const size_t tok0 = (size_t)b * SEQ + n * 64; const int r32 = lane & 31, hi = lane >> 5;
    { const float* ba = F.BA + (tok0 + lane) * 16; const float braw = ba[h8], araw = ba[8 + h8];
      const float beta = 1.f / (1.f + __expf(-braw)); const float xx = araw + F.dt_bias[h8];
      const float sp = fmaxf(xx, 0.f) + log1pf(__expf(-fabsf(xx))); const float g = -__expf(F.a_log[h8]) * sp;
      float gc = dir ? __shfl(g, 63 - lane) : g;
#pragma unroll
      for (int o = 1; o < 64; o <<= 1) { const float t = __shfl_up(gc, o); if (lane >= o) gc += t; }
      const float Gtot = __shfl(gc, 63); const float G = dir ? __shfl(gc, 63 - lane) : gc; const float eg = __expf(G);
      sv[lane] = G; sv[64 + lane] = beta; sv[128 + lane] = beta * eg;
      F.EG[(size_t)item * 128 + lane] = eg; F.EG[(size_t)item * 128 + 64 + lane] = __expf(Gtot - G); }
    LDS_FENCE();
#ifndef PREP_NO_GRAM
    const bf16* Kp = F.DK + tok0 * 512 + h4 * 128; const bf16* Qp = F.DQ + tok0 * 512 + h4 * 128;
#pragma unroll 1
    for (int tt = 0; tt < 4; ++tt) { const int ti = tt >> 1, tj = tt & 1; f32x16 acc = {}, acq = {};
        const bf16* ka = Kp + (size_t)(32 * ti + r32) * 512 + 8 * hi; const bf16* kb_ = Kp + (size_t)(32 * tj + r32) * 512 + 8 * hi; const bf16* qa = Qp + (size_t)(32 * ti + r32) * 512 + 8 * hi;
#pragma unroll
        for (int kb = 0; kb < 8; ++kb) { const bf16x8 fb = ld8(kb_ + 16 * kb); acc = MFMA32(ld8(ka + 16 * kb), fb, acc); acq = MFMA32(ld8(qa + 16 * kb), fb, acq); }
        const int j = 32 * tj + r32, cj = dir ? 63 - j : j; const float Gj = sv[j];
#pragma unroll
        for (int r = 0; r < 16; ++r) { const int i = 32 * ti + crow(r, hi), ci = dir ? 63 - i : i; const float Gi = sv[i], bi = sv[64 + i]; const float dec = __expf(fminf(Gi - Gj, 0.f));
            SA[ci * SAP + cj] = (ci > cj) ? bi * acc[r] * dec : 0.f;
            F.QKM[(size_t)item * 4096 + i * 64 + j] = f2bf((ci >= cj) ? acq[r] * dec : 0.f); }
        asm volatile("" ::: "memory"); }
#endif
    LDS_FENCE();
#ifndef PREP_NO_SOLVE
    SA[lane] = (lane == 0) ? 1.f : 0.f; LDS_FENCE();
    for (int i = 1; i < 64; ++i) { float a = (lane == i) ? 1.f : 0.f; const int nq = (i + 3) >> 2;
        for (int jq = 0; jq < nq; ++jq) { const f32x4 a4 = *(const LAS f32x4*)(SA + i * SAP + 4 * jq); const LAS float* tp = SA + (4 * jq) * SAP + lane;
            a -= a4.x * tp[0]; a -= a4.y * tp[SAP]; a -= a4.z * tp[2 * SAP]; a -= a4.w * tp[3 * SAP]; }
        LDS_FENCE();
        SA[i * SAP + lane] = a;
        LDS_FENCE(); }
#endif
#ifndef PREP_NO_UW
    const bf16* VTp = F.VT + ((size_t)(b * 4 + h4) * 128 + n) * 8192; const bf16* KTp = F.KT + ((size_t)(b * 4 + h4) * 128 + n) * 8192;
#pragma unroll 1
    for (int pass = 0; pass < 2; ++pass) {
        bf16x8 tb[2][4];
#pragma unroll
        for (int ti = 0; ti < 2; ++ti) { const int i = 32 * ti + r32, ci = dir ? 63 - i : i;
#pragma unroll
            for (int kb = 0; kb < 4; ++kb) { float a[8];
#pragma unroll
                for (int e = 0; e < 8; ++e) { const int j = 16 * kb + 8 * hi + e, cj = dir ? 63 - j : j; a[e] = SA[ci * SAP + cj] * sv[64 + 64 * pass + j]; }
                tb[ti][kb] = pack8(a[0], a[1], a[2], a[3], a[4], a[5], a[6], a[7]); asm volatile("" ::: "memory"); } }
        const bf16* src = (pass ? KTp : VTp) + r32 * 64 + 8 * hi;
#pragma unroll 1
        for (int td = 0; td < 4; ++td) { f32x16 a0 = {}, a1 = {};
            if (pass == 0) {
#pragma unroll
                for (int kb = 0; kb < 4; ++kb) { const bf16x8 vf = ld8(src + td * 2048 + 16 * kb); a0 = MFMA32(vf, tb[0][kb], a0); a1 = MFMA32(vf, tb[1][kb], a1); }
                bf16* up = F.UT + (size_t)item * 8192 + (32 * td + 4 * hi) * 64 + r32;
#pragma unroll
                for (int r = 0; r < 16; ++r) { const int dv = (r & 3) + 8 * (r >> 2); up[dv * 64] = f2bf(a0[r]); up[dv * 64 + 32] = f2bf(a1[r]); }
            } else {
#pragma unroll
                for (int kb = 0; kb < 4; ++kb) { const bf16x8 kt = ld8(src + td * 2048 + 16 * kb); a0 = MFMA32(tb[0][kb], kt, a0); a1 = MFMA32(tb[1][kb], kt, a1); }
                bf16* wp = F.W + (size_t)item * 8192 + (4 * hi) * 128 + 32 * td + r32;
#pragma unroll
                for (int r = 0; r < 16; ++r) { const int i = (r & 3) + 8 * (r >> 2); wp[i * 128] = f2bf(a0[r]); wp[(32 + i) * 128] = f2bf(a1[r]); }
            }
            asm volatile("" ::: "memory"); }
    }
#endif
    LDS_FENCE();
}
constexpr int SC_W = 0, SC_Q = 16896, SC_KT = 33792, SC_QK = 51200, SC_EG = 59904, SC_BUF = 60416, SC_PW = 264, SC_PK = 136;
#define SC_BAR() asm volatile("s_waitcnt lgkmcnt(0)\n\ts_barrier" ::: "memory")
__device__ __forceinline__ bf16x8 lds44(const LAS unsigned char* p) { const s16x4 a = *(const LAS s16x4*)p, b = *(const LAS s16x4*)(p + 16); return (bf16x8){a[0], a[1], a[2], a[3], b[0], b[1], b[2], b[3]}; }
__device__ __forceinline__ void lds_put16(LAS unsigned char* p, v4u v) { *(LAS v2u*)p = (v2u){v.x, v.y}; *(LAS v2u*)(p + 8) = (v2u){v.z, v.w}; }
struct ScanRegs { v4u w[4], q[4], k[4], m[2], e; };
__device__ __forceinline__ void scan_load(Frame& F, ScanRegs& R, int lt, size_t it, size_t tok0, int h4, size_t ktoff) {
#pragma unroll
    for (int k = 0; k < 4; ++k) { const int c = lt + 256 * k;
        R.w[k] = *(const v4u*)(F.W + it * 8192 + c * 8);
        R.q[k] = *(const v4u*)(F.DQ + (tok0 + (c >> 4)) * 512 + h4 * 128 + (c & 15) * 8);
        R.k[k] = *(const v4u*)(F.KT + ktoff + c * 8); }
#pragma unroll
    for (int k = 0; k < 2; ++k) R.m[k] = *(const v4u*)(F.QKM + it * 4096 + (lt + 256 * k) * 8);
    if (lt < 32) R.e = *(const v4u*)(F.EG + it * 128 + lt * 4);
}
__device__ __forceinline__ void scan_put(const ScanRegs& R, LAS unsigned char* buf, int lt) {
#pragma unroll
    for (int k = 0; k < 4; ++k) { const int c = lt + 256 * k;
        lds_put16(buf + SC_W + (c >> 4) * SC_PW + (c & 15) * 16, R.w[k]); lds_put16(buf + SC_Q + (c >> 4) * SC_PW + (c & 15) * 16, R.q[k]); lds_put16(buf + SC_KT + (c >> 3) * SC_PK + (c & 7) * 16, R.k[k]); }
#pragma unroll
    for (int k = 0; k < 2; ++k) { const int c = lt + 256 * k; lds_put16(buf + SC_QK + (c >> 3) * SC_PK + (c & 7) * 16, R.m[k]); }
    if (lt < 32) lds_put16(buf + SC_EG + lt * 16, R.e);
}
__device__ __forceinline__ void dn_scan_wg(Frame& F, int bh8) {
    const int h8 = bh8 & 7, b = bh8 >> 3, dir = h8 >> 2, h4 = h8 & 3; const int lane = F.lane, r32 = lane & 31, hi = lane >> 5, wid = F.wave;
#define SC_N(s) (dir ? 127 - (s) : (s))
#define SC_IT(s) ((size_t)bh8 * 128 + SC_N(s))
#define SC_TOK(s) ((size_t)b * SEQ + SC_N(s) * 64)
#define SC_KTO(s) (((size_t)(b * 4 + h4) * 128 + SC_N(s)) * 8192)
    if (wid >= 4) {
        const int lt = F.tid - 256; ScanRegs R;
        scan_load(F, R, lt, SC_IT(0), SC_TOK(0), h4, SC_KTO(0)); scan_put(R, F.lds, lt);
        scan_load(F, R, lt, SC_IT(1), SC_TOK(1), h4, SC_KTO(1));
        SC_BAR();
        for (int s = 0; s < 128; ++s) {
            if (s + 1 < 128) scan_put(R, F.lds + ((s + 1) & 1) * SC_BUF, lt);
            if (s + 2 < 128) scan_load(F, R, lt, SC_IT(s + 2), SC_TOK(s + 2), h4, SC_KTO(s + 2));
            SC_BAR(); }
    } else {
        const int sl = wid; f32x16 S[4];
#pragma unroll
        for (int t = 0; t < 4; ++t) S[t] = (f32x16){};
        bf16* Obase = (dir ? F.OB : F.OF) + h4 * 128 + 32 * sl + 4 * hi;
        const bf16* UTb = F.UT + (size_t)(32 * sl + r32) * 64 + 4 * hi;
        s16x4 ut[8];
#pragma unroll
        for (int q = 0; q < 8; ++q) ut[q] = *(const s16x4*)(UTb + SC_IT(0) * 8192 + 8 * q);
        SC_BAR();
        for (int s = 0; s < 128; ++s) {
            const LAS unsigned char* buf = F.lds + (s & 1) * SC_BUF; const size_t tok0 = SC_TOK(s);
            const LAS unsigned char* aW = buf + SC_W + r32 * SC_PW + 8 * hi; const LAS unsigned char* aQ = buf + SC_Q + r32 * SC_PW + 8 * hi;
            const LAS unsigned char* aK = buf + SC_KT + r32 * SC_PK + 8 * hi; const LAS unsigned char* aM = buf + SC_QK + r32 * SC_PK + 8 * hi;
            const LAS float* eg = (const LAS float*)(buf + SC_EG);
            bf16x8 Sb[8];
#pragma unroll
            for (int kb = 0; kb < 8; ++kb) { const int tk = kb >> 1, rb = 8 * (kb & 1); Sb[kb] = pack8(S[tk][rb], S[tk][rb + 1], S[tk][rb + 2], S[tk][rb + 3], S[tk][rb + 4], S[tk][rb + 5], S[tk][rb + 6], S[tk][rb + 7]); }
            f32x16 vn[2];
            { f32x16 a0 = {}, a1 = {};
#pragma unroll
              for (int kb = 0; kb < 8; ++kb) { a0 = MFMA32(lds44(aW + 32 * kb), Sb[kb], a0); a1 = MFMA32(lds44(aW + 32 * SC_PW + 32 * kb), Sb[kb], a1); }
#pragma unroll
              for (int q = 0; q < 4; ++q)
#pragma unroll
                  for (int e = 0; e < 4; ++e) { a0[4 * q + e] = bf2f(ut[q][e]) - a0[4 * q + e]; a1[4 * q + e] = bf2f(ut[4 + q][e]) - a1[4 * q + e]; }
              vn[0] = a0; vn[1] = a1; }
            if (s + 1 < 128) {
#pragma unroll
                for (int q = 0; q < 8; ++q) ut[q] = *(const s16x4*)(UTb + SC_IT(s + 1) * 8192 + 8 * q); }
            bf16x8 vb[4], vsb[4];
#pragma unroll
            for (int k2 = 0; k2 < 4; ++k2) { const int tc = k2 >> 1, rb = 8 * (k2 & 1); float l[8];
#pragma unroll
                for (int h = 0; h < 2; ++h) { const f32x4 l4 = *(const LAS f32x4*)(eg + 64 + 32 * tc + 8 * (2 * (k2 & 1) + h) + 4 * hi);
#pragma unroll
                    for (int e = 0; e < 4; ++e) l[4 * h + e] = l4[e]; }
                vb[k2] = pack8(vn[tc][rb], vn[tc][rb + 1], vn[tc][rb + 2], vn[tc][rb + 3], vn[tc][rb + 4], vn[tc][rb + 5], vn[tc][rb + 6], vn[tc][rb + 7]);
                vsb[k2] = pack8(vn[tc][rb] * l[0], vn[tc][rb + 1] * l[1], vn[tc][rb + 2] * l[2], vn[tc][rb + 3] * l[3], vn[tc][rb + 4] * l[4], vn[tc][rb + 5] * l[5], vn[tc][rb + 6] * l[6], vn[tc][rb + 7] * l[7]); }
            { f32x16 o0 = {}, o1 = {};
#pragma unroll
              for (int kb = 0; kb < 8; ++kb) { o0 = MFMA32(Sb[kb], lds44(aQ + 32 * kb), o0); o1 = MFMA32(Sb[kb], lds44(aQ + 32 * SC_PW + 32 * kb), o1); }
              o0 = o0 * eg[r32]; o1 = o1 * eg[32 + r32];
#pragma unroll
              for (int k2 = 0; k2 < 4; ++k2) { o0 = MFMA32(vb[k2], lds44(aM + 32 * k2), o0); o1 = MFMA32(vb[k2], lds44(aM + 32 * SC_PK + 32 * k2), o1); }
              bf16* op = Obase + (tok0 + r32) * 512;
#pragma unroll
              for (int q = 0; q < 4; ++q) { v2u w; w.x = pk2(o0[4 * q], o0[4 * q + 1]); w.y = pk2(o0[4 * q + 2], o0[4 * q + 3]); *(v2u*)(op + 8 * q) = w;
                  v2u w1; w1.x = pk2(o1[4 * q], o1[4 * q + 1]); w1.y = pk2(o1[4 * q + 2], o1[4 * q + 3]); *(v2u*)(op + 32 * 512 + 8 * q) = w1; } }
            const float gtot = eg[dir ? 0 : 63];
#pragma unroll
            for (int tk = 0; tk < 4; ++tk) S[tk] = S[tk] * gtot;
#pragma unroll
            for (int k2 = 0; k2 < 4; ++k2)
#pragma unroll
                for (int tk = 0; tk < 4; ++tk) S[tk] = MFMA32(lds44(aK + tk * 32 * SC_PK + 32 * k2), vsb[k2], S[tk]);
            SC_BAR();
        }
    }
#undef SC_N
#undef SC_IT
#undef SC_TOK
#undef SC_KTO
}
__device__ __forceinline__ void p5_mix(Frame& F) {
    const int gw = F.vcu * NWAVES + F.wave, NGW = F.G * NWAVES, lane = F.lane;
    const float g0 = F.dn_norm[2 * lane], g1 = F.dn_norm[2 * lane + 1];
    for (int u = gw; u < M * 4; u += NGW) { const size_t off = (size_t)(u >> 2) * 512 + (u & 3) * 128 + 2 * lane;
        const unsigned a = *(const unsigned*)(F.OF + off), c = *(const unsigned*)(F.OB + off), z = *(const unsigned*)(F.Z + off);
        const float o0 = bflo(a) + bflo(c), o1 = bfhi(a) + bfhi(c); const float rs = rsqrtf(wave_sum(o0 * o0 + o1 * o1) * (1.f / 128.f) + EPS);
        const float z0 = bflo(z), z1 = bfhi(z);
        *(unsigned*)(F.MIXED + (size_t)(u >> 2) * 1024 + 512 + (u & 3) * 128 + 2 * lane) = pk2(o0 * rs * g0 * z0 * fast_sig(z0), o1 * rs * g1 * z1 * fast_sig(z1)); }
}
__device__ __forceinline__ void p10_final(Frame& F) {
    const int gw = F.vcu * NWAVES + F.wave, NGW = F.G * NWAVES;
    f32x4 gn[4];
#pragma unroll
    for (int j = 0; j < 4; ++j) gn[j] = ((const f32x4*)F.norm_final)[F.lane + 64 * j];
    for (int m = gw; m < M; m += NGW) { f32x4* xr = (f32x4*)(F.out + (size_t)m * DM) + F.lane; const float rstd = rsqrtf(F.SS[2 * M + m] * (1.f / DM) + EPS);
#pragma unroll
        for (int j = 0; j < 4; ++j) xr[64 * j] = xr[64 * j] * rstd * gn[j]; }
}
constexpr int N_PHASES = 11;
__global__ void __launch_bounds__(NWAVES * 64, 2) hymba_fwd(Args args) {
    extern __shared__ __attribute__((aligned(16))) unsigned char lds[];
    cg::grid_group grid = cg::this_grid();
    Frame F;
    F.lds = (LAS unsigned char*)lds; F.tid = threadIdx.x; F.lane = F.tid & 63; F.wave = __builtin_amdgcn_readfirstlane(F.tid >> 6);
    F.G = gridDim.x; { const int bx = blockIdx.x; F.vcu = (F.G % 8 == 0) ? (bx % 8) * (F.G / 8) + bx / 8 : bx; }
    unsigned char* ws = args.ws;
    F.x = args.in[0]; F.p = args.in[1]; F.norm_mix = args.in[2]; F.w_in = args.in[3]; F.conv_w = args.in[4]; F.q_norm = args.in[5]; F.k_norm = args.in[6]; F.a_log = args.in[7]; F.dt_bias = args.in[8];
    F.dn_norm = args.in[9]; F.w_out = args.in[10]; F.norm_ffn = args.in[11]; F.w_gate = args.in[12]; F.w_up = args.in[13]; F.w_down = args.in[14]; F.norm_ple = args.in[15]; F.w_ple_gate = args.in[16];
    F.w_ple = args.in[17]; F.norm_final = args.in[18]; F.out = args.out;
    F.SS = (float*)(ws + WS_SS); F.BA = (float*)(ws + WS_BA); F.EG = (float*)(ws + WS_EG);
    F.Wt_in = (bf16*)(ws + WS_WIN); F.Wt_out = (bf16*)(ws + WS_WOUT); F.Wt_gu = (bf16*)(ws + WS_WGU); F.Wt_dn = (bf16*)(ws + WS_WDN); F.Wt_pg = (bf16*)(ws + WS_WPG); F.Wt_pl = (bf16*)(ws + WS_WPL);
    F.PB = (bf16*)(ws + WS_PB); F.XN = (bf16*)(ws + WS_B); F.MIXED = (bf16*)(ws + WS_B); F.HB2 = (bf16*)(ws + WS_B);
    F.PROJ = (bf16*)(ws + WS_C); F.W = (bf16*)(ws + WS_W); F.UT = (bf16*)(ws + WS_UT); F.QKM = (bf16*)(ws + WS_QKM); F.ACT = (bf16*)(ws + WS_C); F.PE = (bf16*)(ws + WS_C);
    F.QA = (bf16*)(ws + WS_QA); F.KA = (bf16*)(ws + WS_KA); F.VA = (bf16*)(ws + WS_VA); F.DQ = (bf16*)(ws + WS_DQ); F.DK = (bf16*)(ws + WS_DK); F.KT = (bf16*)(ws + WS_KT); F.VT = (bf16*)(ws + WS_VT);
    F.Z = (bf16*)(ws + WS_Z); F.OF = (bf16*)(ws + WS_OF); F.OB = (bf16*)(ws + WS_OB); F.HB1 = (bf16*)(ws + WS_HB1);
    const int lo = args.ph_lo, hi = args.ph_hi;
#ifndef ONLY_PH
#define ONLY_PH -1
#endif
#define IN(k) ((ONLY_PH < 0 || ONLY_PH == (k)) && lo <= (k) && (k) < hi)
#ifndef DUP_PH
#define DUP_PH -1
#endif
#define REPS(k) ((DUP_PH == (k)) ? 2 : 1)
#define SEAM(k) do { if (IN(k) && IN((k) + 1)) grid.sync(); } while (0)
    if (IN(0)) for (int rep = 0; rep < REPS(0); ++rep) { p0_prologue(F); __syncthreads(); }
    SEAM(0);
    if (IN(1)) { pg8::Gemm g{F.XN, F.Wt_in, M, NPAD, DM}; pg8::StaticOrder S; S.init(M, NPAD, F.G, (int)blockIdx.x); pg8::EpiProj E{F.PROJ, F.BA};
        pg8::gemm_phase<pg8::EpiProj, pg8::StaticOrder, true, true>(F.lds, g, S, E); }
    SEAM(1);
    if (IN(2)) for (int rep = 0; rep < REPS(2); ++rep) { p2_rope_table(F); for (int r2 = 0; r2 < REPS(21); ++r2) p2_attn_rows(F); for (int r2 = 0; r2 < REPS(22); ++r2) p2_dn_conv(F); __syncthreads(); }
    SEAM(2);
    if (IN(3)) {
        { const attn_body::AttnTensors AT{(const attn_body::bf16*)F.QA, (const attn_body::bf16*)F.KA, (const attn_body::bf16*)F.VA, (attn_body::bf16*)F.MIXED};
#ifndef NO_ATTN
          const attn_body::StaticOrder S((int)F.G, (int)blockIdx.x); for (int rep = 0; rep < REPS(31); ++rep) attn_body::attn_phase<attn_body::StaticOrder>((char*)lds, AT, S);
#endif
        }
        __syncthreads();
        { LAS float* SA = (LAS float*)(F.lds + F.wave * 18176); LAS float* sv = SA + 64 * SAP;
#ifndef NO_PREP
          for (int rep = 0; rep < REPS(32); ++rep) for (int it = F.vcu * NWAVES + F.wave; it < NB * 8 * 128; it += F.G * NWAVES) dn_prep_item(F, it, SA, sv, F.lane);
#endif
        }
        __syncthreads();
    }
    SEAM(3);
    if (IN(4)) {
#ifndef NO_SCAN
        for (int rep = 0; rep < REPS(4); ++rep) for (int it = F.vcu; it < NB * 8; it += F.G) { dn_scan_wg(F, it); __syncthreads(); }
#endif
        __syncthreads(); }
    SEAM(4);
    if (IN(5)) for (int rep = 0; rep < REPS(5); ++rep) { p5_mix(F); }
    SEAM(5);
    if (IN(6)) { pg8::Gemm g{F.MIXED, F.Wt_out, M, DM, DM}; pg8::StaticOrder S; S.init(M, DM, F.G, (int)blockIdx.x); pg8::EpiRes E{F.x, F.out, F.HB1, F.SS};
        pg8::gemm_phase<pg8::EpiRes, pg8::StaticOrder, true, true>(F.lds, g, S, E); }
    SEAM(6);
    if (IN(7)) { pg8::Gemm g{F.HB1, F.Wt_gu, M, 2 * FF, DM}; pg8::StaticOrder S; S.init(M, 2 * FF, F.G, (int)blockIdx.x); pg8::EpiGU E{F.SS, F.ACT};
        pg8::gemm_phase<pg8::EpiGU, pg8::StaticOrder, true, true>(F.lds, g, S, E); }
    SEAM(7);
    if (IN(8)) { pg8::Gemm g{F.ACT, F.Wt_dn, M, DM, FF}; pg8::StaticOrder S; S.init(M, DM, F.G, (int)blockIdx.x); pg8::EpiRes E{F.out, F.out, F.HB2, F.SS + M};
        pg8::gemm_phase<pg8::EpiRes, pg8::StaticOrder, true, true>(F.lds, g, S, E); }
    SEAM(8);
    if (IN(9)) {
#ifndef NO_G9A
        { int kpe = 256; asm volatile("" : "+s"(kpe)); pg8::Gemm g{F.PB, F.Wt_pl, M, DM, kpe}; pg8::StaticOrder S; S.init(M, DM, F.G, (int)blockIdx.x); pg8::EpiStore E{F.PE, DM};
          pg8::gemm_phase<pg8::EpiStore, pg8::StaticOrder, true, true>(F.lds, g, S, E); }
#endif
        asm volatile("s_waitcnt vmcnt(0)" ::: "memory"); __syncthreads();
#ifndef NO_G9B
        { pg8::Gemm g{F.HB2, F.Wt_pg, M, DM, DM}; pg8::StaticOrder S; S.init(M, DM, F.G, (int)blockIdx.x); pg8::EpiPle E{F.out, F.PE, F.SS + M, F.SS + 2 * M};
          pg8::gemm_phase<pg8::EpiPle, pg8::StaticOrder, true, true>(F.lds, g, S, E); }
#endif
    }
    SEAM(9);
    if (IN(10)) { p10_final(F); }
#undef IN
#undef SEAM
}

#ifndef MK_PER_PHASE
#define MK_PER_PHASE 0
#endif
extern "C" void kernel_launch(void* const* d_in, const int* in_sizes, int n_in, void* d_out, int out_size, void* d_ws, size_t ws_size, hipStream_t stream) {
    static int grid = 0;
    if (grid == 0) {
        if (n_in != 19 || in_sizes[0] != M * DM || out_size != M * DM || ws_size < WS_END) { fprintf(stderr, "kernel_launch: unexpected shapes / workspace (n_in %d, ws %zu); nothing launched\n", n_in, ws_size); grid = -1; return; }
        int dev = 0, cus = 0, per_cu = 0;
        (void)hipGetDevice(&dev); (void)hipDeviceGetAttribute(&cus, hipDeviceAttributeMultiprocessorCount, dev);
        (void)hipFuncSetAttribute((const void*)hymba_fwd, hipFuncAttributeMaxDynamicSharedMemorySize, LDS_BYTES);
        (void)hipOccupancyMaxActiveBlocksPerMultiprocessor(&per_cu, (const void*)hymba_fwd, NWAVES * 64, LDS_BYTES);
        (void)hipGetLastError();
        if (per_cu < 1) { fprintf(stderr, "kernel_launch: occupancy query says %d blocks per CU\n", per_cu); per_cu = 1; }
        grid = cus;
    }
    if (grid < 0) return;
    Args a{};
    for (int i = 0; i < 19; ++i) a.in[i] = (const float*)d_in[i];
    a.out = (float*)d_out; a.ws = (unsigned char*)d_ws;
#if MK_PER_PHASE
    for (int ph = 0; ph < N_PHASES; ++ph) { a.ph_lo = ph; a.ph_hi = ph + 1; hipLaunchKernelGGL(hymba_fwd, dim3(grid), dim3(NWAVES * 64), LDS_BYTES, stream, a); }
#else
    a.ph_lo = 0; a.ph_hi = N_PHASES;
    void* kargs[] = {&a};
    hipError_t e = hipLaunchCooperativeKernel((const void*)hymba_fwd, dim3(grid), dim3(NWAVES * 64), kargs, LDS_BYTES, stream);
    if (e != hipSuccess) fprintf(stderr, "cooperative launch failed: %s (grid %d)\n", hipGetErrorString(e), grid);
#endif
}
```

```cpp
#include <hip/hip_runtime.h>
#include <hip/hip_cooperative_groups.h>
#include <cstdio>
#include <cstdint>
namespace pg8 {
#define PG8_LAS __attribute__((address_space(3)))
typedef unsigned short bf16_t;
typedef short bf16x8 __attribute__((ext_vector_type(8)));
typedef float f32x4 __attribute__((ext_vector_type(4)));
typedef unsigned u32x4 __attribute__((ext_vector_type(4)));
constexpr int BM = 256, BK = 64, HALF = 128, HTB = HALF * BK * 2  , STAGE_BYTES = 8 * HTB, NXCD = 8, WGM = 8;

__host__ __device__ __forceinline__ int lds_byte(int r, int c) { const int st = (r >> 4) * 2 + (c >> 5), rr = r & 15, cc = c & 31, ob = rr * 64 + cc * 2; return st * 1024 + (ob ^ (((ob >> 9) & 1) << 5)); }
__host__ __device__ __forceinline__ void stage_rc(int b, int& R, int& C) { const int st = b / 1024, sb = b % 1024, swz = sb ^ (((sb >> 9) & 1) << 5); R = (st >> 1) * 16 + swz / 64; C = (st & 1) * 32 + (swz % 64) / 2; }
__host__ __device__ __forceinline__ int perm32(int rho) { const int n = rho >> 4, i = rho & 15; return 8 * (i >> 2) + 4 * n + (i & 3); }

struct Unit { int pm, pn; };
struct Gemm { const bf16_t* A; const bf16_t* Bt; int M, N, K; };

struct StaticOrder {
    int nM, nN, nwg, G, c;
    __host__ __device__ void init(int M, int N, int G_, int c_) { nM = M / BM; nN = N / BM; nwg = nM * nN; G = G_; c = c_; }
    __host__ __device__ bool next(int i, Unit& u) const {
        const long L = (long)i * G + c; if (L >= nwg) return false;
        int wgid = (int)L; { const int q = nwg / NXCD, r = nwg % NXCD, xcd = wgid % NXCD, off = wgid / NXCD; wgid = (xcd < r ? xcd * (q + 1) : r * (q + 1) + (xcd - r) * q) + off; }
        const int nig = WGM * nN, gid = wgid / nig, fm = gid * WGM, gsz = (nM - fm) < WGM ? (nM - fm) : WGM;
        u.pm = fm + ((wgid % nig) % gsz); u.pn = (wgid % nig) / gsz; return true;
    }
    __device__ __forceinline__ void a_ready(const Unit&) const {}
    __device__ __forceinline__ void done(const Unit&) const {}
};

__device__ __forceinline__ unsigned cvt_pk_bf16(float lo, float hi) { unsigned r; asm volatile("v_cvt_pk_bf16_f32 %0, %1, %2" : "=v"(r) : "v"(lo), "v"(hi)); return r; }
typedef float f32x2 __attribute__((ext_vector_type(2)));
typedef unsigned u32x2 __attribute__((ext_vector_type(2)));
__device__ __forceinline__ float fast_sigmoid(float v) { return __builtin_amdgcn_rcpf(1.f + __expf(-v)); }
struct EpiProj {
    static constexpr bool PERM = true, AFTER_DRAIN = false;
    bf16_t* O; float* BA;
    __device__ __forceinline__ void operator()(const f32x4 (&acc)[2][2][4][2], const Unit& u, int wr, int wc, int fr, int fq) const {
        const int row0 = u.pm * BM + wr * 64 + fr;
        if (u.pn < 11) {
            const int col0 = u.pn * BM + wc * 32 + 8 * fq;
#pragma unroll
            for (int ai = 0; ai < 2; ++ai)
#pragma unroll
                for (int m = 0; m < 4; ++m) { bf16_t* rowp = O + (size_t)(row0 + ai * HALF + m * 16) * 2816 + col0;
#pragma unroll
                    for (int bj = 0; bj < 2; ++bj) { const f32x4 v0 = acc[ai][bj][m][0], v1 = acc[ai][bj][m][1];
                        u32x4 w; w.x = cvt_pk_bf16(v0[0], v0[1]); w.y = cvt_pk_bf16(v0[2], v0[3]); w.z = cvt_pk_bf16(v1[0], v1[1]); w.w = cvt_pk_bf16(v1[2], v1[3]);
                        *(u32x4*)(rowp + bj * HALF) = w; } }
        } else if (wc == 0 && fq < 2) {
#pragma unroll
            for (int ai = 0; ai < 2; ++ai)
#pragma unroll
                for (int m = 0; m < 4; ++m) { float* rowp = BA + (size_t)(row0 + ai * HALF + m * 16) * 16 + 8 * fq;
                    *(f32x4*)(rowp) = acc[ai][0][m][0]; *(f32x4*)(rowp + 4) = acc[ai][0][m][1]; }
        }
    }
};
struct EpiStore {
    static constexpr bool PERM = true, AFTER_DRAIN = false;
    bf16_t* O; int ldc;
    __device__ __forceinline__ void operator()(const f32x4 (&acc)[2][2][4][2], const Unit& u, int wr, int wc, int fr, int fq) const {
        const int row0 = u.pm * BM + wr * 64 + fr; const int col0 = u.pn * BM + wc * 32 + 8 * fq;
#pragma unroll
        for (int ai = 0; ai < 2; ++ai)
#pragma unroll
            for (int m = 0; m < 4; ++m) { bf16_t* rowp = O + (size_t)(row0 + ai * HALF + m * 16) * ldc + col0;
#pragma unroll
                for (int bj = 0; bj < 2; ++bj) { const f32x4 v0 = acc[ai][bj][m][0], v1 = acc[ai][bj][m][1];
                    u32x4 w; w.x = cvt_pk_bf16(v0[0], v0[1]); w.y = cvt_pk_bf16(v0[2], v0[3]); w.z = cvt_pk_bf16(v1[0], v1[1]); w.w = cvt_pk_bf16(v1[2], v1[3]);
                    *(u32x4*)(rowp + bj * HALF) = w; } }
    }
};
template <bool BF> struct EpiRes {
    static constexpr bool PERM = false, AFTER_DRAIN = false;
    const void* base; bf16_t* hb; float* ss;
    __device__ __forceinline__ void operator()(const f32x4 (&acc)[2][2][4][2], const Unit& u, int wr, int wc, int fr, int fq) const {
        const int col0 = u.pn * BM + wc * 32 + 4 * fq;
        u32x2 pk[2][4][4];
        if (BF) {
#pragma unroll
            for (int ai = 0; ai < 2; ++ai)
#pragma unroll
                for (int m = 0; m < 4; ++m)
#pragma unroll
                    for (int q = 0; q < 4; ++q) pk[ai][m][q] = *(const u32x2*)((const bf16_t*)base + (size_t)(u.pm * BM + ai * HALF + wr * 64 + fr + m * 16) * 1024 + col0 + (q >> 1) * HALF + (q & 1) * 16);
            asm volatile("" ::: "memory"); }
#pragma unroll
        for (int ai = 0; ai < 2; ++ai) { f32x4 bs[4][4]; const size_t off0 = (size_t)(u.pm * BM + ai * HALF + wr * 64 + fr) * 1024 + col0;
            if (!BF) {
#pragma unroll
                for (int m = 0; m < 4; ++m)
#pragma unroll
                    for (int q = 0; q < 4; ++q) bs[m][q] = *(const f32x4*)((const float*)base + off0 + (size_t)m * 16 * 1024 + (q >> 1) * HALF + (q & 1) * 16);
                asm volatile("" ::: "memory"); }
#pragma unroll
            for (int m = 0; m < 4; ++m) { const size_t off = off0 + (size_t)m * 16 * 1024; float s = 0.f;
#pragma unroll
                for (int q = 0; q < 4; ++q) { f32x4 r;
                    if (BF) { const u32x2 p = pk[ai][m][q]; r = (f32x4){__uint_as_float(p.x << 16), __uint_as_float(p.x & 0xffff0000u), __uint_as_float(p.y << 16), __uint_as_float(p.y & 0xffff0000u)}; } else r = bs[m][q];
                    const f32x4 o = r + acc[ai][q >> 1][m][q & 1]; const size_t o2 = off + (q >> 1) * HALF + (q & 1) * 16;
                    s += (o[0] * o[0] + o[1] * o[1]) + (o[2] * o[2] + o[3] * o[3]);
                    u32x2 w; w.x = cvt_pk_bf16(o[0], o[1]); w.y = cvt_pk_bf16(o[2], o[3]); *(u32x2*)(hb + o2) = w; }
                s += __shfl_xor(s, 16); s += __shfl_xor(s, 32);
                if (fq == 0) unsafeAtomicAdd(ss + (u.pm * BM + ai * HALF + wr * 64 + m * 16 + fr), s); }
            asm volatile("" ::: "memory"); }
    }
};
struct EpiGU {
    static constexpr bool PERM = true, AFTER_DRAIN = false;
    const float* ss; bf16_t* act;
    __device__ __forceinline__ void operator()(const f32x4 (&acc)[2][2][4][2], const Unit& u, int wr, int wc, int fr, int fq) const {
        const int col0 = u.pn * HALF + wc * 32 + 8 * fq; const int row0 = u.pm * BM + wr * 64 + fr;
        float rs[2][4];
#pragma unroll
        for (int ai = 0; ai < 2; ++ai)
#pragma unroll
            for (int m = 0; m < 4; ++m) rs[ai][m] = ss[row0 + ai * HALF + m * 16];
        asm volatile("" ::: "memory");
#pragma unroll
        for (int ai = 0; ai < 2; ++ai)
#pragma unroll
            for (int m = 0; m < 4; ++m) { const int row = row0 + ai * HALF + m * 16;
                const float rstd = rsqrtf(rs[ai][m] * (1.0f / 1024.0f) + 1e-6f); float a[8];
#pragma unroll
                for (int n = 0; n < 2; ++n)
#pragma unroll
                    for (int e = 0; e < 4; ++e) { const float g = acc[ai][0][m][n][e] * rstd, up = acc[ai][1][m][n][e] * rstd; a[4 * n + e] = g * fast_sigmoid(g) * up; }
                u32x4 w; w.x = cvt_pk_bf16(a[0], a[1]); w.y = cvt_pk_bf16(a[2], a[3]); w.z = cvt_pk_bf16(a[4], a[5]); w.w = cvt_pk_bf16(a[6], a[7]);
                *(u32x4*)(act + (size_t)row * 2816 + col0) = w; }
    }
};
struct EpiPle {
    static constexpr bool PERM = false, AFTER_DRAIN = false;
    const bf16_t* hres; bf16_t* h; const bf16_t* pe; const float* ss2; float* ss3;
    __device__ __forceinline__ void operator()(const f32x4 (&acc)[2][2][4][2], const Unit& u, int wr, int wc, int fr, int fq) const {
        const int col0 = u.pn * BM + wc * 32 + 4 * fq;
#pragma unroll
        for (int ai = 0; ai < 2; ++ai)
#pragma unroll
            for (int mp = 0; mp < 1; ++mp) { u32x2 bs[4][4]; u32x2 pw[4][4]; float sq[4]; const int row0 = u.pm * BM + ai * HALF + wr * 64 + fr; const size_t off0 = (size_t)row0 * 1024 + col0;
#pragma unroll
                for (int m = 0; m < 4; ++m) { sq[m] = ss2[row0 + 16 * m];
#pragma unroll
                    for (int q = 0; q < 4; ++q) { const size_t o2 = off0 + (size_t)m * 16 * 1024 + (q >> 1) * HALF + (q & 1) * 16; bs[m][q] = *(const u32x2*)(hres + o2); pw[m][q] = *(const u32x2*)(pe + o2); } }
                asm volatile("" ::: "memory");
#pragma unroll
                for (int m = 0; m < 4; ++m) { const float rstd = rsqrtf(sq[m] * (1.0f / 1024.0f) + 1e-6f); float s = 0.f;
#pragma unroll
                    for (int q = 0; q < 4; ++q) { const size_t o2 = off0 + (size_t)m * 16 * 1024 + (q >> 1) * HALF + (q & 1) * 16; const f32x4 a = acc[ai][q >> 1][m][q & 1]; const u32x2 p = pw[m][q], r_ = bs[m][q]; f32x4 o;
                        o[0] = __uint_as_float(r_.x << 16) + fast_sigmoid(a[0] * rstd) * __uint_as_float(p.x << 16); o[1] = __uint_as_float(r_.x & 0xffff0000u) + fast_sigmoid(a[1] * rstd) * __uint_as_float(p.x & 0xffff0000u);
                        o[2] = __uint_as_float(r_.y << 16) + fast_sigmoid(a[2] * rstd) * __uint_as_float(p.y << 16); o[3] = __uint_as_float(r_.y & 0xffff0000u) + fast_sigmoid(a[3] * rstd) * __uint_as_float(p.y & 0xffff0000u);
                        { u32x2 w; w.x = cvt_pk_bf16(o[0], o[1]); w.y = cvt_pk_bf16(o[2], o[3]); *(u32x2*)(h + o2) = w; } s += (o[0] * o[0] + o[1] * o[1]) + (o[2] * o[2] + o[3] * o[3]); }
                    s += __shfl_xor(s, 16); s += __shfl_xor(s, 32);
                    if (fq == 0) unsafeAtomicAdd(ss3 + row0 + 16 * m, s); }
                asm volatile("" ::: "memory"); }
    }
};
template <class Epi, class Sched, bool ALIGN_EPI = false, bool SP2 = false>
__device__ __forceinline__ void gemm_phase(PG8_LAS unsigned char* lds, const Gemm g, const Sched& S, const Epi& E, const int wave_id) {
    const int tid = threadIdx.x, wid = __builtin_amdgcn_readfirstlane(tid >> 6), lane = tid & 63, wr = wid >> 2, wc = wid & 3, fr = lane & 15, fq = lane >> 4;
    const int K = g.K, nt = K / BK;
    unsigned voffA[2], voffB[2];
#pragma unroll
    for (int i = 0; i < 2; ++i) { int R, C; stage_rc(tid * 16 + i * 8192, R, C); const int Rb = Epi::PERM ? ((R & ~31) + perm32(R & 31)) : R;
        voffA[i] = (unsigned)(R * K + C) * 2u; voffB[i] = (unsigned)(Rb * K + C) * 2u; }
    const size_t kstep = (size_t)(BK * 2);
    const size_t hstep = (size_t)HALF * K * 2;
    const size_t tstep = 2 * hstep;
    const unsigned ldsw = (unsigned)wid * 1024u;
    const int aoff = lds_byte(wr * 64 + fr, fq * 8), boff = lds_byte(wc * 32 + fr, fq * 8);
#define PG8_SA(b, h) (((b) * 2 + (h)) * HTB)
#define PG8_SB(b, h) ((4 + (b) * 2 + (h)) * HTB)
#define PG8_STAGE(bufoff, gbase, voff) do { _Pragma("unroll") for (int _i = 0; _i < 2; ++_i) \
        __builtin_amdgcn_global_load_lds((const unsigned*)((const char*)(gbase) + (voff)[_i]), (PG8_LAS unsigned*)(lds + (bufoff) + ldsw + _i * 8192), 16, 0, 0); } while (0)
#define PG8_LDA(dst, b, h) do { _Pragma("unroll") for (int m = 0; m < 4; ++m) _Pragma("unroll") for (int k = 0; k < 2; ++k) dst[m][k] = *(const PG8_LAS bf16x8*)(lds + PG8_SA(b, h) + aoff + m * 2048 + k * 1024); } while (0)
#define PG8_LDB(dst, b, h) do { _Pragma("unroll") for (int n = 0; n < 2; ++n) _Pragma("unroll") for (int k = 0; k < 2; ++k) dst[n][k] = *(const PG8_LAS bf16x8*)(lds + PG8_SB(b, h) + boff + n * 2048 + k * 1024); } while (0)
#define PG8_MMA(ai, bj, At, Bt) do { __builtin_amdgcn_s_setprio(1); _Pragma("unroll") for (int m = 0; m < 4; ++m) _Pragma("unroll") for (int n = 0; n < 2; ++n) _Pragma("unroll") for (int k = 0; k < 2; ++k) \
        acc[ai][bj][m][n] = __builtin_amdgcn_mfma_f32_16x16x32_bf16(Bt[n][k], At[m][k], acc[ai][bj][m][n], 0, 0, 0); __builtin_amdgcn_s_setprio(0); } while (0)
#define PG8_WAIT_V(n) asm volatile("s_waitcnt vmcnt(" #n ")" ::: "memory")
#define PG8_WAIT_L(n) asm volatile("s_waitcnt lgkmcnt(" #n ")" ::: "memory")
#define PG8_BAR __builtin_amdgcn_s_barrier()
#define PG8_SCHED __builtin_amdgcn_sched_barrier(0)
    Unit cur, nxt; int ui = 0;
    if (!S.next(0, cur)) return;
    f32x4 acc[2][2][4][2];
#pragma unroll
    for (int a = 0; a < 2; ++a)
#pragma unroll
        for (int b = 0; b < 2; ++b)
#pragma unroll
            for (int m = 0; m < 4; ++m)
#pragma unroll
                for (int n = 0; n < 2; ++n) acc[a][b][m][n] = (f32x4){0.f, 0.f, 0.f, 0.f};
    bf16x8 At[4][2], B0[2][2], B1[2][2];
    const char* cA = (const char*)g.A + (size_t)cur.pm * tstep; const char* cB = (const char*)g.Bt + (size_t)cur.pn * tstep;
    S.a_ready(cur);
    if constexpr (SP2) {
        PG8_STAGE(PG8_SB(0, 0), cB, voffB); PG8_STAGE(PG8_SB(0, 1), cB + hstep, voffB); PG8_STAGE(PG8_SA(0, 0), cA, voffA); PG8_STAGE(PG8_SA(0, 1), cA + hstep, voffA);
        if (wr == 1) PG8_BAR;
        PG8_WAIT_V(2); PG8_BAR;
        PG8_STAGE(PG8_SB(1, 0), cB + kstep, voffB); PG8_STAGE(PG8_SA(1, 0), cA + kstep, voffA); PG8_STAGE(PG8_SB(1, 1), cB + hstep + kstep, voffB);
        PG8_WAIT_V(6); PG8_BAR;
    } else {
        PG8_STAGE(PG8_SB(0, 0), cB, voffB); PG8_STAGE(PG8_SA(0, 0), cA, voffA); PG8_STAGE(PG8_SB(0, 1), cB + hstep, voffB); PG8_STAGE(PG8_SA(0, 1), cA + hstep, voffA);
        if (wr == 1) PG8_BAR;
        PG8_WAIT_V(4); PG8_BAR;
        PG8_STAGE(PG8_SB(1, 0), cB + kstep, voffB); PG8_STAGE(PG8_SA(1, 0), cA + kstep, voffA); PG8_STAGE(PG8_SB(1, 1), cB + hstep + kstep, voffB);
        PG8_WAIT_V(6); PG8_BAR;
    }
    for (;;) {
        const bool has_next = S.next(ui + 1, nxt);
        const char* nA = has_next ? (const char*)g.A + (size_t)nxt.pm * tstep : cA; const char* nB = has_next ? (const char*)g.Bt + (size_t)nxt.pn * tstep : cB;
        for (int t = 0; t < nt; t += 2) {
            const bool last = (t == nt - 2);
            const char* a1 = cA + (size_t)(t + 1) * kstep;
            const char* a2 = last ? nA : cA + (size_t)(t + 2) * kstep; const char* b2 = last ? nB : cB + (size_t)(t + 2) * kstep;
            const char* a3 = a2 + kstep; const char* b3 = b2 + kstep;
            if (last && has_next) S.a_ready(nxt);
            if constexpr (SP2) {
            PG8_LDB(B0, 0, 0); PG8_LDB(B1, 0, 1); PG8_SCHED; PG8_LDA(At, 0, 0); PG8_STAGE(PG8_SA(1, 1), a1 + hstep, voffA);
            PG8_WAIT_V(8); PG8_WAIT_L(0); PG8_BAR; PG8_MMA(0, 0, At, B0); PG8_MMA(0, 1, At, B1); PG8_BAR; PG8_SCHED;
            PG8_LDA(At, 0, 1); PG8_STAGE(PG8_SB(0, 0), b2, voffB); PG8_STAGE(PG8_SB(0, 1), b2 + hstep, voffB); PG8_STAGE(PG8_SA(0, 0), a2, voffA);
            PG8_WAIT_V(8); PG8_WAIT_L(0); PG8_BAR; PG8_MMA(1, 0, At, B0); PG8_MMA(1, 1, At, B1); PG8_BAR; PG8_SCHED;
            PG8_LDB(B0, 1, 0); PG8_LDB(B1, 1, 1); PG8_SCHED; PG8_LDA(At, 1, 0); PG8_STAGE(PG8_SA(0, 1), a2 + hstep, voffA);
            PG8_WAIT_V(8); PG8_WAIT_L(0); PG8_BAR; PG8_MMA(0, 0, At, B0); PG8_MMA(0, 1, At, B1); PG8_BAR; PG8_SCHED;
            PG8_LDA(At, 1, 1); PG8_STAGE(PG8_SB(1, 0), b3, voffB); PG8_STAGE(PG8_SB(1, 1), b3 + hstep, voffB); PG8_STAGE(PG8_SA(1, 0), a3, voffA);
            PG8_WAIT_V(8); PG8_WAIT_L(0); PG8_BAR; PG8_MMA(1, 0, At, B0); PG8_MMA(1, 1, At, B1); PG8_BAR; PG8_SCHED;
            } else {
            PG8_LDB(B0, 0, 0); PG8_SCHED; PG8_LDA(At, 0, 0); PG8_STAGE(PG8_SA(1, 1), a1 + hstep, voffA);
            PG8_WAIT_L(8); PG8_BAR; PG8_WAIT_L(0); PG8_MMA(0, 0, At, B0); PG8_BAR; PG8_SCHED;
            PG8_LDB(B1, 0, 1); PG8_STAGE(PG8_SB(0, 0), b2, voffB);
            PG8_BAR; PG8_WAIT_L(0); PG8_MMA(0, 1, At, B1); PG8_BAR;
            PG8_LDA(At, 0, 1); PG8_STAGE(PG8_SA(0, 0), a2, voffA);
            PG8_BAR; PG8_WAIT_L(0); PG8_MMA(1, 0, At, B0); PG8_BAR; PG8_SCHED;
            PG8_STAGE(PG8_SB(0, 1), b2 + hstep, voffB);
            PG8_WAIT_V(6); PG8_BAR; PG8_MMA(1, 1, At, B1); PG8_BAR;
            PG8_LDB(B0, 1, 0); PG8_SCHED; PG8_LDA(At, 1, 0); PG8_STAGE(PG8_SA(0, 1), a2 + hstep, voffA);
            PG8_WAIT_L(8); PG8_BAR; PG8_WAIT_L(0); PG8_MMA(0, 0, At, B0); PG8_BAR; PG8_SCHED;
            PG8_LDB(B1, 1, 1); PG8_STAGE(PG8_SB(1, 0), b3, voffB);
            PG8_BAR; PG8_WAIT_L(0); PG8_MMA(0, 1, At, B1); PG8_BAR;
            PG8_LDA(At, 1, 1); PG8_STAGE(PG8_SA(1, 0), a3, voffA);
            PG8_BAR; PG8_WAIT_L(0); PG8_MMA(1, 0, At, B0); PG8_BAR; PG8_SCHED;
            PG8_STAGE(PG8_SB(1, 1), b3 + hstep, voffB);
            PG8_WAIT_V(6); PG8_BAR; PG8_MMA(1, 1, At, B1); PG8_BAR;
            }
        }
        if constexpr (ALIGN_EPI) { if (wr == 0) PG8_BAR; }
        if constexpr (!Epi::AFTER_DRAIN) { E(acc, cur, wr, wc, fr, fq); S.done(cur); }
        if (!has_next) break;
#pragma unroll
        for (int a = 0; a < 2; ++a)
#pragma unroll
            for (int b = 0; b < 2; ++b)
#pragma unroll
                for (int m = 0; m < 4; ++m)
#pragma unroll
                    for (int n = 0; n < 2; ++n) acc[a][b][m][n] = (f32x4){0.f, 0.f, 0.f, 0.f};
        cur = nxt; cA = nA; cB = nB; ++ui;
        if constexpr (ALIGN_EPI) { if (wr == 1) PG8_BAR; }
    }
    PG8_WAIT_V(0);
    if constexpr (!ALIGN_EPI) { if (wr == 0) PG8_BAR; }
    PG8_BAR;
    if constexpr (Epi::AFTER_DRAIN) { E.fused(acc, cur, wr, wc, fr, fq, lds, wid, lane); S.done(cur); }
#undef PG8_SA
#undef PG8_SB
#undef PG8_STAGE
#undef PG8_LDA
#undef PG8_LDB
#undef PG8_MMA
#undef PG8_WAIT_V
#undef PG8_WAIT_L
#undef PG8_BAR
#undef PG8_SCHED
}
}
#include <hip/hip_bf16.h>
#include <cmath>
namespace attn_body {
using bf16=__hip_bfloat16;
using bf16x8=__attribute__((ext_vector_type(8)))short;
using s16x4=__attribute__((ext_vector_type(4)))short;
using f32x16=__attribute__((ext_vector_type(16)))float;
using u32x4=__attribute__((ext_vector_type(4)))unsigned;
constexpr int BATCH=8,NHEAD=8,SEQ=8192,D=64,QP=512,KP=128,OP=1024,GQ=4;
constexpr int NW=8,QBLK=32,QB=QBLK*NW,KVBLK=64,NQB=SEQ/QB;
constexpr int ATTN_UNIT_ROWS=QB;
__device__ __forceinline__ int crow(int r,int hi){return (r&3)+8*(r>>2)+4*hi;}
#define SBAR() __builtin_amdgcn_sched_barrier(0)
__device__ __forceinline__ void cmask(f32x16&p0,f32x16&p1,int jb,int qrel,int hi){
  const float NEG=-INFINITY; int kb=64*jb+4*hi;
  #pragma unroll
  for(int r=0;r<16;++r){int kv=kb+(r&3)+8*(r>>2); if(kv>qrel)p0[r]=NEG; if(kv+32>qrel)p1[r]=NEG;}
}

constexpr int NSLOT=3, SLOTB=8192;
constexpr int LDS_K=0, LDS_V=NSLOT*SLOTB, LDS_WS=2*NSLOT*SLOTB, LDS_OST=LDS_WS+NW*64*4, LDS_BYTES=LDS_OST+NW*4096;
constexpr float C2=0.125f*1.4426950408889634f;
__device__ __forceinline__ void glds16(const void*gsrc,unsigned lds_dst){unsigned keep;
  asm volatile("s_mov_b32 %0, m0\n\ts_mov_b32 m0, %2\n\ts_nop 0\n\tglobal_load_lds_dwordx4 %1, off\n\ts_mov_b32 m0, %0":"=&s"(keep):"v"(gsrc),"s"(lds_dst):"memory");}
__device__ __forceinline__ float max3f(float a,float b,float c){float r;asm("v_max3_f32 %0, %1, %2, %3":"=v"(r):"v"(a),"v"(b),"v"(c));return r;}
__device__ __forceinline__ float max2f(float a,float b){float r;asm("v_max_f32_e32 %0, %1, %2":"=v"(r):"v"(a),"v"(b));return r;}
__device__ __forceinline__ float fadd_s(float a,float b){float r;asm("v_add_f32_e32 %0, %1, %2":"=v"(r):"v"(a),"v"(b));return r;}
__device__ __forceinline__ float fsub_s(float a,float b){float r;asm("v_sub_f32_e32 %0, %1, %2":"=v"(r):"v"(a),"v"(b));return r;}
typedef float f32x2_t __attribute__((ext_vector_type(2))); typedef __bf16 bf16x2_t __attribute__((ext_vector_type(2)));
__device__ __forceinline__ unsigned cvtpk_s(float lo,float hi){f32x2_t v={lo,hi};bf16x2_t b=__builtin_convertvector(v,bf16x2_t);return __builtin_bit_cast(unsigned,b);}
#define WAIT_BAR(N) asm volatile("s_waitcnt vmcnt(" #N ") lgkmcnt(0)\n\ts_barrier":::"memory")

__device__ __forceinline__ void qkt(f32x16&p0,f32x16&p1,const char*Kslot,const bf16x8*qr,const f32x16&negm,int r32,int hi){
  const char*kb=Kslot+hi*1024+r32*16;
  #pragma unroll
  for(int d0=0;d0<4;++d0){
    const bf16x8 b0=*reinterpret_cast<const bf16x8*>(kb+d0*2048);
    const bf16x8 b1=*reinterpret_cast<const bf16x8*>(kb+d0*2048+512);
    if(d0==0){p0=__builtin_amdgcn_mfma_f32_32x32x16_bf16(b0,qr[0],negm,0,0,0);p1=__builtin_amdgcn_mfma_f32_32x32x16_bf16(b1,qr[0],negm,0,0,0);}
    else{p0=__builtin_amdgcn_mfma_f32_32x32x16_bf16(b0,qr[d0],p0,0,0,0);p1=__builtin_amdgcn_mfma_f32_32x32x16_bf16(b1,qr[d0],p1,0,0,0);}}
}
typedef __attribute__((address_space(3))) const char* lds_cptr;
typedef short v4i16_t __attribute__((ext_vector_type(4)));
__device__ __forceinline__ void kload8(bf16x8*kf,lds_cptr kp){
  kf[0]=*(const __attribute__((address_space(3))) bf16x8*)(kp);      kf[1]=*(const __attribute__((address_space(3))) bf16x8*)(kp+512);
  kf[2]=*(const __attribute__((address_space(3))) bf16x8*)(kp+2048); kf[3]=*(const __attribute__((address_space(3))) bf16x8*)(kp+2560);
  kf[4]=*(const __attribute__((address_space(3))) bf16x8*)(kp+4096); kf[5]=*(const __attribute__((address_space(3))) bf16x8*)(kp+4608);
  kf[6]=*(const __attribute__((address_space(3))) bf16x8*)(kp+6144); kf[7]=*(const __attribute__((address_space(3))) bf16x8*)(kp+6656);
}
__device__ __forceinline__ void kload2(bf16x8*kf,lds_cptr kp,int j){ kf[2*j]=*(const __attribute__((address_space(3))) bf16x8*)(kp+j*2048); kf[2*j+1]=*(const __attribute__((address_space(3))) bf16x8*)(kp+j*2048+512); }
__device__ __forceinline__ s16x4 vtr(lds_cptr p){ return __builtin_bit_cast(s16x4,__builtin_amdgcn_ds_read_tr16_b64_v4i16((__attribute__((address_space(3))) v4i16_t*)p)); }
__device__ __forceinline__ float rowmax(const f32x16&p0,const f32x16&p1){
  float a=max3f(p0[0],p0[1],p1[0]),b=max3f(p0[2],p0[3],p1[1]);a=max3f(a,p1[2],p1[3]);
  #pragma unroll
  for(int r=4;r<16;r+=4){a=max3f(a,p0[r],p0[r+1]);b=max3f(b,p0[r+2],p0[r+3]);a=max3f(a,p1[r],p1[r+1]);b=max3f(b,p1[r+2],p1[r+3]);}
  const float m=max2f(a,b);
  auto rr=__builtin_amdgcn_permlane32_swap(__float_as_uint(m),__float_as_uint(m),false,false);
  return max2f(__uint_as_float(rr[0]),__uint_as_float(rr[1]));
}
__device__ __forceinline__ void pv(f32x16*o,int vb,bf16x8 pa0,bf16x8 pa1,bf16x8 pa2,bf16x8 pa3){
  #pragma unroll
  for(int d0=0;d0<2;++d0){s16x4 lo[4],hi[4];
    #pragma unroll
    for(int ks=0;ks<4;++ks){
      asm volatile("ds_read_b64_tr_b16 %0,%1 offset:%c2":"=&v"(lo[ks]):"v"(vb),"i"(d0*4096+ks*1024):"memory");
      asm volatile("ds_read_b64_tr_b16 %0,%1 offset:%c2":"=&v"(hi[ks]):"v"(vb),"i"(d0*4096+ks*1024+512):"memory");}
    asm volatile("s_waitcnt lgkmcnt(0)":::"memory");SBAR();
    #define PK(k) (bf16x8){lo[k][0],lo[k][1],lo[k][2],lo[k][3],hi[k][0],hi[k][1],hi[k][2],hi[k][3]}
    o[d0]=__builtin_amdgcn_mfma_f32_32x32x16_bf16(pa0,PK(0),o[d0],0,0,0);
    o[d0]=__builtin_amdgcn_mfma_f32_32x32x16_bf16(pa1,PK(1),o[d0],0,0,0);
    o[d0]=__builtin_amdgcn_mfma_f32_32x32x16_bf16(pa2,PK(2),o[d0],0,0,0);
    o[d0]=__builtin_amdgcn_mfma_f32_32x32x16_bf16(pa3,PK(3),o[d0],0,0,0);
    #undef PK
  }
}

#ifndef ATTN_STORE16
#define ATTN_STORE16(p,v) (*(u32x4*)(p)=(v))
#endif
template<int THRL> __device__ __forceinline__ void attn_unit(int b,int h,int qb,const bf16*Q,const bf16*__restrict__ K,const bf16*__restrict__ V,bf16*O,char*shm){
  const int tid=threadIdx.x,lane=tid&63,r32=lane&31,hi=lane>>5; const int wid=__builtin_amdgcn_readfirstlane(tid>>6);
  const long rowbase=(long)b*SEQ; const int q0=qb*QB;
  const bf16*Qw=Q+(rowbase+q0+wid*QBLK)*QP+h*D;
  const bf16*Kh=K+rowbase*KP+(h/GQ)*D,*Vh=V+rowbase*KP+(h/GQ)*D;
  const unsigned lds0=(unsigned)(uintptr_t)shm;
  float*wsf=(float*)(shm+LDS_WS)+wid*64;
  const bf16*ksrc=Kh+(long)lane*KP+wid*8;
  const bf16*vsrc=Vh+(long)(16*(wid&3)+(lane>>2))*KP+(wid>>2)*32+(lane&3)*8;
  const unsigned kdst=lds0+LDS_K+wid*1024, vdst=lds0+LDS_V+wid*1024;
  #define DMA_K(t,slot) glds16(ksrc+(long)(t)*KVBLK*KP,(unsigned)__builtin_amdgcn_readfirstlane(kdst+(slot)))
  #define DMA_V(t,slot) glds16(vsrc+(long)(t)*KVBLK*KP,(unsigned)__builtin_amdgcn_readfirstlane(vdst+(slot)))
  const int vb0=(int)(lds0+LDS_V)+((lane>>4)&1)*32+(lane&3)*8+(4*hi+((lane&15)>>2))*64;
  const char*Kbase=shm+LDS_K; bf16x8 kf[8];
  const lds_cptr shm3=(lds_cptr)shm; const lds_cptr kp0=shm3+LDS_K+hi*1024+r32*16; const lds_cptr vp0=shm3+LDS_V+((lane>>4)&1)*32+(lane&3)*8+(4*hi+((lane&15)>>2))*64;
  const int NT=SEQ/KVBLK;
  DMA_K(0,0);DMA_V(0,0);DMA_K(1,SLOTB);
  bf16x8 qr[4];
  #pragma unroll
  for(int d0=0;d0<4;++d0)qr[d0]=*reinterpret_cast<const bf16x8*>(&Qw[(long)r32*QP+d0*16+hi*8]);
  float mhat=0.f,l_reg=0.f;f32x16 o[2];o[0]=f32x16{};o[1]=f32x16{};f32x16 negm=f32x16{};asm volatile("":"+v"(negm));
  const int qrel=wid*QBLK+r32;
  #define CMASK(P0,P1,t) do{}while(0)
  bool resc=false;
  #define START(P0,P1) do{ const float rm=rowmax(P0,P1); resc=false; \
    { const float dl=rm; mhat=fadd_s(mhat,dl); \
      _Pragma("unroll") for(int r=0;r<16;++r){P0[r]=fsub_s(P0[r],dl);P1[r]=fsub_s(P1[r],dl);} \
      _Pragma("unroll") for(int r=0;r<16;++r)negm[r]=-mhat; asm volatile("":"+v"(negm)); } \
    _Pragma("unroll") for(int r=0;r<16;++r)P0[r]=__builtin_amdgcn_exp2f(P0[r]); }while(0)
  #define RESC() do{ if(resc){ asm volatile("s_waitcnt lgkmcnt(0)":::"memory"); \
      _Pragma("unroll") for(int d_=0;d_<2;++d_) _Pragma("unroll") for(int r=0;r<16;++r)o[d_][r]*=wsf[crow(r,hi)]; } }while(0)
  f32x16 pA0,pA1,pB0,pB1;
  int sl_prev=0,sl_cur=0,sl_next=SLOTB;
  #define ROT() do{sl_prev=sl_cur;sl_cur=sl_next;sl_next=(sl_next==(NSLOT-1)*SLOTB)?0:sl_next+SLOTB;}while(0)
  DMA_K(2,2*SLOTB);
  WAIT_BAR(3);
  qkt(pA0,pA1,Kbase,qr,negm,r32,hi);asm volatile("s_nop 15\n\ts_nop 7":"+v"(pA0),"+v"(pA1));CMASK(pA0,pA1,0);
  START(pA0,pA1);
  _Pragma("unroll") for(int r=0;r<16;++r)pA1[r]=__builtin_amdgcn_exp2f(pA1[r]);
  WAIT_BAR(0);
  DMA_K(3,0);DMA_V(1,SLOTB);
  ROT();
  kload8(kf,kp0+sl_cur);
  WAIT_BAR(2);
  s16x4 vlo[8],vhi[8]; u32x4 pw0,pw1,pw2,pw3;
  #define PKW(P,B) cvtpk_s(P[B],P[B+1])
  #define PAF(k) __builtin_bit_cast(bf16x8,pw##k)
  #define VFR(i) (bf16x8){vlo[i][0],vlo[i][1],vlo[i][2],vlo[i][3],vhi[i][0],vhi[i][1],vhi[i][2],vhi[i][3]}
  #define PIN(x) asm volatile("":"+v"(x))
  #define MX3(a,b,c) __builtin_fmaxf(__builtin_fmaxf((a),(b)),(c))
  #define GAPA(MF,A0,A1,A2,A3,W0,W1,PW) do{ MF; sacc+=A0; sacc+=A1; sacc+=A2; sacc+=A3; PIN(sacc); W0; W1; PIN(PW); SBAR(); }while(0)
  #define EX(v) __builtin_amdgcn_exp2f(v)
  #define GAPB(MF,X,B) do{ MF; X[B]=EX(X[B]); X[B+1]=EX(X[B+1]); X[B+2]=EX(X[B+2]); X[B+3]=EX(X[B+3]); PIN(X); SBAR(); }while(0)
  #define VRD(i) do{ vlo[i]=vtr(vp_+(((i)>>2)*4096+((i)&3)*1024)); vhi[i]=vtr(vp_+(((i)>>2)*4096+((i)&3)*1024+512)); }while(0)
  #define KRD(G,j) do{ if(G){ kload2(kf,kp0+sl_next,j); SBAR(); } }while(0)
  #define STEP(C0,C1,P0,P1,t,GK,GV,GL) do{ SBAR(); \
    const lds_cptr vp_=vp0+sl_prev; \
    VRD(0); SBAR(); float sacc=(P0[0]+P0[1]); \
    GAPA(C0=__builtin_amdgcn_mfma_f32_32x32x16_bf16(kf[0],qr[0],negm,0,0,0), P0[2],P0[3],P0[4],P0[5],     pw0[0]=PKW(P0,0), pw0[1]=PKW(P0,2), pw0); \
    VRD(4); SBAR(); GAPA(C1=__builtin_amdgcn_mfma_f32_32x32x16_bf16(kf[1],qr[0],negm,0,0,0), P0[6],P0[7],P0[8],P0[9],     pw0[2]=PKW(P0,4), pw0[3]=PKW(P0,6), pw0); \
    VRD(1); SBAR(); GAPA(C0=__builtin_amdgcn_mfma_f32_32x32x16_bf16(kf[2],qr[1],C0,0,0,0),   P0[10],P0[11],P0[12],P0[13], pw1[0]=PKW(P0,8), pw1[1]=PKW(P0,10), pw1); \
    VRD(5); SBAR(); GAPA(C1=__builtin_amdgcn_mfma_f32_32x32x16_bf16(kf[3],qr[1],C1,0,0,0),   P0[14],P0[15],P1[0],P1[1],   pw1[2]=PKW(P0,12),pw1[3]=PKW(P0,14), pw1); \
    VRD(2); SBAR(); GAPA(C0=__builtin_amdgcn_mfma_f32_32x32x16_bf16(kf[4],qr[2],C0,0,0,0),   P1[2],P1[3],P1[4],P1[5],     pw2[0]=PKW(P1,0), pw2[1]=PKW(P1,2), pw2); \
    VRD(6); SBAR(); GAPA(C1=__builtin_amdgcn_mfma_f32_32x32x16_bf16(kf[5],qr[2],C1,0,0,0),   P1[6],P1[7],P1[8],P1[9],     pw2[2]=PKW(P1,4), pw2[3]=PKW(P1,6), pw2); \
    VRD(3); SBAR(); GAPA(C0=__builtin_amdgcn_mfma_f32_32x32x16_bf16(kf[6],qr[3],C0,0,0,0),   P1[10],P1[11],P1[12],P1[13], pw3[0]=PKW(P1,8), pw3[1]=PKW(P1,10), pw3); \
    VRD(7); SBAR(); GAPA(C1=__builtin_amdgcn_mfma_f32_32x32x16_bf16(kf[7],qr[3],C1,0,0,0),   P1[14],P1[15],0.f,0.f,       pw3[2]=PKW(P1,12),pw3[3]=PKW(P1,14), pw3); \
    l_reg+=sacc; \
    if(GK){DMA_K((t)+3,sl_cur);} if(GV){DMA_V((t)+1,sl_next);} \
    CMASK(C0,C1,t); \
    { float a=MX3(C0[0],C0[1],C1[0]),b=MX3(C0[2],C0[3],C1[1]); a=MX3(a,C1[2],C1[3]); \
      _Pragma("unroll") for(int r=4;r<16;r+=4){a=MX3(a,C0[r],C0[r+1]);b=MX3(b,C0[r+2],C0[r+3]);a=MX3(a,C1[r],C1[r+1]);b=MX3(b,C1[r+2],C1[r+3]);} \
      float rm=__builtin_fmaxf(a,b); { auto rr=__builtin_amdgcn_permlane32_swap(__float_as_uint(rm),__float_as_uint(rm),false,false); rm=__builtin_fmaxf(__uint_as_float(rr[0]),__uint_as_float(rr[1])); } \
      resc=false; \
      if(__builtin_expect(__any(rm>(float)THRL),0)){ const float dl=__builtin_fmaxf(rm,0.f); mhat+=dl; \
        _Pragma("unroll") for(int r=0;r<16;++r){C0[r]-=dl;C1[r]-=dl;} \
        _Pragma("unroll") for(int r=0;r<16;++r)negm[r]=-mhat; asm volatile("":"+v"(negm)); \
        const float f=__builtin_amdgcn_exp2f(-dl); l_reg*=f; if(hi==0)wsf[r32]=f; resc=true; } } \
    SBAR(); \
    GAPB(o[0]=__builtin_amdgcn_mfma_f32_32x32x16_bf16(PAF(0),VFR(0),o[0],0,0,0), C0,0); \
    GAPB(o[1]=__builtin_amdgcn_mfma_f32_32x32x16_bf16(PAF(0),VFR(4),o[1],0,0,0), C0,4); \
    KRD(GL,0); GAPB(o[0]=__builtin_amdgcn_mfma_f32_32x32x16_bf16(PAF(1),VFR(1),o[0],0,0,0), C0,8); \
    KRD(GL,1); GAPB(o[1]=__builtin_amdgcn_mfma_f32_32x32x16_bf16(PAF(1),VFR(5),o[1],0,0,0), C0,12); \
    KRD(GL,2); GAPB(o[0]=__builtin_amdgcn_mfma_f32_32x32x16_bf16(PAF(2),VFR(2),o[0],0,0,0), C1,0); \
    KRD(GL,3); GAPB(o[1]=__builtin_amdgcn_mfma_f32_32x32x16_bf16(PAF(2),VFR(6),o[1],0,0,0), C1,4); \
    GAPB(o[0]=__builtin_amdgcn_mfma_f32_32x32x16_bf16(PAF(3),VFR(3),o[0],0,0,0), C1,8); \
    GAPB(o[1]=__builtin_amdgcn_mfma_f32_32x32x16_bf16(PAF(3),VFR(7),o[1],0,0,0), C1,12); \
    }while(0)
  int t=1;
  #undef CMASK
  #define CMASK(P0,P1,t) do{}while(0)
  for(;t+5<NT;t+=2){
    STEP(pB0,pB1,pA0,pA1,t,true,true,true);     WAIT_BAR(2); RESC(); ROT();
    STEP(pA0,pA1,pB0,pB1,t+1,true,true,true);   WAIT_BAR(2); RESC(); ROT();
  }
  #undef CMASK
  #define CMASK(P0,P1,t) do{}while(0)
  #define ENDW(tt) do{ if((tt)+3<NT){WAIT_BAR(2);} else if((tt)+2<NT){WAIT_BAR(1);} else {WAIT_BAR(0);} }while(0)
  for(;t+1<NT;t+=2){
    STEP(pB0,pB1,pA0,pA1,t,(t+3<NT),(t+1<NT),(t+1<NT));       ENDW(t);   RESC(); ROT();
    STEP(pA0,pA1,pB0,pB1,t+1,(t+4<NT),(t+2<NT),(t+2<NT));     ENDW(t+1); RESC(); ROT();
  }
  STEP(pB0,pB1,pA0,pA1,NT-1,false,false,false); RESC();
  { float sacc=pB0[0]+pB0[1]; _Pragma("unroll") for(int r=2;r<16;++r)sacc+=pB0[r]; _Pragma("unroll") for(int r=0;r<16;++r)sacc+=pB1[r]; l_reg+=sacc;
    pw0=(u32x4){PKW(pB0,0),PKW(pB0,2),PKW(pB0,4),PKW(pB0,6)};pw1=(u32x4){PKW(pB0,8),PKW(pB0,10),PKW(pB0,12),PKW(pB0,14)};pw2=(u32x4){PKW(pB1,0),PKW(pB1,2),PKW(pB1,4),PKW(pB1,6)};pw3=(u32x4){PKW(pB1,8),PKW(pB1,10),PKW(pB1,12),PKW(pB1,14)};
    SBAR(); pv(o,vb0+sl_cur,PAF(0),PAF(1),PAF(2),PAF(3)); }
  #undef PKW
  #undef PAF
  #undef VFR
  #undef PIN
  #undef MX3
  #undef GAPA
  #undef GAPB
  #undef EX
  #undef VRD
  #undef KRD
  #undef STEP
  #undef ENDW
  {auto rr=__builtin_amdgcn_permlane32_swap(__float_as_uint(l_reg),__float_as_uint(l_reg),false,false);l_reg=__uint_as_float(rr[0])+__uint_as_float(rr[1]);}
  if(hi==0)wsf[32+r32]=l_reg;asm volatile("s_waitcnt lgkmcnt(0)":::"memory");
  float rli[16];
  #pragma unroll
  for(int r=0;r<16;++r)rli[r]=__builtin_amdgcn_rcpf(wsf[32+crow(r,hi)]);
  bf16*Ow=O+(rowbase+q0+wid*QBLK)*OP+h*D;
  { bf16*stg=(bf16*)(shm+LDS_OST)+wid*2048;
    #pragma unroll
    for(int r=0;r<16;++r){const int orow=crow(r,hi);
      #pragma unroll
      for(int d0=0;d0<2;++d0)stg[orow*64+d0*32+r32]=__float2bfloat16(o[d0][r]*rli[r]);}
    asm volatile("s_waitcnt lgkmcnt(0)":::"memory");
    #pragma unroll
    for(int i=0;i<4;++i){const int row=i*8+(lane>>3),ch=lane&7; const u32x4 v=*(const u32x4*)(stg+row*64+ch*8); ATTN_STORE16(Ow+(long)row*OP+ch*8,v);} }
  asm volatile("s_waitcnt lgkmcnt(0)\n\ts_barrier":::"memory");
  #undef DMA_K
  #undef DMA_V
  #undef CMASK
  #undef START
  #undef RESC
  #undef ROT
}
constexpr int ATTN_LDS_BYTES=LDS_BYTES;
struct AttnTensors { const bf16* Q; const bf16* K; const bf16* V; bf16* O; };
struct AttnUnit { int bh; int qb; };
struct StaticOrder {
  int vcu,G;
  __device__ __forceinline__ explicit StaticOrder(int grid,int block):vcu((grid%8==0)?(block%8)*(grid/8)+block/8:block),G(grid){}
  __device__ __forceinline__ bool next(int i,AttnUnit&u)const{ const int U=vcu+G*i; if(U>=BATCH*NHEAD*NQB)return false; u.bh=U/NQB; u.qb=U%NQB; return true; }
  __device__ __forceinline__ void a_ready(const AttnUnit&)const{}
  __device__ __forceinline__ void done(const AttnUnit&)const{}
};
template<class Sched,int THRL=8> __device__ __forceinline__ void attn_phase(char*lds,const AttnTensors&T,const Sched&S){
  AttnUnit u;
  for(int i=0;S.next(i,u);++i){ S.a_ready(u); attn_unit<THRL>(u.bh/NHEAD,u.bh%NHEAD,u.qb,T.Q,T.K,T.V,T.O,lds); S.done(u); }
}
#undef SBAR
#undef WAIT_BAR
}
namespace cg = cooperative_groups;
#define LAS __attribute__((address_space(3)))
typedef unsigned short bf16;
typedef float f32x4 __attribute__((ext_vector_type(4)));
typedef float f32x16 __attribute__((ext_vector_type(16)));
typedef short bf16x8 __attribute__((ext_vector_type(8)));
typedef short s16x4 __attribute__((ext_vector_type(4)));
typedef unsigned v4u __attribute__((ext_vector_type(4)));
typedef unsigned v2u __attribute__((ext_vector_type(2)));

constexpr int NB = 8, SEQ = 8192, DM = 1024, M = NB * SEQ, NPROJ = 2816, NPAD = 3072, FF = 2816, NWAVES = 8;
constexpr float EPS = 1e-6f;
constexpr size_t MiB = 1u << 20;
constexpr size_t WS_SS = 0;
constexpr size_t WS_BA = 1 * MiB;
constexpr size_t WS_EG = 5 * MiB;
constexpr size_t WS_WIN = 10 * MiB, WS_WOUT = 16 * MiB, WS_WGU = 18 * MiB, WS_WDN = 30 * MiB, WS_WPG = 36 * MiB, WS_WPL = 38 * MiB;
constexpr size_t WS_PB = 48 * MiB;
constexpr size_t WS_B = 80 * MiB;
constexpr size_t WS_C = 208 * MiB;
constexpr size_t WS_W = WS_C, WS_UT = WS_C + 128 * MiB, WS_QKM = WS_C + 256 * MiB;
constexpr size_t WS_D = 560 * MiB;
constexpr size_t WS_QA = WS_D, WS_KA = WS_D + 64 * MiB, WS_VA = WS_D + 80 * MiB, WS_DQ = WS_D + 96 * MiB, WS_DK = WS_D + 160 * MiB, WS_KT = WS_D + 224 * MiB, WS_VT = WS_D + 288 * MiB, WS_Z = WS_D + 352 * MiB;
constexpr size_t WS_OF = WS_VT, WS_OB = WS_DK, WS_HB1 = WS_D;
constexpr size_t WS_QCTR = 800 * 1024;
constexpr size_t WS_END = 1024 * MiB;
static_assert(WS_Z + 64 * MiB <= WS_END, "ws map");
constexpr int LDS_BYTES = 147456;
constexpr int SAP = 68;

struct Args { const float* in[19]; float* out; unsigned char* ws; int ph_lo, ph_hi; };

struct Frame {
    LAS unsigned char* lds; int tid, lane, wave, vcu, G;
    const float* const* in; float* out; unsigned char* ws;
    __device__ __forceinline__ const float* x() const { return in[0]; }
    __device__ __forceinline__ const float* p() const { return in[1]; }
    __device__ __forceinline__ const float* norm_mix() const { return in[2]; }
    __device__ __forceinline__ const float* w_in() const { return in[3]; }
    __device__ __forceinline__ const float* conv_w() const { return in[4]; }
    __device__ __forceinline__ const float* q_norm() const { return in[5]; }
    __device__ __forceinline__ const float* k_norm() const { return in[6]; }
    __device__ __forceinline__ const float* a_log() const { return in[7]; }
    __device__ __forceinline__ const float* dt_bias() const { return in[8]; }
    __device__ __forceinline__ const float* dn_norm() const { return in[9]; }
    __device__ __forceinline__ const float* w_out() const { return in[10]; }
    __device__ __forceinline__ const float* norm_ffn() const { return in[11]; }
    __device__ __forceinline__ const float* w_gate() const { return in[12]; }
    __device__ __forceinline__ const float* w_up() const { return in[13]; }
    __device__ __forceinline__ const float* w_down() const { return in[14]; }
    __device__ __forceinline__ const float* norm_ple() const { return in[15]; }
    __device__ __forceinline__ const float* w_ple_gate() const { return in[16]; }
    __device__ __forceinline__ const float* w_ple() const { return in[17]; }
    __device__ __forceinline__ const float* norm_final() const { return in[18]; }
    __device__ __forceinline__ float* SS() const { return (float*)(ws + WS_SS); }
    __device__ __forceinline__ float* BA() const { return (float*)(ws + WS_BA); }
    __device__ __forceinline__ float* EG() const { return (float*)(ws + WS_EG); }
    __device__ __forceinline__ unsigned* QCTR() const { return (unsigned*)(ws + WS_QCTR); }
    __device__ __forceinline__ bf16* Wt_in() const { return (bf16*)(ws + WS_WIN); }
    __device__ __forceinline__ bf16* Wt_out() const { return (bf16*)(ws + WS_WOUT); }
    __device__ __forceinline__ bf16* Wt_gu() const { return (bf16*)(ws + WS_WGU); }
    __device__ __forceinline__ bf16* Wt_dn() const { return (bf16*)(ws + WS_WDN); }
    __device__ __forceinline__ bf16* Wt_pg() const { return (bf16*)(ws + WS_WPG); }
    __device__ __forceinline__ bf16* Wt_pl() const { return (bf16*)(ws + WS_WPL); }
    __device__ __forceinline__ bf16* PB() const { return (bf16*)(ws + WS_PB); }
    __device__ __forceinline__ bf16* XN() const { return (bf16*)(ws + WS_B); }
    __device__ __forceinline__ bf16* MIXED() const { return (bf16*)(ws + WS_B); }
    __device__ __forceinline__ bf16* HB2() const { return (bf16*)(ws + WS_B); }
    __device__ __forceinline__ bf16* PROJ() const { return (bf16*)(ws + WS_C); }
    __device__ __forceinline__ bf16* W() const { return (bf16*)(ws + WS_W); }
    __device__ __forceinline__ bf16* UT() const { return (bf16*)(ws + WS_UT); }
    __device__ __forceinline__ bf16* QKM() const { return (bf16*)(ws + WS_QKM); }
    __device__ __forceinline__ bf16* ACT() const { return (bf16*)(ws + WS_C); }
    __device__ __forceinline__ bf16* PE() const { return (bf16*)(ws + WS_C); }
    __device__ __forceinline__ bf16* QA() const { return (bf16*)(ws + WS_QA); }
    __device__ __forceinline__ bf16* KA() const { return (bf16*)(ws + WS_KA); }
    __device__ __forceinline__ bf16* VA() const { return (bf16*)(ws + WS_VA); }
    __device__ __forceinline__ bf16* DQ() const { return (bf16*)(ws + WS_DQ); }
    __device__ __forceinline__ bf16* DK() const { return (bf16*)(ws + WS_DK); }
    __device__ __forceinline__ bf16* KT() const { return (bf16*)(ws + WS_KT); }
    __device__ __forceinline__ bf16* VT() const { return (bf16*)(ws + WS_VT); }
    __device__ __forceinline__ bf16* Z() const { return (bf16*)(ws + WS_Z); }
    __device__ __forceinline__ bf16* OF() const { return (bf16*)(ws + WS_OF); }
    __device__ __forceinline__ bf16* OB() const { return (bf16*)(ws + WS_OB); }
    __device__ __forceinline__ bf16* HB1() const { return (bf16*)(ws + WS_HB1); }
};
#define LDS_FENCE() asm volatile("s_waitcnt lgkmcnt(0)" ::: "memory")
__device__ __forceinline__ unsigned pk2(float lo, float hi) { return attn_body::cvtpk_s(lo, hi); }
__device__ __forceinline__ float bflo(unsigned w) { return __uint_as_float(w << 16); }
__device__ __forceinline__ float bfhi(unsigned w) { return __uint_as_float(w & 0xffff0000u); }
__device__ __forceinline__ float bf2f(short s) { return __uint_as_float(((unsigned)(unsigned short)s) << 16); }
__device__ __forceinline__ bf16 f2bf(float f) { return (bf16)(pk2(f, 0.f) & 0xffffu); }
__device__ __forceinline__ float wave_sum(float v) {
#pragma unroll
    for (int o = 1; o < 64; o <<= 1) v += __shfl_xor(v, o);
    return v;
}
__device__ __forceinline__ int crow(int r, int hi) { return (r & 3) + 8 * (r >> 2) + 4 * hi; }
__device__ __forceinline__ float fast_sig(float v) { return __builtin_amdgcn_rcpf(1.f + __expf(-v)); }
#define MFMA32(a, b, c) __builtin_amdgcn_mfma_f32_32x32x16_bf16((a), (b), (c), 0, 0, 0)

__device__ __forceinline__ void p0_transpose_item(const float* W, int ldw, int K, int ncols, int nvalid, bf16* WT, int rb, int rstride, int roff, const float* gain, LAS float* scr, int item, int lane) {
    const int nblk = ncols / 32, kb = item / nblk, nb = item % nblk, k0 = 64 * kb, n0 = 32 * nb;
    float tv[32];
#pragma unroll
    for (int i = 0; i < 32; ++i) { const int kk = 2 * i + (lane >> 5), n = n0 + (lane & 31); tv[i] = (n < nvalid) ? W[(size_t)(k0 + kk) * ldw + n] : 0.f; }
#pragma unroll
    for (int i = 0; i < 32; ++i) { const int kk = 2 * i + (lane >> 5); float v = tv[i]; if (gain) v *= gain[k0 + kk]; scr[kk * 33 + (lane & 31)] = v; }
    LDS_FENCE();
    const int c = lane & 7;
#pragma unroll
    for (int j = 0; j < 4; ++j) { const int nl = (lane >> 3) + 8 * j, n = n0 + nl; const LAS float* s = scr + (8 * c) * 33 + nl;
        v4u o; o.x = pk2(s[0 * 33], s[1 * 33]); o.y = pk2(s[2 * 33], s[3 * 33]); o.z = pk2(s[4 * 33], s[5 * 33]); o.w = pk2(s[6 * 33], s[7 * 33]);
        const int drow = (n / rb) * rstride + roff + (n % rb);
        *(v4u*)(WT + (size_t)drow * K + k0 + 8 * c) = o; }
    LDS_FENCE();
}
__device__ __forceinline__ void p0_prologue(Frame& F) {
    LAS float* scr = (LAS float*)(F.lds + F.wave * 16384);
    const int gw = F.vcu * NWAVES + F.wave, NGW = F.G * NWAVES;
    constexpr int I_IN = 16 * (NPAD / 32), I_OUT = 16 * 32, I_G = 16 * (FF / 32), I_DN = (FF / 64) * 32, I_PG = 16 * 32, I_PL = 4 * 32;
    constexpr int NITEMS = I_IN + I_OUT + 2 * I_G + I_DN + I_PG + I_PL;
    constexpr int BIG = 1 << 30;
    for (int it = gw; it < NITEMS; it += NGW) {
        int r = it;
        if (r < I_IN) { p0_transpose_item(F.w_in(), 2832, 1024, NPAD, 2832, F.Wt_in(), BIG, 0, 0, nullptr, scr, r, F.lane); continue; } r -= I_IN;
        if (r < I_OUT) { p0_transpose_item(F.w_out(), 1024, 1024, 1024, 1024, F.Wt_out(), BIG, 0, 0, nullptr, scr, r, F.lane); continue; } r -= I_OUT;
        if (r < I_G) { p0_transpose_item(F.w_gate(), FF, 1024, FF, FF, F.Wt_gu(), 128, 256, 0, F.norm_ffn(), scr, r, F.lane); continue; } r -= I_G;
        if (r < I_G) { p0_transpose_item(F.w_up(), FF, 1024, FF, FF, F.Wt_gu(), 128, 256, 128, F.norm_ffn(), scr, r, F.lane); continue; } r -= I_G;
        if (r < I_DN) { p0_transpose_item(F.w_down(), 1024, FF, 1024, 1024, F.Wt_dn(), BIG, 0, 0, nullptr, scr, r, F.lane); continue; } r -= I_DN;
        if (r < I_PG) { p0_transpose_item(F.w_ple_gate(), 1024, 1024, 1024, 1024, F.Wt_pg(), BIG, 0, 0, F.norm_ple(), scr, r, F.lane); continue; } r -= I_PG;
        p0_transpose_item(F.w_ple(), 1024, 256, 1024, 1024, F.Wt_pl(), BIG, 0, 0, nullptr, scr, r, F.lane);
    }
    f32x4 gn[4];
#pragma unroll
    for (int j = 0; j < 4; ++j) gn[j] = ((const f32x4*)F.norm_mix())[F.lane + 64 * j];
    for (int m0 = gw * 4; m0 < M; m0 += NGW * 4) { f32x4 v[4][4];
#pragma unroll
        for (int r = 0; r < 4; ++r) { const f32x4* xr = (const f32x4*)(F.x() + (size_t)(m0 + r) * DM) + F.lane;
#pragma unroll
            for (int j = 0; j < 4; ++j) v[r][j] = xr[64 * j]; }
#pragma unroll
        for (int r = 0; r < 4; ++r) { float s = 0.f;
#pragma unroll
            for (int j = 0; j < 4; ++j) s += (v[r][j].x * v[r][j].x + v[r][j].y * v[r][j].y) + (v[r][j].z * v[r][j].z + v[r][j].w * v[r][j].w);
            const float rstd = rsqrtf(wave_sum(s) * (1.f / DM) + EPS); v2u* o8 = (v2u*)(F.XN() + (size_t)(m0 + r) * DM) + F.lane;
#pragma unroll
            for (int j = 0; j < 4; ++j) { const f32x4 y = v[r][j] * rstd * gn[j]; v2u w; w.x = pk2(y.x, y.y); w.y = pk2(y.z, y.w); o8[64 * j] = w; } }
    }
    const size_t gt = (size_t)F.vcu * 512 + F.tid, NGT = (size_t)F.G * 512;
    for (size_t i = gt; i < (size_t)M * 256 / 4; i += NGT * 4) { f32x4 v[4];
#pragma unroll
        for (int k = 0; k < 4; ++k) if (i + k * NGT < (size_t)M * 256 / 4) v[k] = ((const f32x4*)F.p())[i + k * NGT];
#pragma unroll
        for (int k = 0; k < 4; ++k) if (i + k * NGT < (size_t)M * 256 / 4) { v2u w; w.x = pk2(v[k].x, v[k].y); w.y = pk2(v[k].z, v[k].w); ((v2u*)F.PB())[i + k * NGT] = w; } }
    for (size_t i = gt; i < (size_t)3 * M; i += NGT) F.SS()[i] = 0.f;
    if (gt < 8 * 64 || (gt >= 600 && gt < 832)) F.QCTR()[gt] = 0u;
}

constexpr int P2_TAB_BYTES = 192 * 16 * 8;
__device__ __forceinline__ void p2_rope_table(Frame& F) {
    LAS float* tab = (LAS float*)F.lds;
    for (int i = F.tid; i < 192 * 16; i += NWAVES * 64) { const int pos = i >> 4, j = i & 15; const float inv = powf(10000.0f, -(float)j * (1.f / 16.f));
        float s, c; sincosf((float)(pos < 128 ? pos : pos - 128) * inv, &s, &c); tab[2 * i] = c; tab[2 * i + 1] = s; }
    LDS_FENCE(); __syncthreads();
}
__device__ __forceinline__ void p2_attn_rows(Frame& F) {
    const int gw = F.vcu * NWAVES + F.wave, NGW = F.G * NWAVES, lane = F.lane;
    constexpr float C2 = 0.125f * 1.4426950408889634f;
    const LAS float* tab = (const LAS float*)F.lds;
    const bf16* __restrict__ PROJ = F.PROJ(); bf16* __restrict__ QA = F.QA(); bf16* __restrict__ KA = F.KA(); bf16* __restrict__ VA = F.VA(); bf16* __restrict__ Z = F.Z();
    float gq[4], gk[4];
#pragma unroll
    for (int k = 0; k < 4; ++k) { gq[k] = F.q_norm()[(lane & 15) + 16 * k]; gk[k] = F.k_norm()[(lane & 15) + 16 * k]; }
    for (int m0 = gw * 4; m0 < M; m0 += NGW * 4) {
        bf16 xr[4][3][4]; unsigned vv[4]; v4u zz[4];
#pragma unroll
        for (int rr = 0; rr < 4; ++rr) { const bf16* pr = PROJ + (size_t)(m0 + rr) * NPROJ;
#pragma unroll
            for (int it = 0; it < 3; ++it) { const int idx = it * 64 + lane, head = idx >> 4, j = idx & 15;
                if (head < 10) { const bf16* hp = pr + head * 64 + j;
#pragma unroll
                    for (int k = 0; k < 4; ++k) xr[rr][it][k] = hp[16 * k]; } }
            vv[rr] = ((const unsigned*)(pr + 640))[lane]; zz[rr] = ((const v4u*)(pr + 2304))[lane]; }
#pragma unroll
        for (int rr = 0; rr < 4; ++rr) { const int m = m0 + rr, s = m & (SEQ - 1), prow = s >> 6, pcol = 128 + (s & 63);
#pragma unroll
            for (int it = 0; it < 3; ++it) { const int idx = it * 64 + lane, head = idx >> 4, j = idx & 15;
                if (head < 10) {
                    float x0 = __uint_as_float((unsigned)xr[rr][it][0] << 16), x1 = __uint_as_float((unsigned)xr[rr][it][1] << 16), x2 = __uint_as_float((unsigned)xr[rr][it][2] << 16), x3 = __uint_as_float((unsigned)xr[rr][it][3] << 16);
                    float ss = (x0 * x0 + x1 * x1) + (x2 * x2 + x3 * x3);
                    ss += __shfl_xor(ss, 1); ss += __shfl_xor(ss, 2); ss += __shfl_xor(ss, 4); ss += __shfl_xor(ss, 8);
                    const float rs = rsqrtf(ss * (1.f / 64.f) + EPS); const bool isq = head < 8;
                    x0 *= rs * (isq ? gq[0] : gk[0]); x1 *= rs * (isq ? gq[1] : gk[1]); x2 *= rs * (isq ? gq[2] : gk[2]); x3 *= rs * (isq ? gq[3] : gk[3]);
                    const float cr = tab[(prow * 16 + j) * 2], sr = tab[(prow * 16 + j) * 2 + 1], cc = tab[(pcol * 16 + j) * 2], sc = tab[(pcol * 16 + j) * 2 + 1];
                    float o0 = x0 * cr - x1 * sr, o1 = x1 * cr + x0 * sr, o2 = x2 * cc - x3 * sc, o3 = x3 * cc + x2 * sc;
                    bf16* op;
                    if (isq) { o0 *= C2; o1 *= C2; o2 *= C2; o3 *= C2; op = QA + (size_t)m * 512 + head * 64 + j; } else op = KA + (size_t)m * 128 + (head - 8) * 64 + j;
                    op[0] = f2bf(o0); op[16] = f2bf(o1); op[32] = f2bf(o2); op[48] = f2bf(o3);
                } }
            ((unsigned*)(VA + (size_t)m * 128))[lane] = vv[rr]; ((v4u*)(Z + (size_t)m * 512))[lane] = zz[rr]; }
    }
}
struct ConvIn { unsigned u[12]; float w0[5], w1[5]; };
__device__ __forceinline__ void p2_conv_load(Frame& F, int item, ConvIn& C, int lane, int wid) {
    const int type = item % 3, h4 = (item / 3) & 3, n = (item / 12) & 127, b = item / (12 * 128); const int ch = type * 512 + h4 * 128 + 2 * lane;
    const bf16* src = F.PROJ() + (size_t)b * SEQ * NPROJ + 768 + ch; const int s0 = n * 64 + 8 * wid - 2;
#pragma unroll
    for (int k = 0; k < 12; ++k) { const int s = s0 + k; C.u[k] = (s >= 0 && s < SEQ) ? *(const unsigned*)(src + (size_t)s * NPROJ) : 0u; }
#pragma unroll
    for (int j = 0; j < 5; ++j) { C.w0[j] = F.conv_w()[j * 1536 + ch]; C.w1[j] = F.conv_w()[j * 1536 + ch + 1]; }
}
__device__ __forceinline__ void p2_dn_conv(Frame& F) {
    const int lane = F.lane, wid = F.wave; constexpr int NIT = NB * 128 * 12;
    ConvIn C, Cn; int item = F.vcu; if (item < NIT) p2_conv_load(F, item, C, lane, wid);
    for (; item < NIT; item += F.G) {
        const int type = item % 3, h4 = (item / 3) & 3, n = (item / 12) & 127, b = item / (12 * 128);
        if (item + F.G < NIT) p2_conv_load(F, item + F.G, Cn, lane, wid);
        float y0[8], y1[8];
#pragma unroll
        for (int i = 0; i < 8; ++i) { float a0 = 0.f, a1 = 0.f;
#pragma unroll
            for (int j = 0; j < 5; ++j) { a0 += C.w0[j] * bflo(C.u[i + j]); a1 += C.w1[j] * bfhi(C.u[i + j]); }
            a0 = a0 * fast_sig(a0); a1 = a1 * fast_sig(a1);
            if (type < 2) { const float ss = wave_sum(a0 * a0 + a1 * a1); float rs = rsqrtf(ss + EPS); if (type == 0) rs *= 0.08838834764831845f; a0 *= rs; a1 *= rs; }
            y0[i] = a0; y1[i] = a1; }
        const size_t row0 = (size_t)b * SEQ + n * 64 + 8 * wid;
        if (type < 2) { bf16* dst = (type == 0 ? F.DQ() : F.DK()) + row0 * 512 + h4 * 128 + 2 * lane;
#pragma unroll
            for (int i = 0; i < 8; ++i) *(unsigned*)(dst + (size_t)i * 512) = pk2(y0[i], y1[i]); }
        if (type != 0) {
            bf16* dst = (type == 1 ? F.KT() : F.VT()) + ((size_t)(b * 4 + h4) * 128 + n) * 8192 + (size_t)(2 * lane) * 64 + 8 * wid;
            v4u o0, o1; o0.x = pk2(y0[0], y0[1]); o0.y = pk2(y0[2], y0[3]); o0.z = pk2(y0[4], y0[5]); o0.w = pk2(y0[6], y0[7]);
            o1.x = pk2(y1[0], y1[1]); o1.y = pk2(y1[2], y1[3]); o1.z = pk2(y1[4], y1[5]); o1.w = pk2(y1[6], y1[7]);
            *(v4u*)dst = o0; *(v4u*)(dst + 64) = o1; }
        C = Cn;
    }
}
__device__ __forceinline__ bf16x8 ld8(const bf16* p) { return *(const bf16x8*)p; }
__device__ __forceinline__ bf16x8 ld44(const bf16* p) { const s16x4 a = *(const s16x4*)p, b = *(const s16x4*)(p + 8); return (bf16x8){a[0], a[1], a[2], a[3], b[0], b[1], b[2], b[3]}; }
__device__ __forceinline__ bf16x8 pack8(float a0, float a1, float a2, float a3, float a4, float a5, float a6, float a7) {
    v4u w; w.x = pk2(a0, a1); w.y = pk2(a2, a3); w.z = pk2(a4, a5); w.w = pk2(a6, a7); return __builtin_bit_cast(bf16x8, w); }
__device__ __forceinline__ void dn_prep_item(Frame& F, int item, LAS float* SA, LAS float* sv, int lane) {
    const int n = item & 127, h8 = (item >> 7) & 7, b = item >> 10, dir = h8 >> 2, h4 = h8 & 3;
    const size_t tok0 = (size_t)b * SEQ + n * 64; const int r32 = lane & 31, hi = lane >> 5;
    const bf16* Kp = F.DK() + (tok0 + r32) * 512 + h4 * 128 + 8 * hi; const bf16* Qp = F.DQ() + (tok0 + r32) * 512 + h4 * 128 + 8 * hi;
    bf16x8 kf[2][8], qf[8];
#pragma unroll
    for (int kb = 0; kb < 8; ++kb) { kf[0][kb] = ld8(Kp + 16 * kb); kf[1][kb] = ld8(Kp + (size_t)32 * 512 + 16 * kb); qf[kb] = ld8(Qp + 16 * kb); }
    { const float* ba = F.BA() + (tok0 + lane) * 16; const float braw = ba[h8], araw = ba[8 + h8];
      const float beta = 1.f / (1.f + __expf(-braw)); const float xx = araw + F.dt_bias()[h8];
      const float sp = fmaxf(xx, 0.f) + log1pf(__expf(-fabsf(xx))); const float g = -__expf(F.a_log()[h8]) * sp;
      float gc = dir ? __shfl(g, 63 - lane) : g;
#pragma unroll
      for (int o = 1; o < 64; o <<= 1) { const float t = __shfl_up(gc, o); if (lane >= o) gc += t; }
      const float Gtot = __shfl(gc, 63); const float G = dir ? __shfl(gc, 63 - lane) : gc; const float eg = __expf(G);
      sv[lane] = G; sv[64 + lane] = beta; sv[128 + lane] = beta * eg;
      F.EG()[(size_t)item * 128 + lane] = eg; F.EG()[(size_t)item * 128 + 64 + lane] = __expf(Gtot - G); }
    LDS_FENCE();
#ifdef PROBE_SUB
    unsigned long long t_a = __builtin_amdgcn_s_memrealtime();
#endif
#pragma unroll
    for (int ti = 0; ti < 2; ++ti)
#pragma unroll
        for (int tj = 0; tj < 2; ++tj) { f32x16 acc = {}, acq = {}; int r32c = r32, hic = hi; asm volatile("" : "+v"(r32c), "+v"(hic));
#pragma unroll
            for (int kb = 0; kb < 8; ++kb) { acc = MFMA32(kf[tj][kb], kf[ti][kb], acc); acq = MFMA32(kf[tj][kb], qf[kb], acq); }
            if (ti == 0 && tj == 1) {
#pragma unroll
                for (int kb = 0; kb < 8; ++kb) qf[kb] = ld8(Qp + (size_t)32 * 512 + 16 * kb); }
            const int i = 32 * ti + r32c, ci = dir ? 63 - i : i; const float Gi = sv[i], bi = sv[64 + i]; float qv[16];
#pragma unroll
            for (int r = 0; r < 16; ++r) { const int j = 32 * tj + crow(r, hic), cj = dir ? 63 - j : j; const float dec = __expf(fminf(Gi - sv[j], 0.f));
                SA[ci * SAP + cj] = (ci > cj) ? bi * acc[r] * dec : 0.f; qv[r] = (ci >= cj) ? acq[r] * dec : 0.f; }
            bf16* qp = F.QKM() + (size_t)item * 4096 + i * 64 + 32 * tj + 4 * hic;
#pragma unroll
            for (int q = 0; q < 4; ++q) { v2u w; w.x = pk2(qv[4 * q], qv[4 * q + 1]); w.y = pk2(qv[4 * q + 2], qv[4 * q + 3]); *(v2u*)(qp + 8 * q) = w; }
            asm volatile("" ::: "memory"); }
    LDS_FENCE();
#ifdef PROBE_SUB
    unsigned long long t_b = __builtin_amdgcn_s_memrealtime();
#endif
    const bf16* VTp = F.VT() + ((size_t)(b * 4 + h4) * 128 + n) * 8192 + r32 * 64 + 8 * hi; const bf16* KTp = F.KT() + ((size_t)(b * 4 + h4) * 128 + n) * 8192 + r32 * 64 + 8 * hi;
    bf16x8 xf[4][4];
#pragma unroll
    for (int td = 0; td < 4; ++td)
#pragma unroll
        for (int kb = 0; kb < 4; ++kb) xf[td][kb] = ld8(VTp + td * 2048 + 16 * kb);
    asm volatile("" ::: "memory");
    { float T[64];
#if defined(DUP_PH) && DUP_PH == 33
      for (int rep33 = 0; rep33 < 2; ++rep33)
#endif
#pragma unroll
      for (int i = 0; i < 64; ++i) { float a = (lane == i) ? 1.f : 0.f, a2 = 0.f;
#pragma unroll
          for (int jq = 0; jq * 4 < i; ++jq) { const f32x4 a4 = *(const LAS f32x4*)(SA + i * SAP + 4 * jq);
              a -= a4.x * T[4 * jq]; if (4 * jq + 1 < i) a2 -= a4.y * T[4 * jq + 1]; if (4 * jq + 2 < i) a -= a4.z * T[4 * jq + 2]; if (4 * jq + 3 < i) a2 -= a4.w * T[4 * jq + 3];
              if ((jq & 3) == 3) asm volatile("" ::: "memory"); }
          T[i] = a + a2; asm volatile("" ::: "memory"); }
      LDS_FENCE();
#pragma unroll
      for (int i = 0; i < 64; ++i) SA[i * SAP + lane] = T[i]; }
    LDS_FENCE();
#ifdef PROBE_SUB
    unsigned long long t_c = __builtin_amdgcn_s_memrealtime();
#endif
    int r32b = r32, hib = hi; asm volatile("" : "+v"(r32b), "+v"(hib));
#if defined(DUP_PH) && DUP_PH == 35
    for (int rep35 = 0; rep35 < 2; ++rep35)
#endif
#pragma unroll
    for (int pass = 0; pass < 2; ++pass) {
        bf16x8 tb[2][4]; asm volatile("" : "+v"(r32b), "+v"(hib));
#pragma unroll
        for (int ti = 0; ti < 2; ++ti) { const int i = 32 * ti + r32b, ci = dir ? 63 - i : i;
#pragma unroll
            for (int kb = 0; kb < 4; ++kb) { float a[8];
#pragma unroll
                for (int e = 0; e < 8; ++e) { const int j = 16 * kb + 8 * hib + e, cj = dir ? 63 - j : j; a[e] = SA[ci * SAP + cj] * sv[64 + 64 * pass + j]; }
                tb[ti][kb] = pack8(a[0], a[1], a[2], a[3], a[4], a[5], a[6], a[7]); asm volatile("" ::: "memory"); } }
#pragma unroll
        for (int td = 0; td < 4; ++td) { f32x16 a0 = {}, a1 = {}; asm volatile("" : "+v"(r32b), "+v"(hib));
            if (pass == 0) {
#pragma unroll
                for (int kb = 0; kb < 4; ++kb) { a0 = MFMA32(tb[0][kb], xf[td][kb], a0); a1 = MFMA32(tb[1][kb], xf[td][kb], a1); }
#pragma unroll
                for (int kb = 0; kb < 4; ++kb) xf[td][kb] = ld8(KTp + td * 2048 + 16 * kb);
                bf16* up = F.UT() + (size_t)item * 8192 + (32 * td + r32b) * 64 + 4 * hib;
#pragma unroll
                for (int q = 0; q < 4; ++q) { v2u w; w.x = pk2(a0[4 * q], a0[4 * q + 1]); w.y = pk2(a0[4 * q + 2], a0[4 * q + 3]); *(v2u*)(up + 8 * q) = w;
                    v2u w1; w1.x = pk2(a1[4 * q], a1[4 * q + 1]); w1.y = pk2(a1[4 * q + 2], a1[4 * q + 3]); *(v2u*)(up + 32 + 8 * q) = w1; }
            } else {
#pragma unroll
                for (int kb = 0; kb < 4; ++kb) { a0 = MFMA32(xf[td][kb], tb[0][kb], a0); a1 = MFMA32(xf[td][kb], tb[1][kb], a1); }
                bf16* wp = F.W() + (size_t)item * 8192 + r32b * 128 + 32 * td + 4 * hib;
#pragma unroll
                for (int q = 0; q < 4; ++q) { v2u w; w.x = pk2(a0[4 * q], a0[4 * q + 1]); w.y = pk2(a0[4 * q + 2], a0[4 * q + 3]); *(v2u*)(wp + 8 * q) = w;
                    v2u w1; w1.x = pk2(a1[4 * q], a1[4 * q + 1]); w1.y = pk2(a1[4 * q + 2], a1[4 * q + 3]); *(v2u*)(wp + 32 * 128 + 8 * q) = w1; }
            }
            asm volatile("" ::: "memory"); }
    }
    LDS_FENCE();
#ifdef PROBE_SUB
    { asm volatile("s_waitcnt vmcnt(0)" ::: "memory"); unsigned long long t_d = __builtin_amdgcn_s_memrealtime();
      if (blockIdx.x == 0 && F.wave == 0 && lane == 0) { unsigned long long* ts = (unsigned long long*)(F.QCTR() + 1024); const unsigned long long d = (PROBE_SUB == 1) ? (t_b - t_a) : (PROBE_SUB == 2) ? (t_c - t_b) : (t_d - t_c);
          ts[13] = ((item >> 11) == 0 && (item & 2047) < 8 ? 0ull : ts[13]) + d; ts[12] = 0ull; } }
#endif
}
constexpr int SC_W = 0, SC_Q = 16896, SC_KT = 33792, SC_QK = 51200, SC_EG = 59904, SC_BUF = 60416, SC_PW = 264, SC_PK = 136;
#define SC_BAR() asm volatile("s_waitcnt lgkmcnt(0)\n\ts_barrier" ::: "memory")
__device__ __forceinline__ bf16x8 lds44(const LAS unsigned char* p) { const s16x4 a = *(const LAS s16x4*)p, b = *(const LAS s16x4*)(p + 16); return (bf16x8){a[0], a[1], a[2], a[3], b[0], b[1], b[2], b[3]}; }
__device__ __forceinline__ void lds_put16(LAS unsigned char* p, v4u v) { *(LAS v2u*)p = (v2u){v.x, v.y}; *(LAS v2u*)(p + 8) = (v2u){v.z, v.w}; }
struct ScanRegs { v4u w[4], q[4], k[4], m[2], e; };
__device__ __forceinline__ void scan_load(Frame& F, ScanRegs& R, int lt, size_t it, size_t tok0, int h4, size_t ktoff) {
#pragma unroll
    for (int k = 0; k < 4; ++k) { const int c = lt + 256 * k;
        R.w[k] = *(const v4u*)(F.W() + it * 8192 + c * 8);
        R.q[k] = *(const v4u*)(F.DQ() + (tok0 + (c >> 4)) * 512 + h4 * 128 + (c & 15) * 8);
        R.k[k] = *(const v4u*)(F.KT() + ktoff + c * 8); }
#pragma unroll
    for (int k = 0; k < 2; ++k) R.m[k] = *(const v4u*)(F.QKM() + it * 4096 + (lt + 256 * k) * 8);
    if (lt < 32) R.e = *(const v4u*)(F.EG() + it * 128 + lt * 4);
}
__device__ __forceinline__ void scan_put(const ScanRegs& R, LAS unsigned char* buf, int lt) {
#pragma unroll
    for (int k = 0; k < 4; ++k) { const int c = lt + 256 * k;
        lds_put16(buf + SC_W + (c >> 4) * SC_PW + (c & 15) * 16, R.w[k]); lds_put16(buf + SC_Q + (c >> 4) * SC_PW + (c & 15) * 16, R.q[k]); lds_put16(buf + SC_KT + (c >> 3) * SC_PK + (c & 7) * 16, R.k[k]); }
#pragma unroll
    for (int k = 0; k < 2; ++k) { const int c = lt + 256 * k; lds_put16(buf + SC_QK + (c >> 3) * SC_PK + (c & 7) * 16, R.m[k]); }
    if (lt < 32) lds_put16(buf + SC_EG + lt * 16, R.e);
}
__device__ __forceinline__ void dn_scan_wg(Frame& F, int bh8) {
    const int h8 = bh8 & 7, b = bh8 >> 3, dir = h8 >> 2, h4 = h8 & 3; const int lane = F.lane, r32 = lane & 31, hi = lane >> 5, wid = F.wave;
#define SC_N(s) (dir ? 127 - (s) : (s))
#define SC_IT(s) ((size_t)bh8 * 128 + SC_N(s))
#define SC_TOK(s) ((size_t)b * SEQ + SC_N(s) * 64)
#define SC_KTO(s) (((size_t)(b * 4 + h4) * 128 + SC_N(s)) * 8192)
    if (wid >= 4) {
        const int lt = F.tid - 256; ScanRegs R;
        scan_load(F, R, lt, SC_IT(0), SC_TOK(0), h4, SC_KTO(0)); scan_put(R, F.lds, lt);
        scan_load(F, R, lt, SC_IT(1), SC_TOK(1), h4, SC_KTO(1));
        SC_BAR();
        for (int s = 0; s < 128; ++s) {
            if (s + 1 < 128) scan_put(R, F.lds + ((s + 1) & 1) * SC_BUF, lt);
            if (s + 2 < 128) scan_load(F, R, lt, SC_IT(s + 2), SC_TOK(s + 2), h4, SC_KTO(s + 2));
            SC_BAR(); }
    } else {
        const int sl = wid; f32x16 S[4];
#pragma unroll
        for (int t = 0; t < 4; ++t) S[t] = (f32x16){};
        bf16* Obase = (dir ? F.OB() : F.OF()) + h4 * 128 + 32 * sl + 4 * hi;
        const bf16* UTb = F.UT() + (size_t)(32 * sl + r32) * 64 + 4 * hi;
        s16x4 ut[8];
#pragma unroll
        for (int q = 0; q < 8; ++q) ut[q] = *(const s16x4*)(UTb + SC_IT(0) * 8192 + 8 * q);
        SC_BAR();
        for (int s = 0; s < 128; ++s) {
            const LAS unsigned char* buf = F.lds + (s & 1) * SC_BUF; const size_t tok0 = SC_TOK(s);
            const LAS unsigned char* aW = buf + SC_W + r32 * SC_PW + 8 * hi; const LAS unsigned char* aQ = buf + SC_Q + r32 * SC_PW + 8 * hi;
            const LAS unsigned char* aK = buf + SC_KT + r32 * SC_PK + 8 * hi; const LAS unsigned char* aM = buf + SC_QK + r32 * SC_PK + 8 * hi;
            const LAS float* eg = (const LAS float*)(buf + SC_EG);
            bf16x8 Sb[8];
#pragma unroll
            for (int kb = 0; kb < 8; ++kb) { const int tk = kb >> 1, rb = 8 * (kb & 1); Sb[kb] = pack8(S[tk][rb], S[tk][rb + 1], S[tk][rb + 2], S[tk][rb + 3], S[tk][rb + 4], S[tk][rb + 5], S[tk][rb + 6], S[tk][rb + 7]); }
            f32x16 vn[2];
            { f32x16 a0 = {}, a1 = {};
#pragma unroll
              for (int kb = 0; kb < 8; ++kb) { a0 = MFMA32(lds44(aW + 32 * kb), Sb[kb], a0); a1 = MFMA32(lds44(aW + 32 * SC_PW + 32 * kb), Sb[kb], a1); }
#pragma unroll
              for (int q = 0; q < 4; ++q)
#pragma unroll
                  for (int e = 0; e < 4; ++e) { a0[4 * q + e] = bf2f(ut[q][e]) - a0[4 * q + e]; a1[4 * q + e] = bf2f(ut[4 + q][e]) - a1[4 * q + e]; }
              vn[0] = a0; vn[1] = a1; }
            if (s + 1 < 128) {
#pragma unroll
                for (int q = 0; q < 8; ++q) ut[q] = *(const s16x4*)(UTb + SC_IT(s + 1) * 8192 + 8 * q); }
            bf16x8 vb[4];
#pragma unroll
            for (int k2 = 0; k2 < 4; ++k2) { const int tc = k2 >> 1, rb = 8 * (k2 & 1);
                vb[k2] = pack8(vn[tc][rb], vn[tc][rb + 1], vn[tc][rb + 2], vn[tc][rb + 3], vn[tc][rb + 4], vn[tc][rb + 5], vn[tc][rb + 6], vn[tc][rb + 7]); }
            { f32x16 o0 = {}, o1 = {};
#pragma unroll
              for (int kb = 0; kb < 8; ++kb) { o0 = MFMA32(Sb[kb], lds44(aQ + 32 * kb), o0); o1 = MFMA32(Sb[kb], lds44(aQ + 32 * SC_PW + 32 * kb), o1); }
              o0 = o0 * eg[r32]; o1 = o1 * eg[32 + r32];
#pragma unroll
              for (int k2 = 0; k2 < 4; ++k2) { o0 = MFMA32(vb[k2], lds44(aM + 32 * k2), o0); o1 = MFMA32(vb[k2], lds44(aM + 32 * SC_PK + 32 * k2), o1); }
              bf16* op = Obase + (tok0 + r32) * 512;
#pragma unroll
              for (int q = 0; q < 4; ++q) { v2u w; w.x = pk2(o0[4 * q], o0[4 * q + 1]); w.y = pk2(o0[4 * q + 2], o0[4 * q + 3]); *(v2u*)(op + 8 * q) = w;
                  v2u w1; w1.x = pk2(o1[4 * q], o1[4 * q + 1]); w1.y = pk2(o1[4 * q + 2], o1[4 * q + 3]); *(v2u*)(op + 32 * 512 + 8 * q) = w1; } }
            const float gtot = eg[dir ? 0 : 63];
#pragma unroll
            for (int tk = 0; tk < 4; ++tk) S[tk] = S[tk] * gtot;
#pragma unroll
            for (int k2 = 0; k2 < 4; ++k2) { const int tc = k2 >> 1, rb = 8 * (k2 & 1); float l[8];
#pragma unroll
                for (int h = 0; h < 2; ++h) { const f32x4 l4 = *(const LAS f32x4*)(eg + 64 + 32 * tc + 8 * (2 * (k2 & 1) + h) + 4 * hi);
#pragma unroll
                    for (int e = 0; e < 4; ++e) l[4 * h + e] = l4[e]; }
                const bf16x8 vsb = pack8(vn[tc][rb] * l[0], vn[tc][rb + 1] * l[1], vn[tc][rb + 2] * l[2], vn[tc][rb + 3] * l[3], vn[tc][rb + 4] * l[4], vn[tc][rb + 5] * l[5], vn[tc][rb + 6] * l[6], vn[tc][rb + 7] * l[7]);
#pragma unroll
                for (int tk = 0; tk < 4; ++tk) S[tk] = MFMA32(lds44(aK + tk * 32 * SC_PK + 32 * k2), vsb, S[tk]); }
            SC_BAR();
        }
    }
#undef SC_N
#undef SC_IT
#undef SC_TOK
#undef SC_KTO
}
struct DynOrder {
    unsigned* ctr; int xcd; LAS unsigned* slot;
    __device__ __forceinline__ bool next(int, attn_body::AttnUnit& u) const {
        if (threadIdx.x == 0) { unsigned v = 0xffffffffu;
            for (int k = 0; k < 8; ++k) { const int x = (xcd + k) & 7; const unsigned t = __hip_atomic_fetch_add(ctr + 64 * x, 1u, __ATOMIC_RELAXED, __HIP_MEMORY_SCOPE_AGENT); if (t < 256u) { v = (unsigned)x | (t << 3); break; } }
            *slot = v; }
        asm volatile("s_waitcnt vmcnt(0) lgkmcnt(0)\n\ts_barrier" ::: "memory");
        const unsigned v = *slot;
        asm volatile("s_waitcnt lgkmcnt(0)\n\ts_barrier" ::: "memory");
        if (v == 0xffffffffu) return false;
        const unsigned x = v & 7u, t = v >> 3; u.bh = (int)(x + 8u * (t >> 5)); u.qb = (int)(t & 31u); return true; }
    __device__ __forceinline__ void a_ready(const attn_body::AttnUnit&) const {}
    __device__ __forceinline__ void done(const attn_body::AttnUnit&) const {}
};
__device__ __forceinline__ void p5_mix_chunk(Frame& F, const int tok0) {
    const int lane = F.lane;
    const float g0 = F.dn_norm()[2 * lane], g1 = F.dn_norm()[2 * lane + 1];
    const bf16* __restrict__ OFp = F.OF(); const bf16* __restrict__ OBp = F.OB(); const bf16* __restrict__ Zp = F.Z(); bf16* __restrict__ MX = F.MIXED();
    for (int t0 = tok0 + 2 * F.wave; t0 < tok0 + 64; t0 += 2 * NWAVES) { unsigned a[8], c[8], z[8];
#pragma unroll
        for (int k = 0; k < 8; ++k) { const size_t off = (size_t)(t0 + (k >> 2)) * 512 + (k & 3) * 128 + 2 * lane; a[k] = *(const unsigned*)(OFp + off); c[k] = *(const unsigned*)(OBp + off); z[k] = *(const unsigned*)(Zp + off); }
#pragma unroll
        for (int k = 0; k < 8; ++k) { const float o0 = bflo(a[k]) + bflo(c[k]), o1 = bfhi(a[k]) + bfhi(c[k]); const float rs = rsqrtf(wave_sum(o0 * o0 + o1 * o1) * (1.f / 128.f) + EPS);
            const float z0 = bflo(z[k]), z1 = bfhi(z[k]);
            *(unsigned*)(MX + (size_t)(t0 + (k >> 2)) * 1024 + 512 + (k & 3) * 128 + 2 * lane) = pk2(o0 * rs * g0 * z0 * fast_sig(z0), o1 * rs * g1 * z1 * fast_sig(z1)); } }
}
__device__ __forceinline__ void p10_final(Frame& F, const float probe_delta) {
    const int gw = F.vcu * NWAVES + F.wave, NGW = F.G * NWAVES;
    f32x4 gn[4];
#pragma unroll
    for (int j = 0; j < 4; ++j) gn[j] = ((const f32x4*)F.norm_final())[F.lane + 64 * j];
    for (int m0 = gw * 4; m0 < M; m0 += NGW * 4) { v2u v[4][4]; float sq[4];
#pragma unroll
        for (int r = 0; r < 4; ++r) { const v2u* xr = (const v2u*)(F.HB1() + (size_t)(m0 + r) * DM) + F.lane; sq[r] = F.SS()[2 * M + m0 + r];
#pragma unroll
            for (int j = 0; j < 4; ++j) v[r][j] = xr[64 * j]; }
#pragma unroll
        for (int r = 0; r < 4; ++r) { f32x4* xr = (f32x4*)(F.out + (size_t)(m0 + r) * DM) + F.lane; const float rstd = rsqrtf(sq[r] * (1.f / DM) + EPS); const int m = m0 + r;
#pragma unroll
            for (int j = 0; j < 4; ++j) { f32x4 y = (f32x4){bflo(v[r][j].x), bfhi(v[r][j].x), bflo(v[r][j].y), bfhi(v[r][j].y)} * rstd * gn[j]; if (probe_delta != 0.f && m < 1024) y = y + probe_delta; __builtin_nontemporal_store(y, &xr[64 * j]);
#ifdef PROBE_DUPWRITE
                __builtin_nontemporal_store(y, (f32x4*)((float*)(F.ws + WS_C) + (size_t)m * DM) + F.lane + 64 * j);
#endif
#ifdef PROBE_DUPOUT
                asm volatile("" ::: "memory"); __builtin_nontemporal_store(y, &xr[64 * j]);
#endif
            } } }
}
constexpr int N_PHASES = 11;
__global__ void __launch_bounds__(NWAVES * 64, 2) hymba_fwd(Args args) {
    extern __shared__ __attribute__((aligned(16))) unsigned char lds[];
    cg::grid_group grid = cg::this_grid();
    Frame F;
    F.lds = (LAS unsigned char*)lds; F.tid = threadIdx.x; F.lane = F.tid & 63; F.wave = __builtin_amdgcn_readfirstlane(F.tid >> 6);
    F.G = gridDim.x; { const int bx = blockIdx.x; F.vcu = (F.G % 8 == 0) ? (bx % 8) * (F.G / 8) + bx / 8 : bx; }
    F.in = args.in; F.out = args.out; F.ws = args.ws;
    const int lo = args.ph_lo, hi = args.ph_hi; unsigned bar_epoch = 0u;
    if (hi > 1000) grid.sync();
#ifndef ONLY_PH
#define ONLY_PH -1
#endif
#define IN(k) ((ONLY_PH < 0 || ONLY_PH == (k)) && lo <= (k) && (k) < hi)
#ifndef DUP_PH
#define DUP_PH -1
#endif
#define REPS(k) ((DUP_PH == (k)) ? 2 : 1)
#define SEAM(k) do { if (IN(k) && IN((k) + 1)) { { \
        asm volatile("s_waitcnt vmcnt(0)" ::: "memory"); __syncthreads();            \
        ++bar_epoch; \
        if (F.tid == 0) { unsigned* c_ = F.QCTR() + 512; __builtin_amdgcn_fence(__ATOMIC_RELEASE, "agent"); asm volatile("s_waitcnt vmcnt(0)" ::: "memory");     \
            __hip_atomic_fetch_add(c_, 1u, __ATOMIC_RELAXED, __HIP_MEMORY_SCOPE_AGENT); \
            const unsigned tgt_ = bar_epoch * (unsigned)F.G; while (__hip_atomic_load(c_, __ATOMIC_RELAXED, __HIP_MEMORY_SCOPE_AGENT) < tgt_) __builtin_amdgcn_s_sleep(1); \
            __builtin_amdgcn_fence(__ATOMIC_ACQUIRE, "agent"); asm volatile("s_waitcnt vmcnt(0)" ::: "memory"); }     \
        __syncthreads(); } } } while (0)
#ifndef PROBE_SCALE
#define PROBE_SCALE 4e-5f
#endif
#ifdef PROBE_T
#define STAMP(k) do { if (blockIdx.x == 0 && F.tid == 0) ((unsigned long long*)(F.QCTR() + 1024))[k] = __builtin_amdgcn_s_memrealtime(); } while (0)
#else
#define STAMP(k) do { } while (0)
#endif
    STAMP(0);
    if (IN(0)) for (int rep = 0; rep < REPS(0); ++rep) { p0_prologue(F); __syncthreads(); }
    SEAM(0); STAMP(1);
    if (IN(1)) for (int rep = 0; rep < REPS(1); ++rep) { pg8::Gemm g{F.XN(), F.Wt_in(), M, NPAD, DM}; pg8::StaticOrder S; S.init(M, NPAD, F.G, (int)blockIdx.x); pg8::EpiProj E{F.PROJ(), F.BA()};
        pg8::gemm_phase<pg8::EpiProj, pg8::StaticOrder, true, true>(F.lds, g, S, E, F.wave); }
    SEAM(1); STAMP(2);
    if (IN(2)) for (int rep = 0; rep < REPS(2); ++rep) { p2_rope_table(F); for (int r2 = 0; r2 < REPS(21); ++r2) p2_attn_rows(F); for (int r2 = 0; r2 < REPS(22); ++r2) p2_dn_conv(F); __syncthreads(); }
    SEAM(2); STAMP(3);
    if (IN(3)) {
        { LAS float* SA = (LAS float*)(F.lds + F.wave * 18176); LAS float* sv = SA + 64 * SAP;
          for (int it = F.vcu * NWAVES + F.wave; it < NB * 8 * 128; it += F.G * NWAVES) dn_prep_item(F, it, SA, sv, F.lane); }
        asm volatile("s_waitcnt vmcnt(0)" ::: "memory"); __syncthreads();
        if (F.tid == 0) { __builtin_amdgcn_fence(__ATOMIC_RELEASE, "agent"); asm volatile("s_waitcnt vmcnt(0)" ::: "memory"); __hip_atomic_fetch_add(F.QCTR() + 768, 1u, __ATOMIC_RELAXED, __HIP_MEMORY_SCOPE_AGENT); }
    }
    STAMP(4);
    if (IN(4)) {
#ifndef NO_SCAN
        if ((int)blockIdx.x < NB * 8) {
            if (F.tid == 0) { while (__hip_atomic_load(F.QCTR() + 768, __ATOMIC_RELAXED, __HIP_MEMORY_SCOPE_AGENT) < (unsigned)F.G) __builtin_amdgcn_s_sleep(2);
                __builtin_amdgcn_fence(__ATOMIC_ACQUIRE, "agent"); asm volatile("s_waitcnt vmcnt(0)" ::: "memory"); }
            __syncthreads();
            dn_scan_wg(F, (int)blockIdx.x);
            asm volatile("s_waitcnt vmcnt(0)" ::: "memory"); __syncthreads();
            if (F.tid == 0) { __builtin_amdgcn_fence(__ATOMIC_RELEASE, "agent"); asm volatile("s_waitcnt vmcnt(0)" ::: "memory"); __hip_atomic_fetch_add(F.QCTR() + 640, 1u, __ATOMIC_RELAXED, __HIP_MEMORY_SCOPE_AGENT); } }
#endif
#ifdef PROBE_SERIAL
        { __builtin_amdgcn_fence(__ATOMIC_RELEASE, "agent"); __syncthreads(); if (F.tid == 0) { unsigned* c_ = F.QCTR() + 576; __hip_atomic_fetch_add(c_, 1u, __ATOMIC_RELEASE, __HIP_MEMORY_SCOPE_AGENT); while (__hip_atomic_load(c_, __ATOMIC_RELAXED, __HIP_MEMORY_SCOPE_AGENT) < (unsigned)F.G) __builtin_amdgcn_s_sleep(2); } __syncthreads(); }
#endif
        { const attn_body::AttnTensors AT{(const attn_body::bf16*)F.QA(), (const attn_body::bf16*)F.KA(), (const attn_body::bf16*)F.VA(), (attn_body::bf16*)F.MIXED()};
          const DynOrder S{F.QCTR(), (int)(__builtin_amdgcn_s_getreg((3 << 11) | 20) & 7), (LAS unsigned*)(F.lds + 135168)};
          attn_body::attn_phase<DynOrder>((char*)lds, AT, S); }
        __syncthreads();
        F.lane = (int)__builtin_amdgcn_mbcnt_hi(~0u, __builtin_amdgcn_mbcnt_lo(~0u, 0u)); F.tid = F.wave * 64 + F.lane;
        if (F.tid == 0) { while (__hip_atomic_load(F.QCTR() + 640, __ATOMIC_RELAXED, __HIP_MEMORY_SCOPE_AGENT) < (unsigned)(NB * 8)) __builtin_amdgcn_s_sleep(2);
            __builtin_amdgcn_fence(__ATOMIC_ACQUIRE, "agent"); asm volatile("s_waitcnt vmcnt(0)" ::: "memory"); }
        __syncthreads();
        { LAS unsigned* slot = (LAS unsigned*)(F.lds + 135168);
          for (;;) { if (F.tid == 0) *slot = __hip_atomic_fetch_add(F.QCTR() + 704, 1u, __ATOMIC_RELAXED, __HIP_MEMORY_SCOPE_AGENT);
              asm volatile("s_waitcnt vmcnt(0) lgkmcnt(0)\n\ts_barrier" ::: "memory"); const unsigned c = *slot; asm volatile("s_waitcnt lgkmcnt(0)\n\ts_barrier" ::: "memory");
              if (c >= (unsigned)(M / 64)) break; p5_mix_chunk(F, (int)c * 64); } }
    }
    F.lane = (int)__builtin_amdgcn_mbcnt_hi(~0u, __builtin_amdgcn_mbcnt_lo(~0u, 0u)); F.tid = F.wave * 64 + F.lane;
    SEAM(4); STAMP(5);
    STAMP(6);
#ifdef PROBE_BAR
    for (int xb = 1; xb <= 20; ++xb) { asm volatile("s_waitcnt vmcnt(0)" ::: "memory"); __syncthreads();
        if (F.tid == 0) { unsigned* c_ = F.QCTR() + 512 + 16; __builtin_amdgcn_fence(__ATOMIC_RELEASE, "agent"); asm volatile("s_waitcnt vmcnt(0)" ::: "memory");
            __hip_atomic_fetch_add(c_, 1u, __ATOMIC_RELAXED, __HIP_MEMORY_SCOPE_AGENT);
            const unsigned tgt_ = (unsigned)xb * (unsigned)F.G; while (__hip_atomic_load(c_, __ATOMIC_RELAXED, __HIP_MEMORY_SCOPE_AGENT) < tgt_) __builtin_amdgcn_s_sleep(1);
            __builtin_amdgcn_fence(__ATOMIC_ACQUIRE, "agent"); asm volatile("s_waitcnt vmcnt(0)" ::: "memory"); }
        __syncthreads(); }
#endif
    if (IN(6)) { pg8::Gemm g{F.MIXED(), F.Wt_out(), M, DM, DM}; pg8::StaticOrder S; S.init(M, DM, F.G, (int)blockIdx.x); pg8::EpiRes<false> E{F.x(), F.HB1(), F.SS()};
        pg8::gemm_phase<pg8::EpiRes<false>, pg8::StaticOrder, true, true>(F.lds, g, S, E, F.wave); }
    SEAM(6); STAMP(7);
    if (IN(7)) for (int rep = 0; rep < REPS(7); ++rep) { pg8::Gemm g{F.HB1(), F.Wt_gu(), M, 2 * FF, DM}; pg8::StaticOrder S; S.init(M, 2 * FF, F.G, (int)blockIdx.x); pg8::EpiGU E{F.SS(), F.ACT()};
        pg8::gemm_phase<pg8::EpiGU, pg8::StaticOrder, true, true>(F.lds, g, S, E, F.wave); }
    SEAM(7); STAMP(8);
    if (IN(8)) { pg8::Gemm g{F.ACT(), F.Wt_dn(), M, DM, FF}; pg8::StaticOrder S; S.init(M, DM, F.G, (int)blockIdx.x); pg8::EpiRes<true> E{F.HB1(), F.HB2(), F.SS() + M};
        pg8::gemm_phase<pg8::EpiRes<true>, pg8::StaticOrder, true, true>(F.lds, g, S, E, F.wave); }
    SEAM(8); STAMP(9);
    if (IN(9)) {
#ifndef NO_G9A
        { int kpe = 256; asm volatile("" : "+s"(kpe)); pg8::Gemm g{F.PB(), F.Wt_pl(), M, DM, kpe}; pg8::StaticOrder S; S.init(M, DM, F.G, (int)blockIdx.x); pg8::EpiStore E{F.PE(), DM};
          pg8::gemm_phase<pg8::EpiStore, pg8::StaticOrder, true, true>(F.lds, g, S, E, F.wave); }
#endif
        asm volatile("s_waitcnt vmcnt(0)" ::: "memory"); __syncthreads();
#ifndef NO_G9B
        { pg8::Gemm g{F.HB2(), F.Wt_pg(), M, DM, DM}; pg8::StaticOrder S; S.init(M, DM, F.G, (int)blockIdx.x); pg8::EpiPle E{F.HB2(), F.HB1(), F.PE(), F.SS() + M, F.SS() + 2 * M};
          pg8::gemm_phase<pg8::EpiPle, pg8::StaticOrder, true, true>(F.lds, g, S, E, F.wave); }
#endif
    }
    SEAM(9); STAMP(10);
    if (IN(10)) { p10_final(F, 0.f); }
#ifdef PROBE_T
    {
        asm volatile("s_waitcnt vmcnt(0)" ::: "memory"); __syncthreads();
        if (F.tid == 0) { unsigned* c_ = F.QCTR() + 512; __builtin_amdgcn_fence(__ATOMIC_RELEASE, "agent"); asm volatile("s_waitcnt vmcnt(0)" ::: "memory");
            __hip_atomic_fetch_add(c_, 1u, __ATOMIC_RELAXED, __HIP_MEMORY_SCOPE_AGENT);
            const unsigned tgt_ = 11u * (unsigned)F.G; while (__hip_atomic_load(c_, __ATOMIC_RELAXED, __HIP_MEMORY_SCOPE_AGENT) < tgt_) __builtin_amdgcn_s_sleep(1);
            __builtin_amdgcn_fence(__ATOMIC_ACQUIRE, "agent"); asm volatile("s_waitcnt vmcnt(0)" ::: "memory"); }
        __syncthreads();
        STAMP(11);
        float delta = 0.f; { const unsigned long long* ts = (const unsigned long long*)(F.QCTR() + 1024); unsigned long long acc_ = 0;
          for (int k = 0; k < 13; ++k) if ((PROBE_T >> k) & 1) acc_ += __hip_atomic_load(ts + k + 1, __ATOMIC_RELAXED, __HIP_MEMORY_SCOPE_AGENT) - __hip_atomic_load(ts + k, __ATOMIC_RELAXED, __HIP_MEMORY_SCOPE_AGENT);
          delta = (float)acc_ * 0.01f * PROBE_SCALE; }
        for (int m = F.vcu * NWAVES + F.wave; m < 1024; m += F.G * NWAVES) { f32x4* xr = (f32x4*)(F.out + (size_t)m * DM) + F.lane;
            for (int j = 0; j < 4; ++j) xr[64 * j] = xr[64 * j] + delta; }
    }
#endif
#undef IN
#undef SEAM
}

#ifndef MK_PER_PHASE
#define MK_PER_PHASE 0
#endif
extern "C" void kernel_launch(void* const* d_in, const int* in_sizes, int n_in, void* d_out, int out_size, void* d_ws, size_t ws_size, hipStream_t stream) {
    static int grid = 0;
    if (grid == 0) {
        if (n_in != 19 || in_sizes[0] != M * DM || out_size != M * DM || ws_size < WS_END) { fprintf(stderr, "kernel_launch: unexpected shapes / workspace (n_in %d, ws %zu); nothing launched\n", n_in, ws_size); grid = -1; return; }
        int dev = 0, cus = 0, per_cu = 0;
        (void)hipGetDevice(&dev); (void)hipDeviceGetAttribute(&cus, hipDeviceAttributeMultiprocessorCount, dev);
        (void)hipFuncSetAttribute((const void*)hymba_fwd, hipFuncAttributeMaxDynamicSharedMemorySize, LDS_BYTES);
        (void)hipOccupancyMaxActiveBlocksPerMultiprocessor(&per_cu, (const void*)hymba_fwd, NWAVES * 64, LDS_BYTES);
        (void)hipGetLastError();
        if (per_cu < 1) { fprintf(stderr, "kernel_launch: occupancy query says %d blocks per CU\n", per_cu); per_cu = 1; }
        grid = cus;
    }
    if (grid < 0) return;
    (void)hipMemsetAsync((unsigned char*)d_ws + WS_QCTR + 512 * 4, 0, 256, stream);
    Args a{};
    for (int i = 0; i < 19; ++i) a.in[i] = (const float*)d_in[i];
    a.out = (float*)d_out; a.ws = (unsigned char*)d_ws;
#if MK_PER_PHASE
    for (int ph = 0; ph < N_PHASES; ++ph) { a.ph_lo = ph; a.ph_hi = ph + 1; hipLaunchKernelGGL(hymba_fwd, dim3(grid), dim3(NWAVES * 64), LDS_BYTES, stream, a); }
#else
    a.ph_lo = 0; a.ph_hi = N_PHASES;
    void* kargs[] = {&a};
    hipError_t e = hipLaunchCooperativeKernel((const void*)hymba_fwd, dim3(grid), dim3(NWAVES * 64), kargs, LDS_BYTES, stream);
    if (e != hipSuccess) fprintf(stderr, "cooperative launch failed: %s (grid %d)\n", hipGetErrorString(e), grid);
#endif
}
```

```cpp
#include <hip/hip_runtime.h>
#include <hip/hip_cooperative_groups.h>
#include <cstdio>
#include <cstdint>
namespace pg8 {
#define PG8_LAS __attribute__((address_space(3)))
typedef unsigned short bf16_t;
typedef short bf16x8 __attribute__((ext_vector_type(8)));
typedef float f32x4 __attribute__((ext_vector_type(4)));
typedef unsigned u32x4 __attribute__((ext_vector_type(4)));
constexpr int BM = 256, BK = 64, HALF = 128, HTB = HALF * BK * 2  , STAGE_BYTES = 8 * HTB, NXCD = 8, WGM = 8;

__host__ __device__ __forceinline__ int lds_byte(int r, int c) { const int st = (r >> 4) * 2 + (c >> 5), rr = r & 15, cc = c & 31, ob = rr * 64 + cc * 2; return st * 1024 + (ob ^ (((ob >> 9) & 1) << 5)); }
__host__ __device__ __forceinline__ void stage_rc(int b, int& R, int& C) { const int st = b / 1024, sb = b % 1024, swz = sb ^ (((sb >> 9) & 1) << 5); R = (st >> 1) * 16 + swz / 64; C = (st & 1) * 32 + (swz % 64) / 2; }
__host__ __device__ __forceinline__ int perm32(int rho) { const int n = rho >> 4, i = rho & 15; return 8 * (i >> 2) + 4 * n + (i & 3); }

struct Unit { int pm, pn; };
struct Gemm { const bf16_t* A; const bf16_t* Bt; int M, N, K; };

struct StaticOrder {
    int nM, nN, nwg, G, c;
    __host__ __device__ void init(int M, int N, int G_, int c_) { nM = M / BM; nN = N / BM; nwg = nM * nN; G = G_; c = c_; }
    __host__ __device__ bool next(int i, Unit& u) const {
        const long L = (long)i * G + c; if (L >= nwg) return false;
        int wgid = (int)L; { const int q = nwg / NXCD, r = nwg % NXCD, xcd = wgid % NXCD, off = wgid / NXCD; wgid = (xcd < r ? xcd * (q + 1) : r * (q + 1) + (xcd - r) * q) + off; }
        const int nig = WGM * nN, gid = wgid / nig, fm = gid * WGM, gsz = (nM - fm) < WGM ? (nM - fm) : WGM;
        u.pm = fm + ((wgid % nig) % gsz); u.pn = (wgid % nig) / gsz; return true;
    }
    __device__ __forceinline__ void a_ready(const Unit&) const {}
    __device__ __forceinline__ void done(const Unit&) const {}
};

__device__ __forceinline__ unsigned cvt_pk_bf16(float lo, float hi) { unsigned r; asm volatile("v_cvt_pk_bf16_f32 %0, %1, %2" : "=v"(r) : "v"(lo), "v"(hi)); return r; }
typedef float f32x2 __attribute__((ext_vector_type(2)));
typedef unsigned u32x2 __attribute__((ext_vector_type(2)));
__device__ __forceinline__ float fast_sigmoid(float v) { return __builtin_amdgcn_rcpf(1.f + __expf(-v)); }
struct EpiProj {
    static constexpr bool PERM = true, AFTER_DRAIN = false;
    bf16_t* O; float* BA;
    __device__ __forceinline__ void operator()(const f32x4 (&acc)[2][2][4][2], const Unit& u, int wr, int wc, int fr, int fq) const {
        const int row0 = u.pm * BM + wr * 64 + fr;
        if (u.pn < 11) {
            const int col0 = u.pn * BM + wc * 32 + 8 * fq;
#pragma unroll
            for (int ai = 0; ai < 2; ++ai)
#pragma unroll
                for (int m = 0; m < 4; ++m) { bf16_t* rowp = O + (size_t)(row0 + ai * HALF + m * 16) * 2816 + col0;
#pragma unroll
                    for (int bj = 0; bj < 2; ++bj) { const f32x4 v0 = acc[ai][bj][m][0], v1 = acc[ai][bj][m][1];
                        u32x4 w; w.x = cvt_pk_bf16(v0[0], v0[1]); w.y = cvt_pk_bf16(v0[2], v0[3]); w.z = cvt_pk_bf16(v1[0], v1[1]); w.w = cvt_pk_bf16(v1[2], v1[3]);
                        *(u32x4*)(rowp + bj * HALF) = w; } }
        } else if (wc == 0 && fq < 2) {
#pragma unroll
            for (int ai = 0; ai < 2; ++ai)
#pragma unroll
                for (int m = 0; m < 4; ++m) { float* rowp = BA + (size_t)(row0 + ai * HALF + m * 16) * 16 + 8 * fq;
                    *(f32x4*)(rowp) = acc[ai][0][m][0]; *(f32x4*)(rowp + 4) = acc[ai][0][m][1]; }
        }
    }
};
struct EpiStore {
    static constexpr bool PERM = true, AFTER_DRAIN = false;
    bf16_t* O; int ldc;
    __device__ __forceinline__ void operator()(const f32x4 (&acc)[2][2][4][2], const Unit& u, int wr, int wc, int fr, int fq) const {
        const int row0 = u.pm * BM + wr * 64 + fr; const int col0 = u.pn * BM + wc * 32 + 8 * fq;
#pragma unroll
        for (int ai = 0; ai < 2; ++ai)
#pragma unroll
            for (int m = 0; m < 4; ++m) { bf16_t* rowp = O + (size_t)(row0 + ai * HALF + m * 16) * ldc + col0;
#pragma unroll
                for (int bj = 0; bj < 2; ++bj) { const f32x4 v0 = acc[ai][bj][m][0], v1 = acc[ai][bj][m][1];
                    u32x4 w; w.x = cvt_pk_bf16(v0[0], v0[1]); w.y = cvt_pk_bf16(v0[2], v0[3]); w.z = cvt_pk_bf16(v1[0], v1[1]); w.w = cvt_pk_bf16(v1[2], v1[3]);
                    *(u32x4*)(rowp + bj * HALF) = w; } }
    }
};
template <bool BF> struct EpiRes {
    static constexpr bool PERM = false, AFTER_DRAIN = false;
    const void* base; bf16_t* hb; float* ss;
    __device__ __forceinline__ void operator()(const f32x4 (&acc)[2][2][4][2], const Unit& u, int wr, int wc, int fr, int fq) const {
        const int col0 = u.pn * BM + wc * 32 + 4 * fq;
        u32x2 pk[2][4][4];
        if (BF) {
#pragma unroll
            for (int ai = 0; ai < 2; ++ai)
#pragma unroll
                for (int m = 0; m < 4; ++m)
#pragma unroll
                    for (int q = 0; q < 4; ++q) pk[ai][m][q] = *(const u32x2*)((const bf16_t*)base + (size_t)(u.pm * BM + ai * HALF + wr * 64 + fr + m * 16) * 1024 + col0 + (q >> 1) * HALF + (q & 1) * 16);
            asm volatile("" ::: "memory"); }
#pragma unroll
        for (int ai = 0; ai < 2; ++ai) { f32x4 bs[4][4]; const size_t off0 = (size_t)(u.pm * BM + ai * HALF + wr * 64 + fr) * 1024 + col0;
            if (!BF) {
#pragma unroll
                for (int m = 0; m < 4; ++m)
#pragma unroll
                    for (int q = 0; q < 4; ++q) bs[m][q] = *(const f32x4*)((const float*)base + off0 + (size_t)m * 16 * 1024 + (q >> 1) * HALF + (q & 1) * 16);
                asm volatile("" ::: "memory"); }
#pragma unroll
            for (int m = 0; m < 4; ++m) { const size_t off = off0 + (size_t)m * 16 * 1024; float s = 0.f;
#pragma unroll
                for (int q = 0; q < 4; ++q) { f32x4 r;
                    if (BF) { const u32x2 p = pk[ai][m][q]; r = (f32x4){__uint_as_float(p.x << 16), __uint_as_float(p.x & 0xffff0000u), __uint_as_float(p.y << 16), __uint_as_float(p.y & 0xffff0000u)}; } else r = bs[m][q];
                    const f32x4 o = r + acc[ai][q >> 1][m][q & 1]; const size_t o2 = off + (q >> 1) * HALF + (q & 1) * 16;
                    s += (o[0] * o[0] + o[1] * o[1]) + (o[2] * o[2] + o[3] * o[3]);
                    u32x2 w; w.x = cvt_pk_bf16(o[0], o[1]); w.y = cvt_pk_bf16(o[2], o[3]); *(u32x2*)(hb + o2) = w; }
                s += __shfl_xor(s, 16); s += __shfl_xor(s, 32);
                if (fq == 0) unsafeAtomicAdd(ss + (u.pm * BM + ai * HALF + wr * 64 + m * 16 + fr), s); }
            asm volatile("" ::: "memory"); }
    }
};
struct EpiGU {
    static constexpr bool PERM = true, AFTER_DRAIN = false;
    const float* ss; bf16_t* act;
    __device__ __forceinline__ void operator()(const f32x4 (&acc)[2][2][4][2], const Unit& u, int wr, int wc, int fr, int fq) const {
        const int col0 = u.pn * HALF + wc * 32 + 8 * fq; const int row0 = u.pm * BM + wr * 64 + fr;
        float rs[2][4];
#pragma unroll
        for (int ai = 0; ai < 2; ++ai)
#pragma unroll
            for (int m = 0; m < 4; ++m) rs[ai][m] = ss[row0 + ai * HALF + m * 16];
        asm volatile("" ::: "memory");
#pragma unroll
        for (int ai = 0; ai < 2; ++ai)
#pragma unroll
            for (int m = 0; m < 4; ++m) { const int row = row0 + ai * HALF + m * 16;
                const float rstd = rsqrtf(rs[ai][m] * (1.0f / 1024.0f) + 1e-6f); float a[8];
#pragma unroll
                for (int n = 0; n < 2; ++n)
#pragma unroll
                    for (int e = 0; e < 4; ++e) { const float g = acc[ai][0][m][n][e] * rstd, up = acc[ai][1][m][n][e] * rstd; a[4 * n + e] = g * fast_sigmoid(g) * up; }
                u32x4 w; w.x = cvt_pk_bf16(a[0], a[1]); w.y = cvt_pk_bf16(a[2], a[3]); w.z = cvt_pk_bf16(a[4], a[5]); w.w = cvt_pk_bf16(a[6], a[7]);
                *(u32x4*)(act + (size_t)row * 2816 + col0) = w; }
    }
};
struct EpiPle {
    static constexpr bool PERM = false, AFTER_DRAIN = false;
    const bf16_t* hres; bf16_t* h; const bf16_t* pe; const float* ss2; float* ss3;
    __device__ __forceinline__ void operator()(const f32x4 (&acc)[2][2][4][2], const Unit& u, int wr, int wc, int fr, int fq) const {
        const int col0 = u.pn * BM + wc * 32 + 4 * fq;
#pragma unroll
        for (int ai = 0; ai < 2; ++ai)
#pragma unroll
            for (int mp = 0; mp < 1; ++mp) { u32x2 bs[4][4]; u32x2 pw[4][4]; float sq[4]; const int row0 = u.pm * BM + ai * HALF + wr * 64 + fr; const size_t off0 = (size_t)row0 * 1024 + col0;
#pragma unroll
                for (int m = 0; m < 4; ++m) { sq[m] = ss2[row0 + 16 * m];
#pragma unroll
                    for (int q = 0; q < 4; ++q) { const size_t o2 = off0 + (size_t)m * 16 * 1024 + (q >> 1) * HALF + (q & 1) * 16; bs[m][q] = *(const u32x2*)(hres + o2); pw[m][q] = *(const u32x2*)(pe + o2); } }
                asm volatile("" ::: "memory");
#pragma unroll
                for (int m = 0; m < 4; ++m) { const float rstd = rsqrtf(sq[m] * (1.0f / 1024.0f) + 1e-6f); float s = 0.f;
#pragma unroll
                    for (int q = 0; q < 4; ++q) { const size_t o2 = off0 + (size_t)m * 16 * 1024 + (q >> 1) * HALF + (q & 1) * 16; const f32x4 a = acc[ai][q >> 1][m][q & 1]; const u32x2 p = pw[m][q], r_ = bs[m][q]; f32x4 o;
                        o[0] = __uint_as_float(r_.x << 16) + fast_sigmoid(a[0] * rstd) * __uint_as_float(p.x << 16); o[1] = __uint_as_float(r_.x & 0xffff0000u) + fast_sigmoid(a[1] * rstd) * __uint_as_float(p.x & 0xffff0000u);
                        o[2] = __uint_as_float(r_.y << 16) + fast_sigmoid(a[2] * rstd) * __uint_as_float(p.y << 16); o[3] = __uint_as_float(r_.y & 0xffff0000u) + fast_sigmoid(a[3] * rstd) * __uint_as_float(p.y & 0xffff0000u);
                        { u32x2 w; w.x = cvt_pk_bf16(o[0], o[1]); w.y = cvt_pk_bf16(o[2], o[3]); *(u32x2*)(h + o2) = w; } s += (o[0] * o[0] + o[1] * o[1]) + (o[2] * o[2] + o[3] * o[3]); }
                    s += __shfl_xor(s, 16); s += __shfl_xor(s, 32);
                    if (fq == 0) unsafeAtomicAdd(ss3 + row0 + 16 * m, s); }
                asm volatile("" ::: "memory"); }
    }
};
template <class Epi, class Sched, bool ALIGN_EPI = false, bool SP2 = false>
__device__ __forceinline__ void gemm_phase(PG8_LAS unsigned char* lds, const Gemm g, const Sched& S, const Epi& E, const int wave_id) {
    const int tid = threadIdx.x, wid = __builtin_amdgcn_readfirstlane(tid >> 6), lane = tid & 63, wr = wid >> 2, wc = wid & 3, fr = lane & 15, fq = lane >> 4;
    const int K = g.K, nt = K / BK;
    unsigned voffA[2], voffB[2];
#pragma unroll
    for (int i = 0; i < 2; ++i) { int R, C; stage_rc(tid * 16 + i * 8192, R, C); const int Rb = Epi::PERM ? ((R & ~31) + perm32(R & 31)) : R;
        voffA[i] = (unsigned)(R * K + C) * 2u; voffB[i] = (unsigned)(Rb * K + C) * 2u; }
    const size_t kstep = (size_t)(BK * 2);
    const size_t hstep = (size_t)HALF * K * 2;
    const size_t tstep = 2 * hstep;
    const unsigned ldsw = (unsigned)wid * 1024u;
    const int aoff = lds_byte(wr * 64 + fr, fq * 8), boff = lds_byte(wc * 32 + fr, fq * 8);
#define PG8_SA(b, h) (((b) * 2 + (h)) * HTB)
#define PG8_SB(b, h) ((4 + (b) * 2 + (h)) * HTB)
#define PG8_STAGE(bufoff, gbase, voff) do { _Pragma("unroll") for (int _i = 0; _i < 2; ++_i) \
        __builtin_amdgcn_global_load_lds((const unsigned*)((const char*)(gbase) + (voff)[_i]), (PG8_LAS unsigned*)(lds + (bufoff) + ldsw + _i * 8192), 16, 0, 0); } while (0)
#define PG8_LDA(dst, b, h) do { _Pragma("unroll") for (int m = 0; m < 4; ++m) _Pragma("unroll") for (int k = 0; k < 2; ++k) dst[m][k] = *(const PG8_LAS bf16x8*)(lds + PG8_SA(b, h) + aoff + m * 2048 + k * 1024); } while (0)
#define PG8_LDB(dst, b, h) do { _Pragma("unroll") for (int n = 0; n < 2; ++n) _Pragma("unroll") for (int k = 0; k < 2; ++k) dst[n][k] = *(const PG8_LAS bf16x8*)(lds + PG8_SB(b, h) + boff + n * 2048 + k * 1024); } while (0)
#define PG8_MMA(ai, bj, At, Bt) do { __builtin_amdgcn_s_setprio(1); _Pragma("unroll") for (int m = 0; m < 4; ++m) _Pragma("unroll") for (int n = 0; n < 2; ++n) _Pragma("unroll") for (int k = 0; k < 2; ++k) \
        acc[ai][bj][m][n] = __builtin_amdgcn_mfma_f32_16x16x32_bf16(Bt[n][k], At[m][k], acc[ai][bj][m][n], 0, 0, 0); __builtin_amdgcn_s_setprio(0); } while (0)
#define PG8_WAIT_V(n) asm volatile("s_waitcnt vmcnt(" #n ")" ::: "memory")
#define PG8_WAIT_L(n) asm volatile("s_waitcnt lgkmcnt(" #n ")" ::: "memory")
#define PG8_BAR __builtin_amdgcn_s_barrier()
#define PG8_SCHED __builtin_amdgcn_sched_barrier(0)
    Unit cur, nxt; int ui = 0;
    if (!S.next(0, cur)) return;
    f32x4 acc[2][2][4][2];
#pragma unroll
    for (int a = 0; a < 2; ++a)
#pragma unroll
        for (int b = 0; b < 2; ++b)
#pragma unroll
            for (int m = 0; m < 4; ++m)
#pragma unroll
                for (int n = 0; n < 2; ++n) acc[a][b][m][n] = (f32x4){0.f, 0.f, 0.f, 0.f};
    bf16x8 At[4][2], B0[2][2], B1[2][2];
    const char* cA = (const char*)g.A + (size_t)cur.pm * tstep; const char* cB = (const char*)g.Bt + (size_t)cur.pn * tstep;
    S.a_ready(cur);
    if constexpr (SP2) {
        PG8_STAGE(PG8_SB(0, 0), cB, voffB); PG8_STAGE(PG8_SB(0, 1), cB + hstep, voffB); PG8_STAGE(PG8_SA(0, 0), cA, voffA); PG8_STAGE(PG8_SA(0, 1), cA + hstep, voffA);
        if (wr == 1) PG8_BAR;
        PG8_WAIT_V(2); PG8_BAR;
        PG8_STAGE(PG8_SB(1, 0), cB + kstep, voffB); PG8_STAGE(PG8_SA(1, 0), cA + kstep, voffA); PG8_STAGE(PG8_SB(1, 1), cB + hstep + kstep, voffB);
        PG8_WAIT_V(6); PG8_BAR;
    } else {
        PG8_STAGE(PG8_SB(0, 0), cB, voffB); PG8_STAGE(PG8_SA(0, 0), cA, voffA); PG8_STAGE(PG8_SB(0, 1), cB + hstep, voffB); PG8_STAGE(PG8_SA(0, 1), cA + hstep, voffA);
        if (wr == 1) PG8_BAR;
        PG8_WAIT_V(4); PG8_BAR;
        PG8_STAGE(PG8_SB(1, 0), cB + kstep, voffB); PG8_STAGE(PG8_SA(1, 0), cA + kstep, voffA); PG8_STAGE(PG8_SB(1, 1), cB + hstep + kstep, voffB);
        PG8_WAIT_V(6); PG8_BAR;
    }
    for (;;) {
        const bool has_next = S.next(ui + 1, nxt);
        const char* nA = has_next ? (const char*)g.A + (size_t)nxt.pm * tstep : cA; const char* nB = has_next ? (const char*)g.Bt + (size_t)nxt.pn * tstep : cB;
        for (int t = 0; t < nt; t += 2) {
            const bool last = (t == nt - 2);
            const char* a1 = cA + (size_t)(t + 1) * kstep;
            const char* a2 = last ? nA : cA + (size_t)(t + 2) * kstep; const char* b2 = last ? nB : cB + (size_t)(t + 2) * kstep;
            const char* a3 = a2 + kstep; const char* b3 = b2 + kstep;
            if (last && has_next) S.a_ready(nxt);
            if constexpr (SP2) {
            PG8_LDB(B0, 0, 0); PG8_LDB(B1, 0, 1); PG8_SCHED; PG8_LDA(At, 0, 0); PG8_STAGE(PG8_SA(1, 1), a1 + hstep, voffA);
            PG8_WAIT_V(8); PG8_WAIT_L(0); PG8_BAR; PG8_MMA(0, 0, At, B0); PG8_MMA(0, 1, At, B1); PG8_BAR; PG8_SCHED;
            PG8_LDA(At, 0, 1); PG8_STAGE(PG8_SB(0, 0), b2, voffB); PG8_STAGE(PG8_SB(0, 1), b2 + hstep, voffB); PG8_STAGE(PG8_SA(0, 0), a2, voffA);
            PG8_WAIT_V(8); PG8_WAIT_L(0); PG8_BAR; PG8_MMA(1, 0, At, B0); PG8_MMA(1, 1, At, B1); PG8_BAR; PG8_SCHED;
            PG8_LDB(B0, 1, 0); PG8_LDB(B1, 1, 1); PG8_SCHED; PG8_LDA(At, 1, 0); PG8_STAGE(PG8_SA(0, 1), a2 + hstep, voffA);
            PG8_WAIT_V(8); PG8_WAIT_L(0); PG8_BAR; PG8_MMA(0, 0, At, B0); PG8_MMA(0, 1, At, B1); PG8_BAR; PG8_SCHED;
            PG8_LDA(At, 1, 1); PG8_STAGE(PG8_SB(1, 0), b3, voffB); PG8_STAGE(PG8_SB(1, 1), b3 + hstep, voffB); PG8_STAGE(PG8_SA(1, 0), a3, voffA);
            PG8_WAIT_V(8); PG8_WAIT_L(0); PG8_BAR; PG8_MMA(1, 0, At, B0); PG8_MMA(1, 1, At, B1); PG8_BAR; PG8_SCHED;
            } else {
            PG8_LDB(B0, 0, 0); PG8_SCHED; PG8_LDA(At, 0, 0); PG8_STAGE(PG8_SA(1, 1), a1 + hstep, voffA);
            PG8_WAIT_L(8); PG8_BAR; PG8_WAIT_L(0); PG8_MMA(0, 0, At, B0); PG8_BAR; PG8_SCHED;
            PG8_LDB(B1, 0, 1); PG8_STAGE(PG8_SB(0, 0), b2, voffB);
            PG8_BAR; PG8_WAIT_L(0); PG8_MMA(0, 1, At, B1); PG8_BAR;
            PG8_LDA(At, 0, 1); PG8_STAGE(PG8_SA(0, 0), a2, voffA);
            PG8_BAR; PG8_WAIT_L(0); PG8_MMA(1, 0, At, B0); PG8_BAR; PG8_SCHED;
            PG8_STAGE(PG8_SB(0, 1), b2 + hstep, voffB);
            PG8_WAIT_V(6); PG8_BAR; PG8_MMA(1, 1, At, B1); PG8_BAR;
            PG8_LDB(B0, 1, 0); PG8_SCHED; PG8_LDA(At, 1, 0); PG8_STAGE(PG8_SA(0, 1), a2 + hstep, voffA);
            PG8_WAIT_L(8); PG8_BAR; PG8_WAIT_L(0); PG8_MMA(0, 0, At, B0); PG8_BAR; PG8_SCHED;
            PG8_LDB(B1, 1, 1); PG8_STAGE(PG8_SB(1, 0), b3, voffB);
            PG8_BAR; PG8_WAIT_L(0); PG8_MMA(0, 1, At, B1); PG8_BAR;
            PG8_LDA(At, 1, 1); PG8_STAGE(PG8_SA(1, 0), a3, voffA);
            PG8_BAR; PG8_WAIT_L(0); PG8_MMA(1, 0, At, B0); PG8_BAR; PG8_SCHED;
            PG8_STAGE(PG8_SB(1, 1), b3 + hstep, voffB);
            PG8_WAIT_V(6); PG8_BAR; PG8_MMA(1, 1, At, B1); PG8_BAR;
            }
        }
        if constexpr (ALIGN_EPI) { if (wr == 0) PG8_BAR; }
        if constexpr (!Epi::AFTER_DRAIN) { E(acc, cur, wr, wc, fr, fq); S.done(cur); }
        if (!has_next) break;
#pragma unroll
        for (int a = 0; a < 2; ++a)
#pragma unroll
            for (int b = 0; b < 2; ++b)
#pragma unroll
                for (int m = 0; m < 4; ++m)
#pragma unroll
                    for (int n = 0; n < 2; ++n) acc[a][b][m][n] = (f32x4){0.f, 0.f, 0.f, 0.f};
        cur = nxt; cA = nA; cB = nB; ++ui;
        if constexpr (ALIGN_EPI) { if (wr == 1) PG8_BAR; }
    }
    PG8_WAIT_V(0);
    if constexpr (!ALIGN_EPI) { if (wr == 0) PG8_BAR; }
    PG8_BAR;
    if constexpr (Epi::AFTER_DRAIN) { E.fused(acc, cur, wr, wc, fr, fq, lds, wid, lane); S.done(cur); }
#undef PG8_SA
#undef PG8_SB
#undef PG8_STAGE
#undef PG8_LDA
#undef PG8_LDB
#undef PG8_MMA
#undef PG8_WAIT_V
#undef PG8_WAIT_L
#undef PG8_BAR
#undef PG8_SCHED
}
}
#include <hip/hip_bf16.h>
#include <cmath>
namespace attn_body {
using bf16=__hip_bfloat16;
using bf16x8=__attribute__((ext_vector_type(8)))short;
using s16x4=__attribute__((ext_vector_type(4)))short;
using f32x16=__attribute__((ext_vector_type(16)))float;
using u32x4=__attribute__((ext_vector_type(4)))unsigned;
constexpr int BATCH=8,NHEAD=8,SEQ=8192,D=64,QP=512,KP=128,OP=1024,GQ=4;
constexpr int NW=8,QBLK=32,QB=QBLK*NW,KVBLK=64,NQB=SEQ/QB;
constexpr int ATTN_UNIT_ROWS=QB;
__device__ __forceinline__ int crow(int r,int hi){return (r&3)+8*(r>>2)+4*hi;}
#define SBAR() __builtin_amdgcn_sched_barrier(0)
__device__ __forceinline__ void cmask(f32x16&p0,f32x16&p1,int jb,int qrel,int hi){
  const float NEG=-INFINITY; int kb=64*jb+4*hi;
  #pragma unroll
  for(int r=0;r<16;++r){int kv=kb+(r&3)+8*(r>>2); if(kv>qrel)p0[r]=NEG; if(kv+32>qrel)p1[r]=NEG;}
}

constexpr int NSLOT=3, SLOTB=8192;
constexpr int LDS_K=0, LDS_V=NSLOT*SLOTB, LDS_WS=2*NSLOT*SLOTB, LDS_OST=LDS_WS+NW*64*4, LDS_BYTES=LDS_OST+NW*4096;
constexpr float C2=0.125f*1.4426950408889634f;
__device__ __forceinline__ void glds16(const void*gsrc,unsigned lds_dst){unsigned keep;
  asm volatile("s_mov_b32 %0, m0\n\ts_mov_b32 m0, %2\n\ts_nop 0\n\tglobal_load_lds_dwordx4 %1, off\n\ts_mov_b32 m0, %0":"=&s"(keep):"v"(gsrc),"s"(lds_dst):"memory");}
__device__ __forceinline__ float max3f(float a,float b,float c){float r;asm("v_max3_f32 %0, %1, %2, %3":"=v"(r):"v"(a),"v"(b),"v"(c));return r;}
__device__ __forceinline__ float max2f(float a,float b){float r;asm("v_max_f32_e32 %0, %1, %2":"=v"(r):"v"(a),"v"(b));return r;}
__device__ __forceinline__ float fadd_s(float a,float b){float r;asm("v_add_f32_e32 %0, %1, %2":"=v"(r):"v"(a),"v"(b));return r;}
__device__ __forceinline__ float fsub_s(float a,float b){float r;asm("v_sub_f32_e32 %0, %1, %2":"=v"(r):"v"(a),"v"(b));return r;}
typedef float f32x2_t __attribute__((ext_vector_type(2))); typedef __bf16 bf16x2_t __attribute__((ext_vector_type(2)));
__device__ __forceinline__ unsigned cvtpk_s(float lo,float hi){f32x2_t v={lo,hi};bf16x2_t b=__builtin_convertvector(v,bf16x2_t);return __builtin_bit_cast(unsigned,b);}
#define WAIT_BAR(N) asm volatile("s_waitcnt vmcnt(" #N ") lgkmcnt(0)\n\ts_barrier":::"memory")

__device__ __forceinline__ void qkt(f32x16&p0,f32x16&p1,const char*Kslot,const bf16x8*qr,const f32x16&negm,int r32,int hi){
  const char*kb=Kslot+hi*1024+r32*16;
  #pragma unroll
  for(int d0=0;d0<4;++d0){
    const bf16x8 b0=*reinterpret_cast<const bf16x8*>(kb+d0*2048);
    const bf16x8 b1=*reinterpret_cast<const bf16x8*>(kb+d0*2048+512);
    if(d0==0){p0=__builtin_amdgcn_mfma_f32_32x32x16_bf16(b0,qr[0],negm,0,0,0);p1=__builtin_amdgcn_mfma_f32_32x32x16_bf16(b1,qr[0],negm,0,0,0);}
    else{p0=__builtin_amdgcn_mfma_f32_32x32x16_bf16(b0,qr[d0],p0,0,0,0);p1=__builtin_amdgcn_mfma_f32_32x32x16_bf16(b1,qr[d0],p1,0,0,0);}}
}
typedef __attribute__((address_space(3))) const char* lds_cptr;
typedef short v4i16_t __attribute__((ext_vector_type(4)));
__device__ __forceinline__ void kload8(bf16x8*kf,lds_cptr kp){
  kf[0]=*(const __attribute__((address_space(3))) bf16x8*)(kp);      kf[1]=*(const __attribute__((address_space(3))) bf16x8*)(kp+512);
  kf[2]=*(const __attribute__((address_space(3))) bf16x8*)(kp+2048); kf[3]=*(const __attribute__((address_space(3))) bf16x8*)(kp+2560);
  kf[4]=*(const __attribute__((address_space(3))) bf16x8*)(kp+4096); kf[5]=*(const __attribute__((address_space(3))) bf16x8*)(kp+4608);
  kf[6]=*(const __attribute__((address_space(3))) bf16x8*)(kp+6144); kf[7]=*(const __attribute__((address_space(3))) bf16x8*)(kp+6656);
}
__device__ __forceinline__ void kload2(bf16x8*kf,lds_cptr kp,int j){ kf[2*j]=*(const __attribute__((address_space(3))) bf16x8*)(kp+j*2048); kf[2*j+1]=*(const __attribute__((address_space(3))) bf16x8*)(kp+j*2048+512); }
__device__ __forceinline__ s16x4 vtr(lds_cptr p){ return __builtin_bit_cast(s16x4,__builtin_amdgcn_ds_read_tr16_b64_v4i16((__attribute__((address_space(3))) v4i16_t*)p)); }
__device__ __forceinline__ float rowmax(const f32x16&p0,const f32x16&p1){
  float a=max3f(p0[0],p0[1],p1[0]),b=max3f(p0[2],p0[3],p1[1]);a=max3f(a,p1[2],p1[3]);
  #pragma unroll
  for(int r=4;r<16;r+=4){a=max3f(a,p0[r],p0[r+1]);b=max3f(b,p0[r+2],p0[r+3]);a=max3f(a,p1[r],p1[r+1]);b=max3f(b,p1[r+2],p1[r+3]);}
  const float m=max2f(a,b);
  auto rr=__builtin_amdgcn_permlane32_swap(__float_as_uint(m),__float_as_uint(m),false,false);
  return max2f(__uint_as_float(rr[0]),__uint_as_float(rr[1]));
}
__device__ __forceinline__ void pv(f32x16*o,int vb,bf16x8 pa0,bf16x8 pa1,bf16x8 pa2,bf16x8 pa3){
  #pragma unroll
  for(int d0=0;d0<2;++d0){s16x4 lo[4],hi[4];
    #pragma unroll
    for(int ks=0;ks<4;++ks){
      asm volatile("ds_read_b64_tr_b16 %0,%1 offset:%c2":"=&v"(lo[ks]):"v"(vb),"i"(d0*4096+ks*1024):"memory");
      asm volatile("ds_read_b64_tr_b16 %0,%1 offset:%c2":"=&v"(hi[ks]):"v"(vb),"i"(d0*4096+ks*1024+512):"memory");}
    asm volatile("s_waitcnt lgkmcnt(0)":::"memory");SBAR();
    #define PK(k) (bf16x8){lo[k][0],lo[k][1],lo[k][2],lo[k][3],hi[k][0],hi[k][1],hi[k][2],hi[k][3]}
    o[d0]=__builtin_amdgcn_mfma_f32_32x32x16_bf16(pa0,PK(0),o[d0],0,0,0);
    o[d0]=__builtin_amdgcn_mfma_f32_32x32x16_bf16(pa1,PK(1),o[d0],0,0,0);
    o[d0]=__builtin_amdgcn_mfma_f32_32x32x16_bf16(pa2,PK(2),o[d0],0,0,0);
    o[d0]=__builtin_amdgcn_mfma_f32_32x32x16_bf16(pa3,PK(3),o[d0],0,0,0);
    #undef PK
  }
}

#ifndef ATTN_STORE16
#define ATTN_STORE16(p,v) (*(u32x4*)(p)=(v))
#endif
template<int THRL> __device__ __forceinline__ void attn_unit(int b,int h,int qb,const bf16*Q,const bf16*__restrict__ K,const bf16*__restrict__ V,bf16*O,char*shm){
  const int tid=threadIdx.x,lane=tid&63,r32=lane&31,hi=lane>>5; const int wid=__builtin_amdgcn_readfirstlane(tid>>6);
  const long rowbase=(long)b*SEQ; const int q0=qb*QB;
  const bf16*Qw=Q+(rowbase+q0+wid*QBLK)*QP+h*D;
  const bf16*Kh=K+rowbase*KP+(h/GQ)*D,*Vh=V+rowbase*KP+(h/GQ)*D;
  const unsigned lds0=(unsigned)(uintptr_t)shm;
  float*wsf=(float*)(shm+LDS_WS)+wid*64;
  const bf16*ksrc=Kh+(long)lane*KP+wid*8;
  const bf16*vsrc=Vh+(long)(16*(wid&3)+(lane>>2))*KP+(wid>>2)*32+(lane&3)*8;
  const unsigned kdst=lds0+LDS_K+wid*1024, vdst=lds0+LDS_V+wid*1024;
  #define DMA_K(t,slot) glds16(ksrc+(long)(t)*KVBLK*KP,(unsigned)__builtin_amdgcn_readfirstlane(kdst+(slot)))
  #define DMA_V(t,slot) glds16(vsrc+(long)(t)*KVBLK*KP,(unsigned)__builtin_amdgcn_readfirstlane(vdst+(slot)))
  const int vb0=(int)(lds0+LDS_V)+((lane>>4)&1)*32+(lane&3)*8+(4*hi+((lane&15)>>2))*64;
  const char*Kbase=shm+LDS_K; bf16x8 kf[8];
  const lds_cptr shm3=(lds_cptr)shm; const lds_cptr kp0=shm3+LDS_K+hi*1024+r32*16; const lds_cptr vp0=shm3+LDS_V+((lane>>4)&1)*32+(lane&3)*8+(4*hi+((lane&15)>>2))*64;
  const int NT=SEQ/KVBLK;
  DMA_K(0,0);DMA_V(0,0);DMA_K(1,SLOTB);
  bf16x8 qr[4];
  #pragma unroll
  for(int d0=0;d0<4;++d0)qr[d0]=*reinterpret_cast<const bf16x8*>(&Qw[(long)r32*QP+d0*16+hi*8]);
  float mhat=0.f,l_reg=0.f;f32x16 o[2];o[0]=f32x16{};o[1]=f32x16{};f32x16 negm=f32x16{};asm volatile("":"+v"(negm));
  const int qrel=wid*QBLK+r32;
  #define CMASK(P0,P1,t) do{}while(0)
  bool resc=false;
  #define START(P0,P1) do{ const float rm=rowmax(P0,P1); resc=false; \
    { const float dl=rm; mhat=fadd_s(mhat,dl); \
      _Pragma("unroll") for(int r=0;r<16;++r){P0[r]=fsub_s(P0[r],dl);P1[r]=fsub_s(P1[r],dl);} \
      _Pragma("unroll") for(int r=0;r<16;++r)negm[r]=-mhat; asm volatile("":"+v"(negm)); } \
    _Pragma("unroll") for(int r=0;r<16;++r)P0[r]=__builtin_amdgcn_exp2f(P0[r]); }while(0)
  #define RESC() do{ if(resc){ asm volatile("s_waitcnt lgkmcnt(0)":::"memory"); \
      _Pragma("unroll") for(int d_=0;d_<2;++d_) _Pragma("unroll") for(int r=0;r<16;++r)o[d_][r]*=wsf[crow(r,hi)]; } }while(0)
  f32x16 pA0,pA1,pB0,pB1;
  int sl_prev=0,sl_cur=0,sl_next=SLOTB;
  #define ROT() do{sl_prev=sl_cur;sl_cur=sl_next;sl_next=(sl_next==(NSLOT-1)*SLOTB)?0:sl_next+SLOTB;}while(0)
  DMA_K(2,2*SLOTB);
  WAIT_BAR(3);
  qkt(pA0,pA1,Kbase,qr,negm,r32,hi);asm volatile("s_nop 15\n\ts_nop 7":"+v"(pA0),"+v"(pA1));CMASK(pA0,pA1,0);
  START(pA0,pA1);
  _Pragma("unroll") for(int r=0;r<16;++r)pA1[r]=__builtin_amdgcn_exp2f(pA1[r]);
  WAIT_BAR(0);
  DMA_K(3,0);DMA_V(1,SLOTB);
  ROT();
  kload8(kf,kp0+sl_cur);
  WAIT_BAR(2);
  s16x4 vlo[8],vhi[8]; u32x4 pw0,pw1,pw2,pw3;
  #define PKW(P,B) cvtpk_s(P[B],P[B+1])
  #define PAF(k) __builtin_bit_cast(bf16x8,pw##k)
  #define VFR(i) (bf16x8){vlo[i][0],vlo[i][1],vlo[i][2],vlo[i][3],vhi[i][0],vhi[i][1],vhi[i][2],vhi[i][3]}
  #define PIN(x) asm volatile("":"+v"(x))
  #define MX3(a,b,c) __builtin_fmaxf(__builtin_fmaxf((a),(b)),(c))
  #define GAPA(MF,A0,A1,A2,A3,W0,W1,PW) do{ MF; sacc+=A0; sacc+=A1; sacc+=A2; sacc+=A3; PIN(sacc); W0; W1; PIN(PW); SBAR(); }while(0)
  #define EX(v) __builtin_amdgcn_exp2f(v)
  #define GAPB(MF,X,B) do{ MF; X[B]=EX(X[B]); X[B+1]=EX(X[B+1]); X[B+2]=EX(X[B+2]); X[B+3]=EX(X[B+3]); PIN(X); SBAR(); }while(0)
  #define VRD(i) do{ vlo[i]=vtr(vp_+(((i)>>2)*4096+((i)&3)*1024)); vhi[i]=vtr(vp_+(((i)>>2)*4096+((i)&3)*1024+512)); }while(0)
  #define KRD(G,j) do{ if(G){ kload2(kf,kp0+sl_next,j); SBAR(); } }while(0)
  #define STEP(C0,C1,P0,P1,t,GK,GV,GL) do{ SBAR(); \
    const lds_cptr vp_=vp0+sl_prev; \
    VRD(0); SBAR(); float sacc=(P0[0]+P0[1]); \
    GAPA(C0=__builtin_amdgcn_mfma_f32_32x32x16_bf16(kf[0],qr[0],negm,0,0,0), P0[2],P0[3],P0[4],P0[5],     pw0[0]=PKW(P0,0), pw0[1]=PKW(P0,2), pw0); \
    VRD(4); SBAR(); GAPA(C1=__builtin_amdgcn_mfma_f32_32x32x16_bf16(kf[1],qr[0],negm,0,0,0), P0[6],P0[7],P0[8],P0[9],     pw0[2]=PKW(P0,4), pw0[3]=PKW(P0,6), pw0); \
    VRD(1); SBAR(); GAPA(C0=__builtin_amdgcn_mfma_f32_32x32x16_bf16(kf[2],qr[1],C0,0,0,0),   P0[10],P0[11],P0[12],P0[13], pw1[0]=PKW(P0,8), pw1[1]=PKW(P0,10), pw1); \
    VRD(5); SBAR(); GAPA(C1=__builtin_amdgcn_mfma_f32_32x32x16_bf16(kf[3],qr[1],C1,0,0,0),   P0[14],P0[15],P1[0],P1[1],   pw1[2]=PKW(P0,12),pw1[3]=PKW(P0,14), pw1); \
    VRD(2); SBAR(); GAPA(C0=__builtin_amdgcn_mfma_f32_32x32x16_bf16(kf[4],qr[2],C0,0,0,0),   P1[2],P1[3],P1[4],P1[5],     pw2[0]=PKW(P1,0), pw2[1]=PKW(P1,2), pw2); \
    VRD(6); SBAR(); GAPA(C1=__builtin_amdgcn_mfma_f32_32x32x16_bf16(kf[5],qr[2],C1,0,0,0),   P1[6],P1[7],P1[8],P1[9],     pw2[2]=PKW(P1,4), pw2[3]=PKW(P1,6), pw2); \
    VRD(3); SBAR(); GAPA(C0=__builtin_amdgcn_mfma_f32_32x32x16_bf16(kf[6],qr[3],C0,0,0,0),   P1[10],P1[11],P1[12],P1[13], pw3[0]=PKW(P1,8), pw3[1]=PKW(P1,10), pw3); \
    VRD(7); SBAR(); GAPA(C1=__builtin_amdgcn_mfma_f32_32x32x16_bf16(kf[7],qr[3],C1,0,0,0),   P1[14],P1[15],0.f,0.f,       pw3[2]=PKW(P1,12),pw3[3]=PKW(P1,14), pw3); \
    l_reg+=sacc; \
    if(GK){DMA_K((t)+3,sl_cur);} if(GV){DMA_V((t)+1,sl_next);} \
    CMASK(C0,C1,t); \
    if(THRL>=0)   \
    { float a=MX3(C0[0],C0[1],C1[0]),b=MX3(C0[2],C0[3],C1[1]); a=MX3(a,C1[2],C1[3]); \
      _Pragma("unroll") for(int r=4;r<16;r+=4){a=MX3(a,C0[r],C0[r+1]);b=MX3(b,C0[r+2],C0[r+3]);a=MX3(a,C1[r],C1[r+1]);b=MX3(b,C1[r+2],C1[r+3]);} \
      float rm=__builtin_fmaxf(a,b); { auto rr=__builtin_amdgcn_permlane32_swap(__float_as_uint(rm),__float_as_uint(rm),false,false); rm=__builtin_fmaxf(__uint_as_float(rr[0]),__uint_as_float(rr[1])); } \
      resc=false; \
      if(__builtin_expect(__any(rm>(float)THRL),0)){ const float dl=__builtin_fmaxf(rm,0.f); mhat+=dl; \
        _Pragma("unroll") for(int r=0;r<16;++r){C0[r]-=dl;C1[r]-=dl;} \
        _Pragma("unroll") for(int r=0;r<16;++r)negm[r]=-mhat; asm volatile("":"+v"(negm)); \
        const float f=__builtin_amdgcn_exp2f(-dl); l_reg*=f; if(hi==0)wsf[r32]=f; resc=true; } } \
    else { resc=false; } \
    SBAR(); \
    GAPB(o[0]=__builtin_amdgcn_mfma_f32_32x32x16_bf16(PAF(0),VFR(0),o[0],0,0,0), C0,0); \
    GAPB(o[1]=__builtin_amdgcn_mfma_f32_32x32x16_bf16(PAF(0),VFR(4),o[1],0,0,0), C0,4); \
    KRD(GL,0); GAPB(o[0]=__builtin_amdgcn_mfma_f32_32x32x16_bf16(PAF(1),VFR(1),o[0],0,0,0), C0,8); \
    KRD(GL,1); GAPB(o[1]=__builtin_amdgcn_mfma_f32_32x32x16_bf16(PAF(1),VFR(5),o[1],0,0,0), C0,12); \
    KRD(GL,2); GAPB(o[0]=__builtin_amdgcn_mfma_f32_32x32x16_bf16(PAF(2),VFR(2),o[0],0,0,0), C1,0); \
    KRD(GL,3); GAPB(o[1]=__builtin_amdgcn_mfma_f32_32x32x16_bf16(PAF(2),VFR(6),o[1],0,0,0), C1,4); \
    GAPB(o[0]=__builtin_amdgcn_mfma_f32_32x32x16_bf16(PAF(3),VFR(3),o[0],0,0,0), C1,8); \
    GAPB(o[1]=__builtin_amdgcn_mfma_f32_32x32x16_bf16(PAF(3),VFR(7),o[1],0,0,0), C1,12); \
    }while(0)
  int t=1;
  #undef CMASK
  #define CMASK(P0,P1,t) do{}while(0)
  for(;t+5<NT;t+=2){
    STEP(pB0,pB1,pA0,pA1,t,true,true,true);     WAIT_BAR(2); RESC(); ROT();
    STEP(pA0,pA1,pB0,pB1,t+1,true,true,true);   WAIT_BAR(2); RESC(); ROT();
  }
  #undef CMASK
  #define CMASK(P0,P1,t) do{}while(0)
  #define ENDW(tt) do{ if((tt)+3<NT){WAIT_BAR(2);} else if((tt)+2<NT){WAIT_BAR(1);} else {WAIT_BAR(0);} }while(0)
  for(;t+1<NT;t+=2){
    STEP(pB0,pB1,pA0,pA1,t,(t+3<NT),(t+1<NT),(t+1<NT));       ENDW(t);   RESC(); ROT();
    STEP(pA0,pA1,pB0,pB1,t+1,(t+4<NT),(t+2<NT),(t+2<NT));     ENDW(t+1); RESC(); ROT();
  }
  STEP(pB0,pB1,pA0,pA1,NT-1,false,false,false); RESC();
  { float sacc=pB0[0]+pB0[1]; _Pragma("unroll") for(int r=2;r<16;++r)sacc+=pB0[r]; _Pragma("unroll") for(int r=0;r<16;++r)sacc+=pB1[r]; l_reg+=sacc;
    pw0=(u32x4){PKW(pB0,0),PKW(pB0,2),PKW(pB0,4),PKW(pB0,6)};pw1=(u32x4){PKW(pB0,8),PKW(pB0,10),PKW(pB0,12),PKW(pB0,14)};pw2=(u32x4){PKW(pB1,0),PKW(pB1,2),PKW(pB1,4),PKW(pB1,6)};pw3=(u32x4){PKW(pB1,8),PKW(pB1,10),PKW(pB1,12),PKW(pB1,14)};
    SBAR(); pv(o,vb0+sl_cur,PAF(0),PAF(1),PAF(2),PAF(3)); }
  #undef PKW
  #undef PAF
  #undef VFR
  #undef PIN
  #undef MX3
  #undef GAPA
  #undef GAPB
  #undef EX
  #undef VRD
  #undef KRD
  #undef STEP
  #undef ENDW
  {auto rr=__builtin_amdgcn_permlane32_swap(__float_as_uint(l_reg),__float_as_uint(l_reg),false,false);l_reg=__uint_as_float(rr[0])+__uint_as_float(rr[1]);}
  if(hi==0)wsf[32+r32]=l_reg;asm volatile("s_waitcnt lgkmcnt(0)":::"memory");
  float rli[16];
  #pragma unroll
  for(int r=0;r<16;++r)rli[r]=__builtin_amdgcn_rcpf(wsf[32+crow(r,hi)]);
  bf16*Ow=O+(rowbase+q0+wid*QBLK)*OP+h*D;
  { bf16*stg=(bf16*)(shm+LDS_OST)+wid*2048;
    #pragma unroll
    for(int r=0;r<16;++r){const int orow=crow(r,hi);
      #pragma unroll
      for(int d0=0;d0<2;++d0)stg[orow*64+d0*32+r32]=__float2bfloat16(o[d0][r]*rli[r]);}
    asm volatile("s_waitcnt lgkmcnt(0)":::"memory");
    #pragma unroll
    for(int i=0;i<4;++i){const int row=i*8+(lane>>3),ch=lane&7; const u32x4 v=*(const u32x4*)(stg+row*64+ch*8); ATTN_STORE16(Ow+(long)row*OP+ch*8,v);} }
  asm volatile("s_waitcnt lgkmcnt(0)\n\ts_barrier":::"memory");
  #undef DMA_K
  #undef DMA_V
  #undef CMASK
  #undef START
  #undef RESC
  #undef ROT
}
constexpr int ATTN_LDS_BYTES=LDS_BYTES;
struct AttnTensors { const bf16* Q; const bf16* K; const bf16* V; bf16* O; };
struct AttnUnit { int bh; int qb; };
struct StaticOrder {
  int vcu,G;
  __device__ __forceinline__ explicit StaticOrder(int grid,int block):vcu((grid%8==0)?(block%8)*(grid/8)+block/8:block),G(grid){}
  __device__ __forceinline__ bool next(int i,AttnUnit&u)const{ const int U=vcu+G*i; if(U>=BATCH*NHEAD*NQB)return false; u.bh=U/NQB; u.qb=U%NQB; return true; }
  __device__ __forceinline__ void a_ready(const AttnUnit&)const{}
  __device__ __forceinline__ void done(const AttnUnit&)const{}
};
template<class Sched,int THRL=8> __device__ __forceinline__ void attn_phase(char*lds,const AttnTensors&T,const Sched&S){
  AttnUnit u;
  for(int i=0;S.next(i,u);++i){ S.a_ready(u); attn_unit<THRL>(u.bh/NHEAD,u.bh%NHEAD,u.qb,T.Q,T.K,T.V,T.O,lds); S.done(u); }
}
#undef SBAR
#undef WAIT_BAR
}
namespace cg = cooperative_groups;
#define LAS __attribute__((address_space(3)))
typedef unsigned short bf16;
typedef float f32x4 __attribute__((ext_vector_type(4)));
typedef float f32x16 __attribute__((ext_vector_type(16)));
typedef short bf16x8 __attribute__((ext_vector_type(8)));
typedef short s16x4 __attribute__((ext_vector_type(4)));
typedef unsigned v4u __attribute__((ext_vector_type(4)));
typedef unsigned v2u __attribute__((ext_vector_type(2)));

constexpr int NB = 8, SEQ = 8192, DM = 1024, M = NB * SEQ, NPROJ = 2816, NPAD = 3072, FF = 2816, NWAVES = 8;
constexpr float EPS = 1e-6f;
constexpr size_t MiB = 1u << 20;
constexpr size_t WS_SS = 0;
constexpr size_t WS_BA = 1 * MiB;
constexpr size_t WS_EG = 5 * MiB;
constexpr size_t WS_WIN = 10 * MiB, WS_WOUT = 16 * MiB, WS_WGU = 18 * MiB, WS_WDN = 30 * MiB, WS_WPG = 36 * MiB, WS_WPL = 38 * MiB;
constexpr size_t WS_PB = 48 * MiB;
constexpr size_t WS_B = 80 * MiB;
constexpr size_t WS_C = 208 * MiB;
constexpr size_t WS_W = WS_C, WS_UT = WS_C + 128 * MiB, WS_QKM = WS_C + 256 * MiB;
constexpr size_t WS_D = 560 * MiB;
constexpr size_t WS_QA = WS_D, WS_KA = WS_D + 64 * MiB, WS_VA = WS_D + 80 * MiB, WS_DQ = WS_D + 96 * MiB, WS_DK = WS_D + 160 * MiB, WS_KT = WS_D + 224 * MiB, WS_VT = WS_D + 288 * MiB, WS_Z = WS_D + 352 * MiB;
constexpr size_t WS_OF = WS_VT, WS_OB = WS_DK, WS_HB1 = WS_D;
constexpr size_t WS_QCTR = 800 * 1024;
constexpr size_t WS_END = 1024 * MiB;
static_assert(WS_Z + 64 * MiB <= WS_END, "ws map");
constexpr int LDS_BYTES = 147456;
constexpr int SAP = 68;

struct Args { const float* in[19]; float* out; unsigned char* ws; int ph_lo, ph_hi; };

struct Frame {
    LAS unsigned char* lds; int tid, lane, wave, vcu, G;
    const float* const* in; float* out; unsigned char* ws;
    __device__ __forceinline__ const float* x() const { return in[0]; }
    __device__ __forceinline__ const float* p() const { return in[1]; }
    __device__ __forceinline__ const float* norm_mix() const { return in[2]; }
    __device__ __forceinline__ const float* w_in() const { return in[3]; }
    __device__ __forceinline__ const float* conv_w() const { return in[4]; }
    __device__ __forceinline__ const float* q_norm() const { return in[5]; }
    __device__ __forceinline__ const float* k_norm() const { return in[6]; }
    __device__ __forceinline__ const float* a_log() const { return in[7]; }
    __device__ __forceinline__ const float* dt_bias() const { return in[8]; }
    __device__ __forceinline__ const float* dn_norm() const { return in[9]; }
    __device__ __forceinline__ const float* w_out() const { return in[10]; }
    __device__ __forceinline__ const float* norm_ffn() const { return in[11]; }
    __device__ __forceinline__ const float* w_gate() const { return in[12]; }
    __device__ __forceinline__ const float* w_up() const { return in[13]; }
    __device__ __forceinline__ const float* w_down() const { return in[14]; }
    __device__ __forceinline__ const float* norm_ple() const { return in[15]; }
    __device__ __forceinline__ const float* w_ple_gate() const { return in[16]; }
    __device__ __forceinline__ const float* w_ple() const { return in[17]; }
    __device__ __forceinline__ const float* norm_final() const { return in[18]; }
    __device__ __forceinline__ float* SS() const { return (float*)(ws + WS_SS); }
    __device__ __forceinline__ float* BA() const { return (float*)(ws + WS_BA); }
    __device__ __forceinline__ float* EG() const { return (float*)(ws + WS_EG); }
    __device__ __forceinline__ unsigned* QCTR() const { return (unsigned*)(ws + WS_QCTR); }
    __device__ __forceinline__ bf16* Wt_in() const { return (bf16*)(ws + WS_WIN); }
    __device__ __forceinline__ bf16* Wt_out() const { return (bf16*)(ws + WS_WOUT); }
    __device__ __forceinline__ bf16* Wt_gu() const { return (bf16*)(ws + WS_WGU); }
    __device__ __forceinline__ bf16* Wt_dn() const { return (bf16*)(ws + WS_WDN); }
    __device__ __forceinline__ bf16* Wt_pg() const { return (bf16*)(ws + WS_WPG); }
    __device__ __forceinline__ bf16* Wt_pl() const { return (bf16*)(ws + WS_WPL); }
    __device__ __forceinline__ bf16* PB() const { return (bf16*)(ws + WS_PB); }
    __device__ __forceinline__ bf16* XN() const { return (bf16*)(ws + WS_B); }
    __device__ __forceinline__ bf16* MIXED() const { return (bf16*)(ws + WS_B); }
    __device__ __forceinline__ bf16* HB2() const { return (bf16*)(ws + WS_B); }
    __device__ __forceinline__ bf16* PROJ() const { return (bf16*)(ws + WS_C); }
    __device__ __forceinline__ bf16* W() const { return (bf16*)(ws + WS_W); }
    __device__ __forceinline__ bf16* UT() const { return (bf16*)(ws + WS_UT); }
    __device__ __forceinline__ bf16* QKM() const { return (bf16*)(ws + WS_QKM); }
    __device__ __forceinline__ bf16* ACT() const { return (bf16*)(ws + WS_C); }
    __device__ __forceinline__ bf16* PE() const { return (bf16*)(ws + WS_C); }
    __device__ __forceinline__ bf16* QA() const { return (bf16*)(ws + WS_QA); }
    __device__ __forceinline__ bf16* KA() const { return (bf16*)(ws + WS_KA); }
    __device__ __forceinline__ bf16* VA() const { return (bf16*)(ws + WS_VA); }
    __device__ __forceinline__ bf16* DQ() const { return (bf16*)(ws + WS_DQ); }
    __device__ __forceinline__ bf16* DK() const { return (bf16*)(ws + WS_DK); }
    __device__ __forceinline__ bf16* KT() const { return (bf16*)(ws + WS_KT); }
    __device__ __forceinline__ bf16* VT() const { return (bf16*)(ws + WS_VT); }
    __device__ __forceinline__ bf16* Z() const { return (bf16*)(ws + WS_Z); }
    __device__ __forceinline__ bf16* OF() const { return (bf16*)(ws + WS_OF); }
    __device__ __forceinline__ bf16* OB() const { return (bf16*)(ws + WS_OB); }
    __device__ __forceinline__ bf16* HB1() const { return (bf16*)(ws + WS_HB1); }
};
#define LDS_FENCE() asm volatile("s_waitcnt lgkmcnt(0)" ::: "memory")
__device__ __forceinline__ unsigned pk2(float lo, float hi) { return attn_body::cvtpk_s(lo, hi); }
__device__ __forceinline__ float bflo(unsigned w) { return __uint_as_float(w << 16); }
__device__ __forceinline__ float bfhi(unsigned w) { return __uint_as_float(w & 0xffff0000u); }
__device__ __forceinline__ float bf2f(short s) { return __uint_as_float(((unsigned)(unsigned short)s) << 16); }
__device__ __forceinline__ bf16 f2bf(float f) { return (bf16)(pk2(f, 0.f) & 0xffffu); }
__device__ __forceinline__ float wave_sum(float v) {
#pragma unroll
    for (int o = 1; o < 64; o <<= 1) v += __shfl_xor(v, o);
    return v;
}
__device__ __forceinline__ int crow(int r, int hi) { return (r & 3) + 8 * (r >> 2) + 4 * hi; }
__device__ __forceinline__ float fast_sig(float v) { return __builtin_amdgcn_rcpf(1.f + __expf(-v)); }
#define MFMA32(a, b, c) __builtin_amdgcn_mfma_f32_32x32x16_bf16((a), (b), (c), 0, 0, 0)

__device__ __forceinline__ void p0_transpose_item(const float* W, int ldw, int K, int ncols, int nvalid, bf16* WT, int rb, int rstride, int roff, const float* gain, LAS float* scr, int item, int lane) {
    const int nblk = ncols / 32, kb = item / nblk, nb = item % nblk, k0 = 64 * kb, n0 = 32 * nb;
    float tv[32];
#pragma unroll
    for (int i = 0; i < 32; ++i) { const int kk = 2 * i + (lane >> 5), n = n0 + (lane & 31); tv[i] = (n < nvalid) ? W[(size_t)(k0 + kk) * ldw + n] : 0.f; }
#pragma unroll
    for (int i = 0; i < 32; ++i) { const int kk = 2 * i + (lane >> 5); float v = tv[i]; if (gain) v *= gain[k0 + kk]; scr[kk * 33 + (lane & 31)] = v; }
    LDS_FENCE();
    const int c = lane & 7;
#pragma unroll
    for (int j = 0; j < 4; ++j) { const int nl = (lane >> 3) + 8 * j, n = n0 + nl; const LAS float* s = scr + (8 * c) * 33 + nl;
        v4u o; o.x = pk2(s[0 * 33], s[1 * 33]); o.y = pk2(s[2 * 33], s[3 * 33]); o.z = pk2(s[4 * 33], s[5 * 33]); o.w = pk2(s[6 * 33], s[7 * 33]);
        const int drow = (n / rb) * rstride + roff + (n % rb);
        *(v4u*)(WT + (size_t)drow * K + k0 + 8 * c) = o; }
    LDS_FENCE();
}
__device__ __forceinline__ void p0_prologue(Frame& F) {
    LAS float* scr = (LAS float*)(F.lds + F.wave * 16384);
    const int gw = F.vcu * NWAVES + F.wave, NGW = F.G * NWAVES;
    constexpr int I_IN = 16 * (NPAD / 32), I_OUT = 16 * 32, I_G = 16 * (FF / 32), I_DN = (FF / 64) * 32, I_PG = 16 * 32, I_PL = 4 * 32;
    constexpr int NITEMS = I_IN + I_OUT + 2 * I_G + I_DN + I_PG + I_PL;
    constexpr int BIG = 1 << 30;
    for (int it = gw; it < NITEMS; it += NGW) {
        int r = it;
        if (r < I_IN) { p0_transpose_item(F.w_in(), 2832, 1024, NPAD, 2832, F.Wt_in(), BIG, 0, 0, nullptr, scr, r, F.lane); continue; } r -= I_IN;
        if (r < I_OUT) { p0_transpose_item(F.w_out(), 1024, 1024, 1024, 1024, F.Wt_out(), BIG, 0, 0, nullptr, scr, r, F.lane); continue; } r -= I_OUT;
        if (r < I_G) { p0_transpose_item(F.w_gate(), FF, 1024, FF, FF, F.Wt_gu(), 128, 256, 0, F.norm_ffn(), scr, r, F.lane); continue; } r -= I_G;
        if (r < I_G) { p0_transpose_item(F.w_up(), FF, 1024, FF, FF, F.Wt_gu(), 128, 256, 128, F.norm_ffn(), scr, r, F.lane); continue; } r -= I_G;
        if (r < I_DN) { p0_transpose_item(F.w_down(), 1024, FF, 1024, 1024, F.Wt_dn(), BIG, 0, 0, nullptr, scr, r, F.lane); continue; } r -= I_DN;
        if (r < I_PG) { p0_transpose_item(F.w_ple_gate(), 1024, 1024, 1024, 1024, F.Wt_pg(), BIG, 0, 0, F.norm_ple(), scr, r, F.lane); continue; } r -= I_PG;
        p0_transpose_item(F.w_ple(), 1024, 256, 1024, 1024, F.Wt_pl(), BIG, 0, 0, nullptr, scr, r, F.lane);
    }
    f32x4 gn[4];
#pragma unroll
    for (int j = 0; j < 4; ++j) gn[j] = ((const f32x4*)F.norm_mix())[F.lane + 64 * j];
    for (int m0 = gw * 4; m0 < M; m0 += NGW * 4) { f32x4 v[4][4];
#pragma unroll
        for (int r = 0; r < 4; ++r) { const f32x4* xr = (const f32x4*)(F.x() + (size_t)(m0 + r) * DM) + F.lane;
#pragma unroll
            for (int j = 0; j < 4; ++j) v[r][j] = xr[64 * j]; }
#pragma unroll
        for (int r = 0; r < 4; ++r) { float s = 0.f;
#pragma unroll
            for (int j = 0; j < 4; ++j) s += (v[r][j].x * v[r][j].x + v[r][j].y * v[r][j].y) + (v[r][j].z * v[r][j].z + v[r][j].w * v[r][j].w);
            const float rstd = rsqrtf(wave_sum(s) * (1.f / DM) + EPS); v2u* o8 = (v2u*)(F.XN() + (size_t)(m0 + r) * DM) + F.lane;
#pragma unroll
            for (int j = 0; j < 4; ++j) { const f32x4 y = v[r][j] * rstd * gn[j]; v2u w; w.x = pk2(y.x, y.y); w.y = pk2(y.z, y.w); o8[64 * j] = w; } }
    }
    const size_t gt = (size_t)F.vcu * 512 + F.tid, NGT = (size_t)F.G * 512;
    for (size_t i = gt; i < (size_t)M * 256 / 4; i += NGT * 4) { f32x4 v[4];
#pragma unroll
        for (int k = 0; k < 4; ++k) if (i + k * NGT < (size_t)M * 256 / 4) v[k] = ((const f32x4*)F.p())[i + k * NGT];
#pragma unroll
        for (int k = 0; k < 4; ++k) if (i + k * NGT < (size_t)M * 256 / 4) { v2u w; w.x = pk2(v[k].x, v[k].y); w.y = pk2(v[k].z, v[k].w); ((v2u*)F.PB())[i + k * NGT] = w; } }
    for (size_t i = gt; i < (size_t)3 * M; i += NGT) F.SS()[i] = 0.f;
    if (gt < 8 * 64 || (gt >= 600 && gt < 832)) F.QCTR()[gt] = 0u;
}

constexpr int P2_TAB_BYTES = 192 * 16 * 8;
__device__ __forceinline__ void p2_rope_table(Frame& F) {
    LAS float* tab = (LAS float*)F.lds;
    for (int i = F.tid; i < 192 * 16; i += NWAVES * 64) { const int pos = i >> 4, j = i & 15; const float inv = powf(10000.0f, -(float)j * (1.f / 16.f));
        float s, c; sincosf((float)(pos < 128 ? pos : pos - 128) * inv, &s, &c); tab[2 * i] = c; tab[2 * i + 1] = s; }
    LDS_FENCE(); __syncthreads();
}
__device__ __forceinline__ void p2_attn_rows(Frame& F) {
    const int gw = F.vcu * NWAVES + F.wave, NGW = F.G * NWAVES, lane = F.lane;
    constexpr float C2 = 0.125f * 1.4426950408889634f;
    const LAS float* tab = (const LAS float*)F.lds;
    const bf16* __restrict__ PROJ = F.PROJ(); bf16* __restrict__ QA = F.QA(); bf16* __restrict__ KA = F.KA(); bf16* __restrict__ VA = F.VA(); bf16* __restrict__ Z = F.Z();
    float gq[4], gk[4];
#pragma unroll
    for (int k = 0; k < 4; ++k) { gq[k] = F.q_norm()[(lane & 15) + 16 * k]; gk[k] = F.k_norm()[(lane & 15) + 16 * k]; }
    for (int m0 = gw * 4; m0 < M; m0 += NGW * 4) {
        bf16 xr[4][3][4]; unsigned vv[4]; v4u zz[4];
#pragma unroll
        for (int rr = 0; rr < 4; ++rr) { const bf16* pr = PROJ + (size_t)(m0 + rr) * NPROJ;
#pragma unroll
            for (int it = 0; it < 3; ++it) { const int idx = it * 64 + lane, head = idx >> 4, j = idx & 15;
                if (head < 10) { const bf16* hp = pr + head * 64 + j;
#pragma unroll
                    for (int k = 0; k < 4; ++k) xr[rr][it][k] = hp[16 * k]; } }
            vv[rr] = ((const unsigned*)(pr + 640))[lane]; zz[rr] = ((const v4u*)(pr + 2304))[lane]; }
#pragma unroll
        for (int rr = 0; rr < 4; ++rr) { const int m = m0 + rr, s = m & (SEQ - 1), prow = s >> 6, pcol = 128 + (s & 63);
#pragma unroll
            for (int it = 0; it < 3; ++it) { const int idx = it * 64 + lane, head = idx >> 4, j = idx & 15;
                if (head < 10) {
                    float x0 = __uint_as_float((unsigned)xr[rr][it][0] << 16), x1 = __uint_as_float((unsigned)xr[rr][it][1] << 16), x2 = __uint_as_float((unsigned)xr[rr][it][2] << 16), x3 = __uint_as_float((unsigned)xr[rr][it][3] << 16);
                    float ss = (x0 * x0 + x1 * x1) + (x2 * x2 + x3 * x3);
                    ss += __shfl_xor(ss, 1); ss += __shfl_xor(ss, 2); ss += __shfl_xor(ss, 4); ss += __shfl_xor(ss, 8);
                    const float rs = rsqrtf(ss * (1.f / 64.f) + EPS); const bool isq = head < 8;
                    x0 *= rs * (isq ? gq[0] : gk[0]); x1 *= rs * (isq ? gq[1] : gk[1]); x2 *= rs * (isq ? gq[2] : gk[2]); x3 *= rs * (isq ? gq[3] : gk[3]);
                    const float cr = tab[(prow * 16 + j) * 2], sr = tab[(prow * 16 + j) * 2 + 1], cc = tab[(pcol * 16 + j) * 2], sc = tab[(pcol * 16 + j) * 2 + 1];
                    float o0 = x0 * cr - x1 * sr, o1 = x1 * cr + x0 * sr, o2 = x2 * cc - x3 * sc, o3 = x3 * cc + x2 * sc;
                    bf16* op;
                    if (isq) { o0 *= C2; o1 *= C2; o2 *= C2; o3 *= C2; op = QA + (size_t)m * 512 + head * 64 + j; } else op = KA + (size_t)m * 128 + (head - 8) * 64 + j;
                    op[0] = f2bf(o0); op[16] = f2bf(o1); op[32] = f2bf(o2); op[48] = f2bf(o3);
                } }
            ((unsigned*)(VA + (size_t)m * 128))[lane] = vv[rr]; ((v4u*)(Z + (size_t)m * 512))[lane] = zz[rr]; }
    }
}
struct ConvIn { unsigned u[12]; float w0[5], w1[5]; };
__device__ __forceinline__ void p2_conv_load(Frame& F, int item, ConvIn& C, int lane, int wid) {
    const int type = item % 3, h4 = (item / 3) & 3, n = (item / 12) & 127, b = item / (12 * 128); const int ch = type * 512 + h4 * 128 + 2 * lane;
    const bf16* src = F.PROJ() + (size_t)b * SEQ * NPROJ + 768 + ch; const int s0 = n * 64 + 8 * wid - 2;
#pragma unroll
    for (int k = 0; k < 12; ++k) { const int s = s0 + k; C.u[k] = (s >= 0 && s < SEQ) ? *(const unsigned*)(src + (size_t)s * NPROJ) : 0u; }
#pragma unroll
    for (int j = 0; j < 5; ++j) { C.w0[j] = F.conv_w()[j * 1536 + ch]; C.w1[j] = F.conv_w()[j * 1536 + ch + 1]; }
}
__device__ __forceinline__ void p2_dn_conv(Frame& F) {
    const int lane = F.lane, wid = F.wave; constexpr int NIT = NB * 128 * 12;
    ConvIn C, Cn; int item = F.vcu; if (item < NIT) p2_conv_load(F, item, C, lane, wid);
    for (; item < NIT; item += F.G) {
        const int type = item % 3, h4 = (item / 3) & 3, n = (item / 12) & 127, b = item / (12 * 128);
        if (item + F.G < NIT) p2_conv_load(F, item + F.G, Cn, lane, wid);
        float y0[8], y1[8];
#pragma unroll
        for (int i = 0; i < 8; ++i) { float a0 = 0.f, a1 = 0.f;
#pragma unroll
            for (int j = 0; j < 5; ++j) { a0 += C.w0[j] * bflo(C.u[i + j]); a1 += C.w1[j] * bfhi(C.u[i + j]); }
            a0 = a0 * fast_sig(a0); a1 = a1 * fast_sig(a1);
            if (type < 2) { const float ss = wave_sum(a0 * a0 + a1 * a1); float rs = rsqrtf(ss + EPS); if (type == 0) rs *= 0.08838834764831845f; a0 *= rs; a1 *= rs; }
            y0[i] = a0; y1[i] = a1; }
        const size_t row0 = (size_t)b * SEQ + n * 64 + 8 * wid;
        if (type < 2) { bf16* dst = (type == 0 ? F.DQ() : F.DK()) + row0 * 512 + h4 * 128 + 2 * lane;
#pragma unroll
            for (int i = 0; i < 8; ++i) *(unsigned*)(dst + (size_t)i * 512) = pk2(y0[i], y1[i]); }
        if (type != 0) {
            bf16* dst = (type == 1 ? F.KT() : F.VT()) + ((size_t)(b * 4 + h4) * 128 + n) * 8192 + (size_t)(2 * lane) * 64 + 8 * wid;
            v4u o0, o1; o0.x = pk2(y0[0], y0[1]); o0.y = pk2(y0[2], y0[3]); o0.z = pk2(y0[4], y0[5]); o0.w = pk2(y0[6], y0[7]);
            o1.x = pk2(y1[0], y1[1]); o1.y = pk2(y1[2], y1[3]); o1.z = pk2(y1[4], y1[5]); o1.w = pk2(y1[6], y1[7]);
            *(v4u*)dst = o0; *(v4u*)(dst + 64) = o1; }
        C = Cn;
    }
}
__device__ __forceinline__ bf16x8 ld8(const bf16* p) { return *(const bf16x8*)p; }
__device__ __forceinline__ bf16x8 ld44(const bf16* p) { const s16x4 a = *(const s16x4*)p, b = *(const s16x4*)(p + 8); return (bf16x8){a[0], a[1], a[2], a[3], b[0], b[1], b[2], b[3]}; }
__device__ __forceinline__ bf16x8 pack8(float a0, float a1, float a2, float a3, float a4, float a5, float a6, float a7) {
    v4u w; w.x = pk2(a0, a1); w.y = pk2(a2, a3); w.z = pk2(a4, a5); w.w = pk2(a6, a7); return __builtin_bit_cast(bf16x8, w); }
__device__ __forceinline__ void dn_prep_item(Frame& F, int item, LAS float* SA, LAS float* sv, int lane) {
    const int n = item & 127, h8 = (item >> 7) & 7, b = item >> 10, dir = h8 >> 2, h4 = h8 & 3;
    const size_t tok0 = (size_t)b * SEQ + n * 64; const int r32 = lane & 31, hi = lane >> 5;
    const bf16* Kp = F.DK() + (tok0 + r32) * 512 + h4 * 128 + 8 * hi; const bf16* Qp = F.DQ() + (tok0 + r32) * 512 + h4 * 128 + 8 * hi;
    bf16x8 kf[2][8], qf[8];
#pragma unroll
    for (int kb = 0; kb < 8; ++kb) { kf[0][kb] = ld8(Kp + 16 * kb); kf[1][kb] = ld8(Kp + (size_t)32 * 512 + 16 * kb); qf[kb] = ld8(Qp + 16 * kb); }
    { const float* ba = F.BA() + (tok0 + lane) * 16; const float braw = ba[h8], araw = ba[8 + h8];
      const float beta = 1.f / (1.f + __expf(-braw)); const float xx = araw + F.dt_bias()[h8];
      const float sp = fmaxf(xx, 0.f) + log1pf(__expf(-fabsf(xx))); const float g = -__expf(F.a_log()[h8]) * sp;
      float gc = dir ? __shfl(g, 63 - lane) : g;
#pragma unroll
      for (int o = 1; o < 64; o <<= 1) { const float t = __shfl_up(gc, o); if (lane >= o) gc += t; }
      const float Gtot = __shfl(gc, 63); const float G = dir ? __shfl(gc, 63 - lane) : gc; const float eg = __expf(G);
      sv[lane] = G; sv[64 + lane] = beta; sv[128 + lane] = beta * eg;
      F.EG()[(size_t)item * 128 + lane] = eg; F.EG()[(size_t)item * 128 + 64 + lane] = __expf(Gtot - G); }
    LDS_FENCE();
#ifdef PROBE_SUB
    unsigned long long t_a = __builtin_amdgcn_s_memrealtime();
#endif
#pragma unroll
    for (int ti = 0; ti < 2; ++ti)
#pragma unroll
        for (int tj = 0; tj < 2; ++tj) { f32x16 acc = {}, acq = {}; int r32c = r32, hic = hi; asm volatile("" : "+v"(r32c), "+v"(hic));
#pragma unroll
            for (int kb = 0; kb < 8; ++kb) { acc = MFMA32(kf[tj][kb], kf[ti][kb], acc); acq = MFMA32(kf[tj][kb], qf[kb], acq); }
            if (ti == 0 && tj == 1) {
#pragma unroll
                for (int kb = 0; kb < 8; ++kb) qf[kb] = ld8(Qp + (size_t)32 * 512 + 16 * kb); }
            const int i = 32 * ti + r32c, ci = dir ? 63 - i : i; const float Gi = sv[i], bi = sv[64 + i]; float qv[16];
#pragma unroll
            for (int r = 0; r < 16; ++r) { const int j = 32 * tj + crow(r, hic), cj = dir ? 63 - j : j; const float dec = __expf(fminf(Gi - sv[j], 0.f));
                SA[ci * SAP + cj] = (ci > cj) ? bi * acc[r] * dec : 0.f; qv[r] = (ci >= cj) ? acq[r] * dec : 0.f; }
            bf16* qp = F.QKM() + (size_t)item * 4096 + i * 64 + 32 * tj + 4 * hic;
#pragma unroll
            for (int q = 0; q < 4; ++q) { v2u w; w.x = pk2(qv[4 * q], qv[4 * q + 1]); w.y = pk2(qv[4 * q + 2], qv[4 * q + 3]); *(v2u*)(qp + 8 * q) = w; }
            asm volatile("" ::: "memory"); }
    LDS_FENCE();
#ifdef PROBE_SUB
    unsigned long long t_b = __builtin_amdgcn_s_memrealtime();
#endif
    const bf16* VTp = F.VT() + ((size_t)(b * 4 + h4) * 128 + n) * 8192 + r32 * 64 + 8 * hi; const bf16* KTp = F.KT() + ((size_t)(b * 4 + h4) * 128 + n) * 8192 + r32 * 64 + 8 * hi;
    bf16x8 xf[4][4];
#pragma unroll
    for (int td = 0; td < 4; ++td)
#pragma unroll
        for (int kb = 0; kb < 4; ++kb) xf[td][kb] = ld8(VTp + td * 2048 + 16 * kb);
    asm volatile("" ::: "memory");
    { float T[64];
#if defined(DUP_PH) && DUP_PH == 33
      for (int rep33 = 0; rep33 < 2; ++rep33)
#endif
#pragma unroll
      for (int i = 0; i < 64; ++i) { float a = (lane == i) ? 1.f : 0.f, a2 = 0.f;
#pragma unroll
          for (int jq = 0; jq * 4 < i; ++jq) { const f32x4 a4 = *(const LAS f32x4*)(SA + i * SAP + 4 * jq);
              a -= a4.x * T[4 * jq]; if (4 * jq + 1 < i) a2 -= a4.y * T[4 * jq + 1]; if (4 * jq + 2 < i) a -= a4.z * T[4 * jq + 2]; if (4 * jq + 3 < i) a2 -= a4.w * T[4 * jq + 3];
              if ((jq & 3) == 3) asm volatile("" ::: "memory"); }
          T[i] = a + a2; asm volatile("" ::: "memory"); }
      LDS_FENCE();
#pragma unroll
      for (int i = 0; i < 64; ++i) SA[i * SAP + lane] = T[i]; }
    LDS_FENCE();
#ifdef PROBE_SUB
    unsigned long long t_c = __builtin_amdgcn_s_memrealtime();
#endif
    int r32b = r32, hib = hi; asm volatile("" : "+v"(r32b), "+v"(hib));
#if defined(DUP_PH) && DUP_PH == 35
    for (int rep35 = 0; rep35 < 2; ++rep35)
#endif
#pragma unroll
    for (int pass = 0; pass < 2; ++pass) {
        bf16x8 tb[2][4]; asm volatile("" : "+v"(r32b), "+v"(hib));
#pragma unroll
        for (int ti = 0; ti < 2; ++ti) { const int i = 32 * ti + r32b, ci = dir ? 63 - i : i;
#pragma unroll
            for (int kb = 0; kb < 4; ++kb) { float a[8];
#pragma unroll
                for (int e = 0; e < 8; ++e) { const int j = 16 * kb + 8 * hib + e, cj = dir ? 63 - j : j; a[e] = SA[ci * SAP + cj] * sv[64 + 64 * pass + j]; }
                tb[ti][kb] = pack8(a[0], a[1], a[2], a[3], a[4], a[5], a[6], a[7]); asm volatile("" ::: "memory"); } }
#pragma unroll
        for (int td = 0; td < 4; ++td) { f32x16 a0 = {}, a1 = {}; asm volatile("" : "+v"(r32b), "+v"(hib));
            if (pass == 0) {
#pragma unroll
                for (int kb = 0; kb < 4; ++kb) { a0 = MFMA32(tb[0][kb], xf[td][kb], a0); a1 = MFMA32(tb[1][kb], xf[td][kb], a1); }
#pragma unroll
                for (int kb = 0; kb < 4; ++kb) xf[td][kb] = ld8(KTp + td * 2048 + 16 * kb);
                bf16* up = F.UT() + (size_t)item * 8192 + (32 * td + r32b) * 64 + 4 * hib;
#pragma unroll
                for (int q = 0; q < 4; ++q) { v2u w; w.x = pk2(a0[4 * q], a0[4 * q + 1]); w.y = pk2(a0[4 * q + 2], a0[4 * q + 3]); *(v2u*)(up + 8 * q) = w;
                    v2u w1; w1.x = pk2(a1[4 * q], a1[4 * q + 1]); w1.y = pk2(a1[4 * q + 2], a1[4 * q + 3]); *(v2u*)(up + 32 + 8 * q) = w1; }
            } else {
#pragma unroll
                for (int kb = 0; kb < 4; ++kb) { a0 = MFMA32(xf[td][kb], tb[0][kb], a0); a1 = MFMA32(xf[td][kb], tb[1][kb], a1); }
                bf16* wp = F.W() + (size_t)item * 8192 + r32b * 128 + 32 * td + 4 * hib;
#pragma unroll
                for (int q = 0; q < 4; ++q) { v2u w; w.x = pk2(a0[4 * q], a0[4 * q + 1]); w.y = pk2(a0[4 * q + 2], a0[4 * q + 3]); *(v2u*)(wp + 8 * q) = w;
                    v2u w1; w1.x = pk2(a1[4 * q], a1[4 * q + 1]); w1.y = pk2(a1[4 * q + 2], a1[4 * q + 3]); *(v2u*)(wp + 32 * 128 + 8 * q) = w1; }
            }
            asm volatile("" ::: "memory"); }
    }
    LDS_FENCE();
#ifdef PROBE_SUB
    { asm volatile("s_waitcnt vmcnt(0)" ::: "memory"); unsigned long long t_d = __builtin_amdgcn_s_memrealtime();
      if (blockIdx.x == 0 && F.wave == 0 && lane == 0) { unsigned long long* ts = (unsigned long long*)(F.QCTR() + 1024); const unsigned long long d = (PROBE_SUB == 1) ? (t_b - t_a) : (PROBE_SUB == 2) ? (t_c - t_b) : (t_d - t_c);
          ts[13] = ((item >> 11) == 0 && (item & 2047) < 8 ? 0ull : ts[13]) + d; ts[12] = 0ull; } }
#endif
}
constexpr int SC_W = 0, SC_Q = 16896, SC_KT = 33792, SC_QK = 51200, SC_EG = 59904, SC_BUF = 60416, SC_PW = 264, SC_PK = 136;
#define SC_BAR() asm volatile("s_waitcnt lgkmcnt(0)\n\ts_barrier" ::: "memory")
__device__ __forceinline__ bf16x8 lds44(const LAS unsigned char* p) { const s16x4 a = *(const LAS s16x4*)p, b = *(const LAS s16x4*)(p + 16); return (bf16x8){a[0], a[1], a[2], a[3], b[0], b[1], b[2], b[3]}; }
__device__ __forceinline__ void lds_put16(LAS unsigned char* p, v4u v) { *(LAS v2u*)p = (v2u){v.x, v.y}; *(LAS v2u*)(p + 8) = (v2u){v.z, v.w}; }
struct ScanRegs { v4u w[4], q[4], k[4], m[2], e; };
__device__ __forceinline__ void scan_load(Frame& F, ScanRegs& R, int lt, size_t it, size_t tok0, int h4, size_t ktoff) {
#pragma unroll
    for (int k = 0; k < 4; ++k) { const int c = lt + 256 * k;
        R.w[k] = *(const v4u*)(F.W() + it * 8192 + c * 8);
        R.q[k] = *(const v4u*)(F.DQ() + (tok0 + (c >> 4)) * 512 + h4 * 128 + (c & 15) * 8);
        R.k[k] = *(const v4u*)(F.KT() + ktoff + c * 8); }
#pragma unroll
    for (int k = 0; k < 2; ++k) R.m[k] = *(const v4u*)(F.QKM() + it * 4096 + (lt + 256 * k) * 8);
    if (lt < 32) R.e = *(const v4u*)(F.EG() + it * 128 + lt * 4);
}
__device__ __forceinline__ void scan_put(const ScanRegs& R, LAS unsigned char* buf, int lt) {
#pragma unroll
    for (int k = 0; k < 4; ++k) { const int c = lt + 256 * k;
        lds_put16(buf + SC_W + (c >> 4) * SC_PW + (c & 15) * 16, R.w[k]); lds_put16(buf + SC_Q + (c >> 4) * SC_PW + (c & 15) * 16, R.q[k]); lds_put16(buf + SC_KT + (c >> 3) * SC_PK + (c & 7) * 16, R.k[k]); }
#pragma unroll
    for (int k = 0; k < 2; ++k) { const int c = lt + 256 * k; lds_put16(buf + SC_QK + (c >> 3) * SC_PK + (c & 7) * 16, R.m[k]); }
    if (lt < 32) lds_put16(buf + SC_EG + lt * 16, R.e);
}
__device__ __forceinline__ void dn_scan_wg(Frame& F, int bh8) {
    const int h8 = bh8 & 7, b = bh8 >> 3, dir = h8 >> 2, h4 = h8 & 3; const int lane = F.lane, r32 = lane & 31, hi = lane >> 5, wid = F.wave;
#define SC_N(s) (dir ? 127 - (s) : (s))
#define SC_IT(s) ((size_t)bh8 * 128 + SC_N(s))
#define SC_TOK(s) ((size_t)b * SEQ + SC_N(s) * 64)
#define SC_KTO(s) (((size_t)(b * 4 + h4) * 128 + SC_N(s)) * 8192)
    if (wid >= 4) {
        const int lt = F.tid - 256; ScanRegs R;
        scan_load(F, R, lt, SC_IT(0), SC_TOK(0), h4, SC_KTO(0)); scan_put(R, F.lds, lt);
        scan_load(F, R, lt, SC_IT(1), SC_TOK(1), h4, SC_KTO(1));
        SC_BAR();
        for (int s = 0; s < 128; ++s) {
            if (s + 1 < 128) scan_put(R, F.lds + ((s + 1) & 1) * SC_BUF, lt);
            if (s + 2 < 128) scan_load(F, R, lt, SC_IT(s + 2), SC_TOK(s + 2), h4, SC_KTO(s + 2));
            SC_BAR(); }
    } else {
        const int sl = wid; f32x16 S[4];
#pragma unroll
        for (int t = 0; t < 4; ++t) S[t] = (f32x16){};
        bf16* Obase = (dir ? F.OB() : F.OF()) + h4 * 128 + 32 * sl + 4 * hi;
        const bf16* UTb = F.UT() + (size_t)(32 * sl + r32) * 64 + 4 * hi;
        s16x4 ut[8];
#pragma unroll
        for (int q = 0; q < 8; ++q) ut[q] = *(const s16x4*)(UTb + SC_IT(0) * 8192 + 8 * q);
        SC_BAR();
        for (int s = 0; s < 128; ++s) {
            const LAS unsigned char* buf = F.lds + (s & 1) * SC_BUF; const size_t tok0 = SC_TOK(s);
            const LAS unsigned char* aW = buf + SC_W + r32 * SC_PW + 8 * hi; const LAS unsigned char* aQ = buf + SC_Q + r32 * SC_PW + 8 * hi;
            const LAS unsigned char* aK = buf + SC_KT + r32 * SC_PK + 8 * hi; const LAS unsigned char* aM = buf + SC_QK + r32 * SC_PK + 8 * hi;
            const LAS float* eg = (const LAS float*)(buf + SC_EG);
            bf16x8 Sb[8];
#pragma unroll
            for (int kb = 0; kb < 8; ++kb) { const int tk = kb >> 1, rb = 8 * (kb & 1); Sb[kb] = pack8(S[tk][rb], S[tk][rb + 1], S[tk][rb + 2], S[tk][rb + 3], S[tk][rb + 4], S[tk][rb + 5], S[tk][rb + 6], S[tk][rb + 7]); }
            f32x16 vn[2];
            { f32x16 a0 = {}, a1 = {};
#pragma unroll
              for (int kb = 0; kb < 8; ++kb) { a0 = MFMA32(lds44(aW + 32 * kb), Sb[kb], a0); a1 = MFMA32(lds44(aW + 32 * SC_PW + 32 * kb), Sb[kb], a1); }
#pragma unroll
              for (int q = 0; q < 4; ++q)
#pragma unroll
                  for (int e = 0; e < 4; ++e) { a0[4 * q + e] = bf2f(ut[q][e]) - a0[4 * q + e]; a1[4 * q + e] = bf2f(ut[4 + q][e]) - a1[4 * q + e]; }
              vn[0] = a0; vn[1] = a1; }
            if (s + 1 < 128) {
#pragma unroll
                for (int q = 0; q < 8; ++q) ut[q] = *(const s16x4*)(UTb + SC_IT(s + 1) * 8192 + 8 * q); }
            bf16x8 vb[4];
#pragma unroll
            for (int k2 = 0; k2 < 4; ++k2) { const int tc = k2 >> 1, rb = 8 * (k2 & 1);
                vb[k2] = pack8(vn[tc][rb], vn[tc][rb + 1], vn[tc][rb + 2], vn[tc][rb + 3], vn[tc][rb + 4], vn[tc][rb + 5], vn[tc][rb + 6], vn[tc][rb + 7]); }
            { f32x16 o0 = {}, o1 = {};
#pragma unroll
              for (int kb = 0; kb < 8; ++kb) { o0 = MFMA32(Sb[kb], lds44(aQ + 32 * kb), o0); o1 = MFMA32(Sb[kb], lds44(aQ + 32 * SC_PW + 32 * kb), o1); }
              o0 = o0 * eg[r32]; o1 = o1 * eg[32 + r32];
#pragma unroll
              for (int k2 = 0; k2 < 4; ++k2) { o0 = MFMA32(vb[k2], lds44(aM + 32 * k2), o0); o1 = MFMA32(vb[k2], lds44(aM + 32 * SC_PK + 32 * k2), o1); }
              bf16* op = Obase + (tok0 + r32) * 512;
#pragma unroll
              for (int q = 0; q < 4; ++q) { v2u w; w.x = pk2(o0[4 * q], o0[4 * q + 1]); w.y = pk2(o0[4 * q + 2], o0[4 * q + 3]); *(v2u*)(op + 8 * q) = w;
                  v2u w1; w1.x = pk2(o1[4 * q], o1[4 * q + 1]); w1.y = pk2(o1[4 * q + 2], o1[4 * q + 3]); *(v2u*)(op + 32 * 512 + 8 * q) = w1; } }
            const float gtot = eg[dir ? 0 : 63];
#pragma unroll
            for (int tk = 0; tk < 4; ++tk) S[tk] = S[tk] * gtot;
#pragma unroll
            for (int k2 = 0; k2 < 4; ++k2) { const int tc = k2 >> 1, rb = 8 * (k2 & 1); float l[8];
#pragma unroll
                for (int h = 0; h < 2; ++h) { const f32x4 l4 = *(const LAS f32x4*)(eg + 64 + 32 * tc + 8 * (2 * (k2 & 1) + h) + 4 * hi);
#pragma unroll
                    for (int e = 0; e < 4; ++e) l[4 * h + e] = l4[e]; }
                const bf16x8 vsb = pack8(vn[tc][rb] * l[0], vn[tc][rb + 1] * l[1], vn[tc][rb + 2] * l[2], vn[tc][rb + 3] * l[3], vn[tc][rb + 4] * l[4], vn[tc][rb + 5] * l[5], vn[tc][rb + 6] * l[6], vn[tc][rb + 7] * l[7]);
#pragma unroll
                for (int tk = 0; tk < 4; ++tk) S[tk] = MFMA32(lds44(aK + tk * 32 * SC_PK + 32 * k2), vsb, S[tk]); }
            SC_BAR();
        }
    }
#undef SC_N
#undef SC_IT
#undef SC_TOK
#undef SC_KTO
}
struct DynOrder {
    unsigned* ctr; int xcd; LAS unsigned* slot;
    __device__ __forceinline__ bool next(int, attn_body::AttnUnit& u) const {
        if (threadIdx.x == 0) { unsigned v = 0xffffffffu;
            for (int k = 0; k < 8; ++k) { const int x = (xcd + k) & 7; const unsigned t = __hip_atomic_fetch_add(ctr + 64 * x, 1u, __ATOMIC_RELAXED, __HIP_MEMORY_SCOPE_AGENT); if (t < 256u) { v = (unsigned)x | (t << 3); break; } }
            *slot = v; }
        asm volatile("s_waitcnt vmcnt(0) lgkmcnt(0)\n\ts_barrier" ::: "memory");
        const unsigned v = *slot;
        asm volatile("s_waitcnt lgkmcnt(0)\n\ts_barrier" ::: "memory");
        if (v == 0xffffffffu) return false;
        const unsigned x = v & 7u, t = v >> 3; u.bh = (int)(x + 8u * (t >> 5)); u.qb = (int)(t & 31u); return true; }
    __device__ __forceinline__ void a_ready(const attn_body::AttnUnit&) const {}
    __device__ __forceinline__ void done(const attn_body::AttnUnit&) const {}
};
__device__ __forceinline__ void p5_mix_chunk(Frame& F, const int tok0) {
    const int lane = F.lane;
    const float g0 = F.dn_norm()[2 * lane], g1 = F.dn_norm()[2 * lane + 1];
    const bf16* __restrict__ OFp = F.OF(); const bf16* __restrict__ OBp = F.OB(); const bf16* __restrict__ Zp = F.Z(); bf16* __restrict__ MX = F.MIXED();
    for (int t0 = tok0 + 2 * F.wave; t0 < tok0 + 64; t0 += 2 * NWAVES) { unsigned a[8], c[8], z[8];
#pragma unroll
        for (int k = 0; k < 8; ++k) { const size_t off = (size_t)(t0 + (k >> 2)) * 512 + (k & 3) * 128 + 2 * lane; a[k] = *(const unsigned*)(OFp + off); c[k] = *(const unsigned*)(OBp + off); z[k] = *(const unsigned*)(Zp + off); }
#pragma unroll
        for (int k = 0; k < 8; ++k) { const float o0 = bflo(a[k]) + bflo(c[k]), o1 = bfhi(a[k]) + bfhi(c[k]); const float rs = rsqrtf(wave_sum(o0 * o0 + o1 * o1) * (1.f / 128.f) + EPS);
            const float z0 = bflo(z[k]), z1 = bfhi(z[k]);
            *(unsigned*)(MX + (size_t)(t0 + (k >> 2)) * 1024 + 512 + (k & 3) * 128 + 2 * lane) = pk2(o0 * rs * g0 * z0 * fast_sig(z0), o1 * rs * g1 * z1 * fast_sig(z1)); } }
}
__device__ __forceinline__ void p10_final(Frame& F, const float probe_delta) {
    const int gw = F.vcu * NWAVES + F.wave, NGW = F.G * NWAVES;
    f32x4 gn[4];
#pragma unroll
    for (int j = 0; j < 4; ++j) gn[j] = ((const f32x4*)F.norm_final())[F.lane + 64 * j];
    for (int m0 = gw * 4; m0 < M; m0 += NGW * 4) { v2u v[4][4]; float sq[4];
#pragma unroll
        for (int r = 0; r < 4; ++r) { const v2u* xr = (const v2u*)(F.HB1() + (size_t)(m0 + r) * DM) + F.lane; sq[r] = F.SS()[2 * M + m0 + r];
#pragma unroll
            for (int j = 0; j < 4; ++j) v[r][j] = xr[64 * j]; }
#pragma unroll
        for (int r = 0; r < 4; ++r) { f32x4* xr = (f32x4*)(F.out + (size_t)(m0 + r) * DM) + F.lane; const float rstd = rsqrtf(sq[r] * (1.f / DM) + EPS); const int m = m0 + r;
#pragma unroll
            for (int j = 0; j < 4; ++j) { f32x4 y = (f32x4){bflo(v[r][j].x), bfhi(v[r][j].x), bflo(v[r][j].y), bfhi(v[r][j].y)} * rstd * gn[j]; if (probe_delta != 0.f && m < 1024) y = y + probe_delta; __builtin_nontemporal_store(y, &xr[64 * j]);
#ifdef PROBE_DUPWRITE
                __builtin_nontemporal_store(y, (f32x4*)((float*)(F.ws + WS_C) + (size_t)m * DM) + F.lane + 64 * j);
#endif
#ifdef PROBE_DUPOUT
                asm volatile("" ::: "memory"); __builtin_nontemporal_store(y, &xr[64 * j]);
#endif
            } } }
}
constexpr int N_PHASES = 11;
__global__ void __launch_bounds__(NWAVES * 64, 2) hymba_fwd(Args args) {
    extern __shared__ __attribute__((aligned(16))) unsigned char lds[];
    cg::grid_group grid = cg::this_grid();
    Frame F;
    F.lds = (LAS unsigned char*)lds; F.tid = threadIdx.x; F.lane = F.tid & 63; F.wave = __builtin_amdgcn_readfirstlane(F.tid >> 6);
    F.G = gridDim.x; { const int bx = blockIdx.x; F.vcu = (F.G % 8 == 0) ? (bx % 8) * (F.G / 8) + bx / 8 : bx; }
    F.in = args.in; F.out = args.out; F.ws = args.ws;
    const int lo = args.ph_lo, hi = args.ph_hi; unsigned bar_epoch = 0u;
    if (hi > 1000) grid.sync();
#ifndef ONLY_PH
#define ONLY_PH -1
#endif
#define IN(k) ((ONLY_PH < 0 || ONLY_PH == (k)) && lo <= (k) && (k) < hi)
#ifndef DUP_PH
#define DUP_PH -1
#endif
#define REPS(k) ((DUP_PH == (k)) ? 2 : 1)
#define SEAM(k) do { if (IN(k) && IN((k) + 1)) { { \
        asm volatile("s_waitcnt vmcnt(0)" ::: "memory"); __syncthreads();            \
        ++bar_epoch; \
        if (F.tid == 0) { unsigned* c_ = F.QCTR() + 512; __builtin_amdgcn_fence(__ATOMIC_RELEASE, "agent"); asm volatile("s_waitcnt vmcnt(0)" ::: "memory");     \
            __hip_atomic_fetch_add(c_, 1u, __ATOMIC_RELAXED, __HIP_MEMORY_SCOPE_AGENT); \
            const unsigned tgt_ = bar_epoch * (unsigned)F.G; while (__hip_atomic_load(c_, __ATOMIC_RELAXED, __HIP_MEMORY_SCOPE_AGENT) < tgt_) __builtin_amdgcn_s_sleep(1); \
            __builtin_amdgcn_fence(__ATOMIC_ACQUIRE, "agent"); asm volatile("s_waitcnt vmcnt(0)" ::: "memory"); }     \
        __syncthreads(); } } } while (0)
#ifndef PROBE_SCALE
#define PROBE_SCALE 4e-5f
#endif
#ifdef PROBE_T
#define STAMP(k) do { if (blockIdx.x == 0 && F.tid == 0) ((unsigned long long*)(F.QCTR() + 1024))[k] = __builtin_amdgcn_s_memrealtime(); } while (0)
#else
#define STAMP(k) do { } while (0)
#endif
    STAMP(0);
    if (IN(0)) for (int rep = 0; rep < REPS(0); ++rep) { p0_prologue(F); __syncthreads(); }
    SEAM(0); STAMP(1);
    if (IN(1)) for (int rep = 0; rep < REPS(1); ++rep) { pg8::Gemm g{F.XN(), F.Wt_in(), M, NPAD, DM}; pg8::StaticOrder S; S.init(M, NPAD, F.G, (int)blockIdx.x); pg8::EpiProj E{F.PROJ(), F.BA()};
        pg8::gemm_phase<pg8::EpiProj, pg8::StaticOrder, true, true>(F.lds, g, S, E, F.wave); }
    SEAM(1); STAMP(2);
    if (IN(2)) for (int rep = 0; rep < REPS(2); ++rep) { p2_rope_table(F); for (int r2 = 0; r2 < REPS(21); ++r2) p2_attn_rows(F); for (int r2 = 0; r2 < REPS(22); ++r2) p2_dn_conv(F); __syncthreads(); }
    SEAM(2); STAMP(3);
    if (IN(3)) {
        { LAS float* SA = (LAS float*)(F.lds + F.wave * 18176); LAS float* sv = SA + 64 * SAP;
          for (int it = F.vcu * NWAVES + F.wave; it < NB * 8 * 128; it += F.G * NWAVES) dn_prep_item(F, it, SA, sv, F.lane); }
        asm volatile("s_waitcnt vmcnt(0)" ::: "memory"); __syncthreads();
        if (F.tid == 0) { __builtin_amdgcn_fence(__ATOMIC_RELEASE, "agent"); asm volatile("s_waitcnt vmcnt(0)" ::: "memory"); __hip_atomic_fetch_add(F.QCTR() + 768, 1u, __ATOMIC_RELAXED, __HIP_MEMORY_SCOPE_AGENT); }
    }
    STAMP(4);
    if (IN(4)) {
#ifndef NO_SCAN
        if ((int)blockIdx.x < NB * 8) {
            if (F.tid == 0) { while (__hip_atomic_load(F.QCTR() + 768, __ATOMIC_RELAXED, __HIP_MEMORY_SCOPE_AGENT) < (unsigned)F.G) __builtin_amdgcn_s_sleep(2);
                __builtin_amdgcn_fence(__ATOMIC_ACQUIRE, "agent"); asm volatile("s_waitcnt vmcnt(0)" ::: "memory"); }
            __syncthreads();
            dn_scan_wg(F, (int)blockIdx.x);
            asm volatile("s_waitcnt vmcnt(0)" ::: "memory"); __syncthreads();
            if (F.tid == 0) { __builtin_amdgcn_fence(__ATOMIC_RELEASE, "agent"); asm volatile("s_waitcnt vmcnt(0)" ::: "memory"); __hip_atomic_fetch_add(F.QCTR() + 640, 1u, __ATOMIC_RELAXED, __HIP_MEMORY_SCOPE_AGENT); } }
#endif
#ifdef PROBE_SERIAL
        { __builtin_amdgcn_fence(__ATOMIC_RELEASE, "agent"); __syncthreads(); if (F.tid == 0) { unsigned* c_ = F.QCTR() + 576; __hip_atomic_fetch_add(c_, 1u, __ATOMIC_RELEASE, __HIP_MEMORY_SCOPE_AGENT); while (__hip_atomic_load(c_, __ATOMIC_RELAXED, __HIP_MEMORY_SCOPE_AGENT) < (unsigned)F.G) __builtin_amdgcn_s_sleep(2); } __syncthreads(); }
#endif
        { const attn_body::AttnTensors AT{(const attn_body::bf16*)F.QA(), (const attn_body::bf16*)F.KA(), (const attn_body::bf16*)F.VA(), (attn_body::bf16*)F.MIXED()};
          const DynOrder S{F.QCTR(), (int)(__builtin_amdgcn_s_getreg((3 << 11) | 20) & 7), (LAS unsigned*)(F.lds + 135168)};
          float mq = fabsf(F.q_norm()[F.lane]), mk = fabsf(F.k_norm()[F.lane]);
#pragma unroll
          for (int o = 1; o < 64; o <<= 1) { mq = fmaxf(mq, __shfl_xor(mq, o)); mk = fmaxf(mk, __shfl_xor(mk, o)); }
          const bool bounded = __builtin_amdgcn_readfirstlane((int)(23.1f * mq * mk < 60.f)) != 0;
          if (bounded) attn_body::attn_phase<DynOrder, -1>((char*)lds, AT, S); else attn_body::attn_phase<DynOrder, 8>((char*)lds, AT, S); }
        __syncthreads();
        F.lane = (int)__builtin_amdgcn_mbcnt_hi(~0u, __builtin_amdgcn_mbcnt_lo(~0u, 0u)); F.tid = F.wave * 64 + F.lane;
        if (F.tid == 0) { while (__hip_atomic_load(F.QCTR() + 640, __ATOMIC_RELAXED, __HIP_MEMORY_SCOPE_AGENT) < (unsigned)(NB * 8)) __builtin_amdgcn_s_sleep(2);
            __builtin_amdgcn_fence(__ATOMIC_ACQUIRE, "agent"); asm volatile("s_waitcnt vmcnt(0)" ::: "memory"); }
        __syncthreads();
        { LAS unsigned* slot = (LAS unsigned*)(F.lds + 135168);
          for (;;) { if (F.tid == 0) *slot = __hip_atomic_fetch_add(F.QCTR() + 704, 1u, __ATOMIC_RELAXED, __HIP_MEMORY_SCOPE_AGENT);
              asm volatile("s_waitcnt vmcnt(0) lgkmcnt(0)\n\ts_barrier" ::: "memory"); const unsigned c = *slot; asm volatile("s_waitcnt lgkmcnt(0)\n\ts_barrier" ::: "memory");
              if (c >= (unsigned)(M / 64)) break; p5_mix_chunk(F, (int)c * 64); } }
    }
    F.lane = (int)__builtin_amdgcn_mbcnt_hi(~0u, __builtin_amdgcn_mbcnt_lo(~0u, 0u)); F.tid = F.wave * 64 + F.lane;
    SEAM(4); STAMP(5);
    STAMP(6);
#ifdef PROBE_BAR
    for (int xb = 1; xb <= 20; ++xb) { asm volatile("s_waitcnt vmcnt(0)" ::: "memory"); __syncthreads();
        if (F.tid == 0) { unsigned* c_ = F.QCTR() + 512 + 16; __builtin_amdgcn_fence(__ATOMIC_RELEASE, "agent"); asm volatile("s_waitcnt vmcnt(0)" ::: "memory");
            __hip_atomic_fetch_add(c_, 1u, __ATOMIC_RELAXED, __HIP_MEMORY_SCOPE_AGENT);
            const unsigned tgt_ = (unsigned)xb * (unsigned)F.G; while (__hip_atomic_load(c_, __ATOMIC_RELAXED, __HIP_MEMORY_SCOPE_AGENT) < tgt_) __builtin_amdgcn_s_sleep(1);
            __builtin_amdgcn_fence(__ATOMIC_ACQUIRE, "agent"); asm volatile("s_waitcnt vmcnt(0)" ::: "memory"); }
        __syncthreads(); }
#endif
    if (IN(6)) { pg8::Gemm g{F.MIXED(), F.Wt_out(), M, DM, DM}; pg8::StaticOrder S; S.init(M, DM, F.G, (int)blockIdx.x); pg8::EpiRes<false> E{F.x(), F.HB1(), F.SS()};
        pg8::gemm_phase<pg8::EpiRes<false>, pg8::StaticOrder, true, true>(F.lds, g, S, E, F.wave); }
    SEAM(6); STAMP(7);
    if (IN(7)) for (int rep = 0; rep < REPS(7); ++rep) { pg8::Gemm g{F.HB1(), F.Wt_gu(), M, 2 * FF, DM}; pg8::StaticOrder S; S.init(M, 2 * FF, F.G, (int)blockIdx.x); pg8::EpiGU E{F.SS(), F.ACT()};
        pg8::gemm_phase<pg8::EpiGU, pg8::StaticOrder, true, true>(F.lds, g, S, E, F.wave); }
    SEAM(7); STAMP(8);
    if (IN(8)) { pg8::Gemm g{F.ACT(), F.Wt_dn(), M, DM, FF}; pg8::StaticOrder S; S.init(M, DM, F.G, (int)blockIdx.x); pg8::EpiRes<true> E{F.HB1(), F.HB2(), F.SS() + M};
        pg8::gemm_phase<pg8::EpiRes<true>, pg8::StaticOrder, true, true>(F.lds, g, S, E, F.wave); }
    SEAM(8); STAMP(9);
    if (IN(9)) {
#ifndef NO_G9A
        { int kpe = 256; asm volatile("" : "+s"(kpe)); pg8::Gemm g{F.PB(), F.Wt_pl(), M, DM, kpe}; pg8::StaticOrder S; S.init(M, DM, F.G, (int)blockIdx.x); pg8::EpiStore E{F.PE(), DM};
          pg8::gemm_phase<pg8::EpiStore, pg8::StaticOrder, true, true>(F.lds, g, S, E, F.wave); }
#endif
        asm volatile("s_waitcnt vmcnt(0)" ::: "memory"); __syncthreads();
#ifndef NO_G9B
        { pg8::Gemm g{F.HB2(), F.Wt_pg(), M, DM, DM}; pg8::StaticOrder S; S.init(M, DM, F.G, (int)blockIdx.x); pg8::EpiPle E{F.HB2(), F.HB1(), F.PE(), F.SS() + M, F.SS() + 2 * M};
          pg8::gemm_phase<pg8::EpiPle, pg8::StaticOrder, true, true>(F.lds, g, S, E, F.wave); }
#endif
    }
    SEAM(9); STAMP(10);
    if (IN(10)) { p10_final(F, 0.f); }
#ifdef PROBE_T
    {
        asm volatile("s_waitcnt vmcnt(0)" ::: "memory"); __syncthreads();
        if (F.tid == 0) { unsigned* c_ = F.QCTR() + 512; __builtin_amdgcn_fence(__ATOMIC_RELEASE, "agent"); asm volatile("s_waitcnt vmcnt(0)" ::: "memory");
            __hip_atomic_fetch_add(c_, 1u, __ATOMIC_RELAXED, __HIP_MEMORY_SCOPE_AGENT);
            const unsigned tgt_ = 11u * (unsigned)F.G; while (__hip_atomic_load(c_, __ATOMIC_RELAXED, __HIP_MEMORY_SCOPE_AGENT) < tgt_) __builtin_amdgcn_s_sleep(1);
            __builtin_amdgcn_fence(__ATOMIC_ACQUIRE, "agent"); asm volatile("s_waitcnt vmcnt(0)" ::: "memory"); }
        __syncthreads();
        STAMP(11);
        float delta = 0.f; { const unsigned long long* ts = (const unsigned long long*)(F.QCTR() + 1024); unsigned long long acc_ = 0;
          for (int k = 0; k < 13; ++k) if ((PROBE_T >> k) & 1) acc_ += __hip_atomic_load(ts + k + 1, __ATOMIC_RELAXED, __HIP_MEMORY_SCOPE_AGENT) - __hip_atomic_load(ts + k, __ATOMIC_RELAXED, __HIP_MEMORY_SCOPE_AGENT);
          delta = (float)acc_ * 0.01f * PROBE_SCALE; }
        for (int m = F.vcu * NWAVES + F.wave; m < 1024; m += F.G * NWAVES) { f32x4* xr = (f32x4*)(F.out + (size_t)m * DM) + F.lane;
            for (int j = 0; j < 4; ++j) xr[64 * j] = xr[64 * j] + delta; }
    }
#endif
#undef IN
#undef SEAM
}

#ifndef MK_PER_PHASE
#define MK_PER_PHASE 0
#endif
extern "C" void kernel_launch(void* const* d_in, const int* in_sizes, int n_in, void* d_out, int out_size, void* d_ws, size_t ws_size, hipStream_t stream) {
    static int grid = 0;
    if (grid == 0) {
        if (n_in != 19 || in_sizes[0] != M * DM || out_size != M * DM || ws_size < WS_END) { fprintf(stderr, "kernel_launch: unexpected shapes / workspace (n_in %d, ws %zu); nothing launched\n", n_in, ws_size); grid = -1; return; }
        int dev = 0, cus = 0, per_cu = 0;
        (void)hipGetDevice(&dev); (void)hipDeviceGetAttribute(&cus, hipDeviceAttributeMultiprocessorCount, dev);
        (void)hipFuncSetAttribute((const void*)hymba_fwd, hipFuncAttributeMaxDynamicSharedMemorySize, LDS_BYTES);
        (void)hipOccupancyMaxActiveBlocksPerMultiprocessor(&per_cu, (const void*)hymba_fwd, NWAVES * 64, LDS_BYTES);
        (void)hipGetLastError();
        if (per_cu < 1) { fprintf(stderr, "kernel_launch: occupancy query says %d blocks per CU\n", per_cu); per_cu = 1; }
        grid = cus;
    }
    if (grid < 0) return;
    (void)hipMemsetAsync((unsigned char*)d_ws + WS_QCTR + 512 * 4, 0, 256, stream);
    Args a{};
    for (int i = 0; i < 19; ++i) a.in[i] = (const float*)d_in[i];
    a.out = (float*)d_out; a.ws = (unsigned char*)d_ws;
#if MK_PER_PHASE
    for (int ph = 0; ph < N_PHASES; ++ph) { a.ph_lo = ph; a.ph_hi = ph + 1; hipLaunchKernelGGL(hymba_fwd, dim3(grid), dim3(NWAVES * 64), LDS_BYTES, stream, a); }
#else
    a.ph_lo = 0; a.ph_hi = N_PHASES;
    void* kargs[] = {&a};
    hipError_t e = hipLaunchCooperativeKernel((const void*)hymba_fwd, dim3(grid), dim3(NWAVES * 64), kargs, LDS_BYTES, stream);
    if (e != hipSuccess) fprintf(stderr, "cooperative launch failed: %s (grid %d)\n", hipGetErrorString(e), grid);
#endif
}
```

```cpp
#include <hip/hip_runtime.h>
#include <hip/hip_cooperative_groups.h>
#include <cstdio>
#include <cstdint>
namespace pg8 {
#define PG8_LAS __attribute__((address_space(3)))
typedef unsigned short bf16_t;
typedef short bf16x8 __attribute__((ext_vector_type(8)));
typedef float f32x4 __attribute__((ext_vector_type(4)));
typedef unsigned u32x4 __attribute__((ext_vector_type(4)));
constexpr int BM = 256, BK = 64, HALF = 128, HTB = HALF * BK * 2  , STAGE_BYTES = 8 * HTB, NXCD = 8, WGM = 8;

__host__ __device__ __forceinline__ int lds_byte(int r, int c) { const int st = (r >> 4) * 2 + (c >> 5), rr = r & 15, cc = c & 31, ob = rr * 64 + cc * 2; return st * 1024 + (ob ^ (((ob >> 9) & 1) << 5)); }
__host__ __device__ __forceinline__ void stage_rc(int b, int& R, int& C) { const int st = b / 1024, sb = b % 1024, swz = sb ^ (((sb >> 9) & 1) << 5); R = (st >> 1) * 16 + swz / 64; C = (st & 1) * 32 + (swz % 64) / 2; }
__host__ __device__ __forceinline__ int perm32(int rho) { const int n = rho >> 4, i = rho & 15; return 8 * (i >> 2) + 4 * n + (i & 3); }

struct Unit { int pm, pn; };
struct Gemm { const bf16_t* A; const bf16_t* Bt; int M, N, K; };

struct StaticOrder {
    int nM, nN, nwg, G, c;
    __host__ __device__ void init(int M, int N, int G_, int c_) { nM = M / BM; nN = N / BM; nwg = nM * nN; G = G_; c = c_; }
    __host__ __device__ bool next(int i, Unit& u) const {
        const long L = (long)i * G + c; if (L >= nwg) return false;
        int wgid = (int)L; { const int q = nwg / NXCD, r = nwg % NXCD, xcd = wgid % NXCD, off = wgid / NXCD; wgid = (xcd < r ? xcd * (q + 1) : r * (q + 1) + (xcd - r) * q) + off; }
        const int nig = WGM * nN, gid = wgid / nig, fm = gid * WGM, gsz = (nM - fm) < WGM ? (nM - fm) : WGM;
        u.pm = fm + ((wgid % nig) % gsz); u.pn = (wgid % nig) / gsz; return true;
    }
    __device__ __forceinline__ void a_ready(const Unit&) const {}
    __device__ __forceinline__ void done(const Unit&) const {}
};

__device__ __forceinline__ unsigned cvt_pk_bf16(float lo, float hi) { unsigned r; asm volatile("v_cvt_pk_bf16_f32 %0, %1, %2" : "=v"(r) : "v"(lo), "v"(hi)); return r; }
typedef float f32x2 __attribute__((ext_vector_type(2)));
typedef unsigned u32x2 __attribute__((ext_vector_type(2)));
__device__ __forceinline__ float fast_sigmoid(float v) { return __builtin_amdgcn_rcpf(1.f + __expf(-v)); }
struct EpiProj {
    static constexpr bool PERM = true, AFTER_DRAIN = false;
    bf16_t* O; float* BA;
    __device__ __forceinline__ void operator()(const f32x4 (&acc)[2][2][4][2], const Unit& u, int wr, int wc, int fr, int fq) const {
        const int row0 = u.pm * BM + wr * 64 + fr;
        if (u.pn < 11) {
            const int col0 = u.pn * BM + wc * 32 + 8 * fq;
#pragma unroll
            for (int ai = 0; ai < 2; ++ai)
#pragma unroll
                for (int m = 0; m < 4; ++m) { bf16_t* rowp = O + (size_t)(row0 + ai * HALF + m * 16) * 2816 + col0;
#pragma unroll
                    for (int bj = 0; bj < 2; ++bj) { const f32x4 v0 = acc[ai][bj][m][0], v1 = acc[ai][bj][m][1];
                        u32x4 w; w.x = cvt_pk_bf16(v0[0], v0[1]); w.y = cvt_pk_bf16(v0[2], v0[3]); w.z = cvt_pk_bf16(v1[0], v1[1]); w.w = cvt_pk_bf16(v1[2], v1[3]);
                        *(u32x4*)(rowp + bj * HALF) = w; } }
        } else if (wc == 0 && fq < 2) {
#pragma unroll
            for (int ai = 0; ai < 2; ++ai)
#pragma unroll
                for (int m = 0; m < 4; ++m) { float* rowp = BA + (size_t)(row0 + ai * HALF + m * 16) * 16 + 8 * fq;
                    *(f32x4*)(rowp) = acc[ai][0][m][0]; *(f32x4*)(rowp + 4) = acc[ai][0][m][1]; }
        }
    }
};
struct EpiStore {
    static constexpr bool PERM = true, AFTER_DRAIN = false;
    bf16_t* O; int ldc;
    __device__ __forceinline__ void operator()(const f32x4 (&acc)[2][2][4][2], const Unit& u, int wr, int wc, int fr, int fq) const {
        const int row0 = u.pm * BM + wr * 64 + fr; const int col0 = u.pn * BM + wc * 32 + 8 * fq;
#pragma unroll
        for (int ai = 0; ai < 2; ++ai)
#pragma unroll
            for (int m = 0; m < 4; ++m) { bf16_t* rowp = O + (size_t)(row0 + ai * HALF + m * 16) * ldc + col0;
#pragma unroll
                for (int bj = 0; bj < 2; ++bj) { const f32x4 v0 = acc[ai][bj][m][0], v1 = acc[ai][bj][m][1];
                    u32x4 w; w.x = cvt_pk_bf16(v0[0], v0[1]); w.y = cvt_pk_bf16(v0[2], v0[3]); w.z = cvt_pk_bf16(v1[0], v1[1]); w.w = cvt_pk_bf16(v1[2], v1[3]);
                    *(u32x4*)(rowp + bj * HALF) = w; } }
    }
};
template <bool BF> struct EpiRes {
    static constexpr bool PERM = false, AFTER_DRAIN = false;
    const void* base; bf16_t* hb; float* ss;
    __device__ __forceinline__ void operator()(const f32x4 (&acc)[2][2][4][2], const Unit& u, int wr, int wc, int fr, int fq) const {
        const int col0 = u.pn * BM + wc * 32 + 4 * fq;
        u32x2 pk[2][4][4];
        if (BF) {
#pragma unroll
            for (int ai = 0; ai < 2; ++ai)
#pragma unroll
                for (int m = 0; m < 4; ++m)
#pragma unroll
                    for (int q = 0; q < 4; ++q) pk[ai][m][q] = *(const u32x2*)((const bf16_t*)base + (size_t)(u.pm * BM + ai * HALF + wr * 64 + fr + m * 16) * 1024 + col0 + (q >> 1) * HALF + (q & 1) * 16);
            asm volatile("" ::: "memory"); }
#pragma unroll
        for (int ai = 0; ai < 2; ++ai) { f32x4 bs[4][4]; const size_t off0 = (size_t)(u.pm * BM + ai * HALF + wr * 64 + fr) * 1024 + col0;
            if (!BF) {
#pragma unroll
                for (int m = 0; m < 4; ++m)
#pragma unroll
                    for (int q = 0; q < 4; ++q) bs[m][q] = *(const f32x4*)((const float*)base + off0 + (size_t)m * 16 * 1024 + (q >> 1) * HALF + (q & 1) * 16);
                asm volatile("" ::: "memory"); }
#pragma unroll
            for (int m = 0; m < 4; ++m) { const size_t off = off0 + (size_t)m * 16 * 1024; float s = 0.f;
#pragma unroll
                for (int q = 0; q < 4; ++q) { f32x4 r;
                    if (BF) { const u32x2 p = pk[ai][m][q]; r = (f32x4){__uint_as_float(p.x << 16), __uint_as_float(p.x & 0xffff0000u), __uint_as_float(p.y << 16), __uint_as_float(p.y & 0xffff0000u)}; } else r = bs[m][q];
                    const f32x4 o = r + acc[ai][q >> 1][m][q & 1]; const size_t o2 = off + (q >> 1) * HALF + (q & 1) * 16;
                    s += (o[0] * o[0] + o[1] * o[1]) + (o[2] * o[2] + o[3] * o[3]);
                    u32x2 w; w.x = cvt_pk_bf16(o[0], o[1]); w.y = cvt_pk_bf16(o[2], o[3]); *(u32x2*)(hb + o2) = w; }
                s += __shfl_xor(s, 16); s += __shfl_xor(s, 32);
                if (fq == 0) unsafeAtomicAdd(ss + (u.pm * BM + ai * HALF + wr * 64 + m * 16 + fr), s); }
            asm volatile("" ::: "memory"); }
    }
};
struct EpiGU {
    static constexpr bool PERM = true, AFTER_DRAIN = false;
    const float* ss; bf16_t* act;
    __device__ __forceinline__ void operator()(const f32x4 (&acc)[2][2][4][2], const Unit& u, int wr, int wc, int fr, int fq) const {
        const int col0 = u.pn * HALF + wc * 32 + 8 * fq; const int row0 = u.pm * BM + wr * 64 + fr;
        float rs[2][4];
#pragma unroll
        for (int ai = 0; ai < 2; ++ai)
#pragma unroll
            for (int m = 0; m < 4; ++m) rs[ai][m] = ss[row0 + ai * HALF + m * 16];
        asm volatile("" ::: "memory");
#pragma unroll
        for (int ai = 0; ai < 2; ++ai)
#pragma unroll
            for (int m = 0; m < 4; ++m) { const int row = row0 + ai * HALF + m * 16;
                const float rstd = rsqrtf(rs[ai][m] * (1.0f / 1024.0f) + 1e-6f); float a[8];
#pragma unroll
                for (int n = 0; n < 2; ++n)
#pragma unroll
                    for (int e = 0; e < 4; ++e) { const float g = acc[ai][0][m][n][e] * rstd, up = acc[ai][1][m][n][e] * rstd; a[4 * n + e] = g * fast_sigmoid(g) * up; }
                u32x4 w; w.x = cvt_pk_bf16(a[0], a[1]); w.y = cvt_pk_bf16(a[2], a[3]); w.z = cvt_pk_bf16(a[4], a[5]); w.w = cvt_pk_bf16(a[6], a[7]);
                *(u32x4*)(act + (size_t)row * 2816 + col0) = w; }
    }
};
struct EpiPle {
    static constexpr bool PERM = false, AFTER_DRAIN = false;
    const bf16_t* hres; bf16_t* h; const bf16_t* pe; const float* ss2; float* ss3;
    __device__ __forceinline__ void operator()(const f32x4 (&acc)[2][2][4][2], const Unit& u, int wr, int wc, int fr, int fq) const {
        const int col0 = u.pn * BM + wc * 32 + 4 * fq;
#pragma unroll
        for (int ai = 0; ai < 2; ++ai)
#pragma unroll
            for (int mp = 0; mp < 1; ++mp) { u32x2 bs[4][4]; u32x2 pw[4][4]; float sq[4]; const int row0 = u.pm * BM + ai * HALF + wr * 64 + fr; const size_t off0 = (size_t)row0 * 1024 + col0;
#pragma unroll
                for (int m = 0; m < 4; ++m) { sq[m] = ss2[row0 + 16 * m];
#pragma unroll
                    for (int q = 0; q < 4; ++q) { const size_t o2 = off0 + (size_t)m * 16 * 1024 + (q >> 1) * HALF + (q & 1) * 16; bs[m][q] = *(const u32x2*)(hres + o2); pw[m][q] = *(const u32x2*)(pe + o2); } }
                asm volatile("" ::: "memory");
#pragma unroll
                for (int m = 0; m < 4; ++m) { const float rstd = rsqrtf(sq[m] * (1.0f / 1024.0f) + 1e-6f); float s = 0.f;
#pragma unroll
                    for (int q = 0; q < 4; ++q) { const size_t o2 = off0 + (size_t)m * 16 * 1024 + (q >> 1) * HALF + (q & 1) * 16; const f32x4 a = acc[ai][q >> 1][m][q & 1]; const u32x2 p = pw[m][q], r_ = bs[m][q]; f32x4 o;
                        o[0] = __uint_as_float(r_.x << 16) + fast_sigmoid(a[0] * rstd) * __uint_as_float(p.x << 16); o[1] = __uint_as_float(r_.x & 0xffff0000u) + fast_sigmoid(a[1] * rstd) * __uint_as_float(p.x & 0xffff0000u);
                        o[2] = __uint_as_float(r_.y << 16) + fast_sigmoid(a[2] * rstd) * __uint_as_float(p.y << 16); o[3] = __uint_as_float(r_.y & 0xffff0000u) + fast_sigmoid(a[3] * rstd) * __uint_as_float(p.y & 0xffff0000u);
                        { u32x2 w; w.x = cvt_pk_bf16(o[0], o[1]); w.y = cvt_pk_bf16(o[2], o[3]); *(u32x2*)(h + o2) = w; } s += (o[0] * o[0] + o[1] * o[1]) + (o[2] * o[2] + o[3] * o[3]); }
                    s += __shfl_xor(s, 16); s += __shfl_xor(s, 32);
                    if (fq == 0) unsafeAtomicAdd(ss3 + row0 + 16 * m, s); }
                asm volatile("" ::: "memory"); }
    }
};
template <class Epi, class Sched, bool ALIGN_EPI = false, bool SP2 = false>
__device__ __forceinline__ void gemm_phase(PG8_LAS unsigned char* lds, const Gemm g, const Sched& S, const Epi& E, const int wave_id) {
    const int tid = threadIdx.x, wid = __builtin_amdgcn_readfirstlane(tid >> 6), lane = tid & 63, wr = wid >> 2, wc = wid & 3, fr = lane & 15, fq = lane >> 4;
    const int K = g.K, nt = K / BK;
    unsigned voffA[2], voffB[2];
#pragma unroll
    for (int i = 0; i < 2; ++i) { int R, C; stage_rc(tid * 16 + i * 8192, R, C); const int Rb = Epi::PERM ? ((R & ~31) + perm32(R & 31)) : R;
        voffA[i] = (unsigned)(R * K + C) * 2u; voffB[i] = (unsigned)(Rb * K + C) * 2u; }
    const size_t kstep = (size_t)(BK * 2);
    const size_t hstep = (size_t)HALF * K * 2;
    const size_t tstep = 2 * hstep;
    const unsigned ldsw = (unsigned)wid * 1024u;
    const int aoff = lds_byte(wr * 64 + fr, fq * 8), boff = lds_byte(wc * 32 + fr, fq * 8);
#define PG8_SA(b, h) (((b) * 2 + (h)) * HTB)
#define PG8_SB(b, h) ((4 + (b) * 2 + (h)) * HTB)
#define PG8_STAGE(bufoff, gbase, voff) do { _Pragma("unroll") for (int _i = 0; _i < 2; ++_i) \
        __builtin_amdgcn_global_load_lds((const unsigned*)((const char*)(gbase) + (voff)[_i]), (PG8_LAS unsigned*)(lds + (bufoff) + ldsw + _i * 8192), 16, 0, 0); } while (0)
#define PG8_LDA(dst, b, h) do { _Pragma("unroll") for (int m = 0; m < 4; ++m) _Pragma("unroll") for (int k = 0; k < 2; ++k) dst[m][k] = *(const PG8_LAS bf16x8*)(lds + PG8_SA(b, h) + aoff + m * 2048 + k * 1024); } while (0)
#define PG8_LDB(dst, b, h) do { _Pragma("unroll") for (int n = 0; n < 2; ++n) _Pragma("unroll") for (int k = 0; k < 2; ++k) dst[n][k] = *(const PG8_LAS bf16x8*)(lds + PG8_SB(b, h) + boff + n * 2048 + k * 1024); } while (0)
#define PG8_MMA(ai, bj, At, Bt) do { __builtin_amdgcn_s_setprio(1); _Pragma("unroll") for (int m = 0; m < 4; ++m) _Pragma("unroll") for (int n = 0; n < 2; ++n) _Pragma("unroll") for (int k = 0; k < 2; ++k) \
        acc[ai][bj][m][n] = __builtin_amdgcn_mfma_f32_16x16x32_bf16(Bt[n][k], At[m][k], acc[ai][bj][m][n], 0, 0, 0); __builtin_amdgcn_s_setprio(0); } while (0)
#define PG8_WAIT_V(n) asm volatile("s_waitcnt vmcnt(" #n ")" ::: "memory")
#define PG8_WAIT_L(n) asm volatile("s_waitcnt lgkmcnt(" #n ")" ::: "memory")
#define PG8_BAR __builtin_amdgcn_s_barrier()
#define PG8_SCHED __builtin_amdgcn_sched_barrier(0)
    Unit cur, nxt; int ui = 0;
    if (!S.next(0, cur)) return;
    f32x4 acc[2][2][4][2];
#pragma unroll
    for (int a = 0; a < 2; ++a)
#pragma unroll
        for (int b = 0; b < 2; ++b)
#pragma unroll
            for (int m = 0; m < 4; ++m)
#pragma unroll
                for (int n = 0; n < 2; ++n) acc[a][b][m][n] = (f32x4){0.f, 0.f, 0.f, 0.f};
    bf16x8 At[4][2], B0[2][2], B1[2][2];
    const char* cA = (const char*)g.A + (size_t)cur.pm * tstep; const char* cB = (const char*)g.Bt + (size_t)cur.pn * tstep;
    S.a_ready(cur);
    if constexpr (SP2) {
        PG8_STAGE(PG8_SB(0, 0), cB, voffB); PG8_STAGE(PG8_SB(0, 1), cB + hstep, voffB); PG8_STAGE(PG8_SA(0, 0), cA, voffA); PG8_STAGE(PG8_SA(0, 1), cA + hstep, voffA);
        if (wr == 1) PG8_BAR;
        PG8_WAIT_V(2); PG8_BAR;
        PG8_STAGE(PG8_SB(1, 0), cB + kstep, voffB); PG8_STAGE(PG8_SA(1, 0), cA + kstep, voffA); PG8_STAGE(PG8_SB(1, 1), cB + hstep + kstep, voffB);
        PG8_WAIT_V(6); PG8_BAR;
    } else {
        PG8_STAGE(PG8_SB(0, 0), cB, voffB); PG8_STAGE(PG8_SA(0, 0), cA, voffA); PG8_STAGE(PG8_SB(0, 1), cB + hstep, voffB); PG8_STAGE(PG8_SA(0, 1), cA + hstep, voffA);
        if (wr == 1) PG8_BAR;
        PG8_WAIT_V(4); PG8_BAR;
        PG8_STAGE(PG8_SB(1, 0), cB + kstep, voffB); PG8_STAGE(PG8_SA(1, 0), cA + kstep, voffA); PG8_STAGE(PG8_SB(1, 1), cB + hstep + kstep, voffB);
        PG8_WAIT_V(6); PG8_BAR;
    }
    for (;;) {
        const bool has_next = S.next(ui + 1, nxt);
        const char* nA = has_next ? (const char*)g.A + (size_t)nxt.pm * tstep : cA; const char* nB = has_next ? (const char*)g.Bt + (size_t)nxt.pn * tstep : cB;
        for (int t = 0; t < nt; t += 2) {
            const bool last = (t == nt - 2);
            const char* a1 = cA + (size_t)(t + 1) * kstep;
            const char* a2 = last ? nA : cA + (size_t)(t + 2) * kstep; const char* b2 = last ? nB : cB + (size_t)(t + 2) * kstep;
            const char* a3 = a2 + kstep; const char* b3 = b2 + kstep;
            if (last && has_next) S.a_ready(nxt);
            if constexpr (SP2) {
            PG8_LDB(B0, 0, 0); PG8_LDB(B1, 0, 1); PG8_SCHED; PG8_LDA(At, 0, 0); PG8_STAGE(PG8_SA(1, 1), a1 + hstep, voffA);
            PG8_WAIT_V(8); PG8_WAIT_L(0); PG8_BAR; PG8_MMA(0, 0, At, B0); PG8_MMA(0, 1, At, B1); PG8_BAR; PG8_SCHED;
            PG8_LDA(At, 0, 1); PG8_STAGE(PG8_SB(0, 0), b2, voffB); PG8_STAGE(PG8_SB(0, 1), b2 + hstep, voffB); PG8_STAGE(PG8_SA(0, 0), a2, voffA);
            PG8_WAIT_V(8); PG8_WAIT_L(0); PG8_BAR; PG8_MMA(1, 0, At, B0); PG8_MMA(1, 1, At, B1); PG8_BAR; PG8_SCHED;
            PG8_LDB(B0, 1, 0); PG8_LDB(B1, 1, 1); PG8_SCHED; PG8_LDA(At, 1, 0); PG8_STAGE(PG8_SA(0, 1), a2 + hstep, voffA);
            PG8_WAIT_V(8); PG8_WAIT_L(0); PG8_BAR; PG8_MMA(0, 0, At, B0); PG8_MMA(0, 1, At, B1); PG8_BAR; PG8_SCHED;
            PG8_LDA(At, 1, 1); PG8_STAGE(PG8_SB(1, 0), b3, voffB); PG8_STAGE(PG8_SB(1, 1), b3 + hstep, voffB); PG8_STAGE(PG8_SA(1, 0), a3, voffA);
            PG8_WAIT_V(8); PG8_WAIT_L(0); PG8_BAR; PG8_MMA(1, 0, At, B0); PG8_MMA(1, 1, At, B1); PG8_BAR; PG8_SCHED;
            } else {
            PG8_LDB(B0, 0, 0); PG8_SCHED; PG8_LDA(At, 0, 0); PG8_STAGE(PG8_SA(1, 1), a1 + hstep, voffA);
            PG8_WAIT_L(8); PG8_BAR; PG8_WAIT_L(0); PG8_MMA(0, 0, At, B0); PG8_BAR; PG8_SCHED;
            PG8_LDB(B1, 0, 1); PG8_STAGE(PG8_SB(0, 0), b2, voffB);
            PG8_BAR; PG8_WAIT_L(0); PG8_MMA(0, 1, At, B1); PG8_BAR;
            PG8_LDA(At, 0, 1); PG8_STAGE(PG8_SA(0, 0), a2, voffA);
            PG8_BAR; PG8_WAIT_L(0); PG8_MMA(1, 0, At, B0); PG8_BAR; PG8_SCHED;
            PG8_STAGE(PG8_SB(0, 1), b2 + hstep, voffB);
            PG8_WAIT_V(6); PG8_BAR; PG8_MMA(1, 1, At, B1); PG8_BAR;
            PG8_LDB(B0, 1, 0); PG8_SCHED; PG8_LDA(At, 1, 0); PG8_STAGE(PG8_SA(0, 1), a2 + hstep, voffA);
            PG8_WAIT_L(8); PG8_BAR; PG8_WAIT_L(0); PG8_MMA(0, 0, At, B0); PG8_BAR; PG8_SCHED;
            PG8_LDB(B1, 1, 1); PG8_STAGE(PG8_SB(1, 0), b3, voffB);
            PG8_BAR; PG8_WAIT_L(0); PG8_MMA(0, 1, At, B1); PG8_BAR;
            PG8_LDA(At, 1, 1); PG8_STAGE(PG8_SA(1, 0), a3, voffA);
            PG8_BAR; PG8_WAIT_L(0); PG8_MMA(1, 0, At, B0); PG8_BAR; PG8_SCHED;
            PG8_STAGE(PG8_SB(1, 1), b3 + hstep, voffB);
            PG8_WAIT_V(6); PG8_BAR; PG8_MMA(1, 1, At, B1); PG8_BAR;
            }
        }
        if constexpr (ALIGN_EPI) { if (wr == 0) PG8_BAR; }
        if constexpr (!Epi::AFTER_DRAIN) { E(acc, cur, wr, wc, fr, fq); S.done(cur); }
        if (!has_next) break;
#pragma unroll
        for (int a = 0; a < 2; ++a)
#pragma unroll
            for (int b = 0; b < 2; ++b)
#pragma unroll
                for (int m = 0; m < 4; ++m)
#pragma unroll
                    for (int n = 0; n < 2; ++n) acc[a][b][m][n] = (f32x4){0.f, 0.f, 0.f, 0.f};
        cur = nxt; cA = nA; cB = nB; ++ui;
        if constexpr (ALIGN_EPI) { if (wr == 1) PG8_BAR; }
    }
    PG8_WAIT_V(0);
    if constexpr (!ALIGN_EPI) { if (wr == 0) PG8_BAR; }
    PG8_BAR;
    if constexpr (Epi::AFTER_DRAIN) { E.fused(acc, cur, wr, wc, fr, fq, lds, wid, lane); S.done(cur); }
#undef PG8_SA
#undef PG8_SB
#undef PG8_STAGE
#undef PG8_LDA
#undef PG8_LDB
#undef PG8_MMA
#undef PG8_WAIT_V
#undef PG8_WAIT_L
#undef PG8_BAR
#undef PG8_SCHED
}
}
#include <hip/hip_bf16.h>
#include <cmath>
namespace attn_body {
using bf16=__hip_bfloat16;
using bf16x8=__attribute__((ext_vector_type(8)))short;
using s16x4=__attribute__((ext_vector_type(4)))short;
using f32x16=__attribute__((ext_vector_type(16)))float;
using u32x4=__attribute__((ext_vector_type(4)))unsigned;
constexpr int BATCH=8,NHEAD=8,SEQ=8192,D=64,QP=512,KP=128,OP=1024,GQ=4;
constexpr int NW=8,QBLK=32,QB=QBLK*NW,KVBLK=64,NQB=SEQ/QB;
constexpr int ATTN_UNIT_ROWS=QB;
__device__ __forceinline__ int crow(int r,int hi){return (r&3)+8*(r>>2)+4*hi;}
#define SBAR() __builtin_amdgcn_sched_barrier(0)
__device__ __forceinline__ void cmask(f32x16&p0,f32x16&p1,int jb,int qrel,int hi){
  const float NEG=-INFINITY; int kb=64*jb+4*hi;
  #pragma unroll
  for(int r=0;r<16;++r){int kv=kb+(r&3)+8*(r>>2); if(kv>qrel)p0[r]=NEG; if(kv+32>qrel)p1[r]=NEG;}
}

constexpr int NSLOT=3, SLOTB=8192;
constexpr int LDS_K=0, LDS_V=NSLOT*SLOTB, LDS_WS=2*NSLOT*SLOTB, LDS_OST=LDS_WS+NW*64*4, LDS_BYTES=LDS_OST+NW*4096;
constexpr float C2=0.125f*1.4426950408889634f;
__device__ __forceinline__ void glds16(const void*gsrc,unsigned lds_dst){unsigned keep;
  asm volatile("s_mov_b32 %0, m0\n\ts_mov_b32 m0, %2\n\ts_nop 0\n\tglobal_load_lds_dwordx4 %1, off\n\ts_mov_b32 m0, %0":"=&s"(keep):"v"(gsrc),"s"(lds_dst):"memory");}
__device__ __forceinline__ float max3f(float a,float b,float c){float r;asm("v_max3_f32 %0, %1, %2, %3":"=v"(r):"v"(a),"v"(b),"v"(c));return r;}
__device__ __forceinline__ float max2f(float a,float b){float r;asm("v_max_f32_e32 %0, %1, %2":"=v"(r):"v"(a),"v"(b));return r;}
__device__ __forceinline__ float fadd_s(float a,float b){float r;asm("v_add_f32_e32 %0, %1, %2":"=v"(r):"v"(a),"v"(b));return r;}
__device__ __forceinline__ float fsub_s(float a,float b){float r;asm("v_sub_f32_e32 %0, %1, %2":"=v"(r):"v"(a),"v"(b));return r;}
typedef float f32x2_t __attribute__((ext_vector_type(2))); typedef __bf16 bf16x2_t __attribute__((ext_vector_type(2)));
__device__ __forceinline__ unsigned cvtpk_s(float lo,float hi){f32x2_t v={lo,hi};bf16x2_t b=__builtin_convertvector(v,bf16x2_t);return __builtin_bit_cast(unsigned,b);}
#define WAIT_BAR(N) asm volatile("s_waitcnt vmcnt(" #N ") lgkmcnt(0)\n\ts_barrier":::"memory")

__device__ __forceinline__ void qkt(f32x16&p0,f32x16&p1,const char*Kslot,const bf16x8*qr,const f32x16&negm,int r32,int hi){
  const char*kb=Kslot+hi*1024+r32*16;
  #pragma unroll
  for(int d0=0;d0<4;++d0){
    const bf16x8 b0=*reinterpret_cast<const bf16x8*>(kb+d0*2048);
    const bf16x8 b1=*reinterpret_cast<const bf16x8*>(kb+d0*2048+512);
    if(d0==0){p0=__builtin_amdgcn_mfma_f32_32x32x16_bf16(b0,qr[0],negm,0,0,0);p1=__builtin_amdgcn_mfma_f32_32x32x16_bf16(b1,qr[0],negm,0,0,0);}
    else{p0=__builtin_amdgcn_mfma_f32_32x32x16_bf16(b0,qr[d0],p0,0,0,0);p1=__builtin_amdgcn_mfma_f32_32x32x16_bf16(b1,qr[d0],p1,0,0,0);}}
}
typedef __attribute__((address_space(3))) const char* lds_cptr;
typedef short v4i16_t __attribute__((ext_vector_type(4)));
__device__ __forceinline__ void kload8(bf16x8*kf,lds_cptr kp){
  kf[0]=*(const __attribute__((address_space(3))) bf16x8*)(kp);      kf[1]=*(const __attribute__((address_space(3))) bf16x8*)(kp+512);
  kf[2]=*(const __attribute__((address_space(3))) bf16x8*)(kp+2048); kf[3]=*(const __attribute__((address_space(3))) bf16x8*)(kp+2560);
  kf[4]=*(const __attribute__((address_space(3))) bf16x8*)(kp+4096); kf[5]=*(const __attribute__((address_space(3))) bf16x8*)(kp+4608);
  kf[6]=*(const __attribute__((address_space(3))) bf16x8*)(kp+6144); kf[7]=*(const __attribute__((address_space(3))) bf16x8*)(kp+6656);
}
__device__ __forceinline__ void kload2(bf16x8*kf,lds_cptr kp,int j){ kf[2*j]=*(const __attribute__((address_space(3))) bf16x8*)(kp+j*2048); kf[2*j+1]=*(const __attribute__((address_space(3))) bf16x8*)(kp+j*2048+512); }
__device__ __forceinline__ s16x4 vtr(lds_cptr p){ return __builtin_bit_cast(s16x4,__builtin_amdgcn_ds_read_tr16_b64_v4i16((__attribute__((address_space(3))) v4i16_t*)p)); }
__device__ __forceinline__ float rowmax(const f32x16&p0,const f32x16&p1){
  float a=max3f(p0[0],p0[1],p1[0]),b=max3f(p0[2],p0[3],p1[1]);a=max3f(a,p1[2],p1[3]);
  #pragma unroll
  for(int r=4;r<16;r+=4){a=max3f(a,p0[r],p0[r+1]);b=max3f(b,p0[r+2],p0[r+3]);a=max3f(a,p1[r],p1[r+1]);b=max3f(b,p1[r+2],p1[r+3]);}
  const float m=max2f(a,b);
  auto rr=__builtin_amdgcn_permlane32_swap(__float_as_uint(m),__float_as_uint(m),false,false);
  return max2f(__uint_as_float(rr[0]),__uint_as_float(rr[1]));
}
__device__ __forceinline__ void pv(f32x16*o,int vb,bf16x8 pa0,bf16x8 pa1,bf16x8 pa2,bf16x8 pa3){
  #pragma unroll
  for(int d0=0;d0<2;++d0){s16x4 lo[4],hi[4];
    #pragma unroll
    for(int ks=0;ks<4;++ks){
      asm volatile("ds_read_b64_tr_b16 %0,%1 offset:%c2":"=&v"(lo[ks]):"v"(vb),"i"(d0*4096+ks*1024):"memory");
      asm volatile("ds_read_b64_tr_b16 %0,%1 offset:%c2":"=&v"(hi[ks]):"v"(vb),"i"(d0*4096+ks*1024+512):"memory");}
    asm volatile("s_waitcnt lgkmcnt(0)":::"memory");SBAR();
    #define PK(k) (bf16x8){lo[k][0],lo[k][1],lo[k][2],lo[k][3],hi[k][0],hi[k][1],hi[k][2],hi[k][3]}
    o[d0]=__builtin_amdgcn_mfma_f32_32x32x16_bf16(pa0,PK(0),o[d0],0,0,0);
    o[d0]=__builtin_amdgcn_mfma_f32_32x32x16_bf16(pa1,PK(1),o[d0],0,0,0);
    o[d0]=__builtin_amdgcn_mfma_f32_32x32x16_bf16(pa2,PK(2),o[d0],0,0,0);
    o[d0]=__builtin_amdgcn_mfma_f32_32x32x16_bf16(pa3,PK(3),o[d0],0,0,0);
    #undef PK
  }
}

#ifndef ATTN_STORE16
#define ATTN_STORE16(p,v) (*(u32x4*)(p)=(v))
#endif
template<int THRL> __device__ __forceinline__ void attn_unit(int b,int h,int qb,const bf16*Q,const bf16*__restrict__ K,const bf16*__restrict__ V,bf16*O,char*shm){
  const int tid=threadIdx.x,lane=tid&63,r32=lane&31,hi=lane>>5; const int wid=__builtin_amdgcn_readfirstlane(tid>>6);
  const long rowbase=(long)b*SEQ; const int q0=qb*QB;
  const bf16*Qw=Q+(rowbase+q0+wid*QBLK)*QP+h*D;
  const bf16*Kh=K+rowbase*KP+(h/GQ)*D,*Vh=V+rowbase*KP+(h/GQ)*D;
  const unsigned lds0=(unsigned)(uintptr_t)shm;
  float*wsf=(float*)(shm+LDS_WS)+wid*64;
  const bf16*ksrc=Kh+(long)lane*KP+wid*8;
  const bf16*vsrc=Vh+(long)(16*(wid&3)+(lane>>2))*KP+(wid>>2)*32+(lane&3)*8;
  const unsigned kdst=lds0+LDS_K+wid*1024, vdst=lds0+LDS_V+wid*1024;
  #define DMA_K(t,slot) glds16(ksrc+(long)(t)*KVBLK*KP,(unsigned)__builtin_amdgcn_readfirstlane(kdst+(slot)))
  #define DMA_V(t,slot) glds16(vsrc+(long)(t)*KVBLK*KP,(unsigned)__builtin_amdgcn_readfirstlane(vdst+(slot)))
  const int vb0=(int)(lds0+LDS_V)+((lane>>4)&1)*32+(lane&3)*8+(4*hi+((lane&15)>>2))*64;
  const char*Kbase=shm+LDS_K; bf16x8 kf[8];
  const lds_cptr shm3=(lds_cptr)shm; const lds_cptr kp0=shm3+LDS_K+hi*1024+r32*16; const lds_cptr vp0=shm3+LDS_V+((lane>>4)&1)*32+(lane&3)*8+(4*hi+((lane&15)>>2))*64;
  const int NT=SEQ/KVBLK;
  DMA_K(0,0);DMA_V(0,0);DMA_K(1,SLOTB);
  bf16x8 qr[4];
  #pragma unroll
  for(int d0=0;d0<4;++d0)qr[d0]=*reinterpret_cast<const bf16x8*>(&Qw[(long)r32*QP+d0*16+hi*8]);
  float mhat=0.f,l_reg=0.f;f32x16 o[2];o[0]=f32x16{};o[1]=f32x16{};f32x16 negm=f32x16{};asm volatile("":"+v"(negm));
  const int qrel=wid*QBLK+r32;
  #define CMASK(P0,P1,t) do{}while(0)
  bool resc=false;
  #define START(P0,P1) do{ const float rm=rowmax(P0,P1); resc=false; \
    { const float dl=rm; mhat=fadd_s(mhat,dl); \
      _Pragma("unroll") for(int r=0;r<16;++r){P0[r]=fsub_s(P0[r],dl);P1[r]=fsub_s(P1[r],dl);} \
      _Pragma("unroll") for(int r=0;r<16;++r)negm[r]=-mhat; asm volatile("":"+v"(negm)); } \
    _Pragma("unroll") for(int r=0;r<16;++r)P0[r]=__builtin_amdgcn_exp2f(P0[r]); }while(0)
  #define RESC() do{ if(resc){ asm volatile("s_waitcnt lgkmcnt(0)":::"memory"); \
      _Pragma("unroll") for(int d_=0;d_<2;++d_) _Pragma("unroll") for(int r=0;r<16;++r)o[d_][r]*=wsf[crow(r,hi)]; } }while(0)
  f32x16 pA0,pA1,pB0,pB1;
  int sl_prev=0,sl_cur=0,sl_next=SLOTB;
  #define ROT() do{sl_prev=sl_cur;sl_cur=sl_next;sl_next=(sl_next==(NSLOT-1)*SLOTB)?0:sl_next+SLOTB;}while(0)
  DMA_K(2,2*SLOTB);
  WAIT_BAR(3);
  qkt(pA0,pA1,Kbase,qr,negm,r32,hi);asm volatile("s_nop 15\n\ts_nop 7":"+v"(pA0),"+v"(pA1));CMASK(pA0,pA1,0);
  START(pA0,pA1);
  _Pragma("unroll") for(int r=0;r<16;++r)pA1[r]=__builtin_amdgcn_exp2f(pA1[r]);
  WAIT_BAR(0);
  DMA_K(3,0);DMA_V(1,SLOTB);
  ROT();
  kload8(kf,kp0+sl_cur);
  WAIT_BAR(2);
  s16x4 vlo[8],vhi[8]; u32x4 pw0,pw1,pw2,pw3;
  #define PKW(P,B) cvtpk_s(P[B],P[B+1])
  #define PAF(k) __builtin_bit_cast(bf16x8,pw##k)
  #define VFR(i) (bf16x8){vlo[i][0],vlo[i][1],vlo[i][2],vlo[i][3],vhi[i][0],vhi[i][1],vhi[i][2],vhi[i][3]}
  #define PIN(x) asm volatile("":"+v"(x))
  #define MX3(a,b,c) __builtin_fmaxf(__builtin_fmaxf((a),(b)),(c))
  #define GAPA(MF,A0,A1,A2,A3,W0,W1,PW) do{ MF; sacc2+=(f32x2_t){A0,A1}; sacc2+=(f32x2_t){A2,A3}; PIN(sacc2); W0; W1; PIN(PW); SBAR(); }while(0)
  #define EX(v) __builtin_amdgcn_exp2f(v)
  #define GAPB(MF,X,B) do{ MF; X[B]=EX(X[B]); X[B+1]=EX(X[B+1]); X[B+2]=EX(X[B+2]); X[B+3]=EX(X[B+3]); PIN(X); SBAR(); }while(0)
  #define VRD(i) do{ vlo[i]=vtr(vp_+(((i)>>2)*4096+((i)&3)*1024)); vhi[i]=vtr(vp_+(((i)>>2)*4096+((i)&3)*1024+512)); }while(0)
  #define KRD(G,j) do{ if(G){ kload2(kf,kp0+sl_next,j); SBAR(); } }while(0)
  #define STEP(C0,C1,P0,P1,t,GK,GV,GL) do{ SBAR(); \
    const lds_cptr vp_=vp0+sl_prev; \
    VRD(0); SBAR(); f32x2_t sacc2={P0[0],P0[1]}; \
    GAPA(C0=__builtin_amdgcn_mfma_f32_32x32x16_bf16(kf[0],qr[0],negm,0,0,0), P0[2],P0[3],P0[4],P0[5],     pw0[0]=PKW(P0,0), pw0[1]=PKW(P0,2), pw0); \
    VRD(4); SBAR(); GAPA(C1=__builtin_amdgcn_mfma_f32_32x32x16_bf16(kf[1],qr[0],negm,0,0,0), P0[6],P0[7],P0[8],P0[9],     pw0[2]=PKW(P0,4), pw0[3]=PKW(P0,6), pw0); \
    VRD(1); SBAR(); GAPA(C0=__builtin_amdgcn_mfma_f32_32x32x16_bf16(kf[2],qr[1],C0,0,0,0),   P0[10],P0[11],P0[12],P0[13], pw1[0]=PKW(P0,8), pw1[1]=PKW(P0,10), pw1); \
    VRD(5); SBAR(); GAPA(C1=__builtin_amdgcn_mfma_f32_32x32x16_bf16(kf[3],qr[1],C1,0,0,0),   P0[14],P0[15],P1[0],P1[1],   pw1[2]=PKW(P0,12),pw1[3]=PKW(P0,14), pw1); \
    VRD(2); SBAR(); GAPA(C0=__builtin_amdgcn_mfma_f32_32x32x16_bf16(kf[4],qr[2],C0,0,0,0),   P1[2],P1[3],P1[4],P1[5],     pw2[0]=PKW(P1,0), pw2[1]=PKW(P1,2), pw2); \
    VRD(6); SBAR(); GAPA(C1=__builtin_amdgcn_mfma_f32_32x32x16_bf16(kf[5],qr[2],C1,0,0,0),   P1[6],P1[7],P1[8],P1[9],     pw2[2]=PKW(P1,4), pw2[3]=PKW(P1,6), pw2); \
    VRD(3); SBAR(); GAPA(C0=__builtin_amdgcn_mfma_f32_32x32x16_bf16(kf[6],qr[3],C0,0,0,0),   P1[10],P1[11],P1[12],P1[13], pw3[0]=PKW(P1,8), pw3[1]=PKW(P1,10), pw3); \
    VRD(7); SBAR(); GAPA(C1=__builtin_amdgcn_mfma_f32_32x32x16_bf16(kf[7],qr[3],C1,0,0,0),   P1[14],P1[15],0.f,0.f,       pw3[2]=PKW(P1,12),pw3[3]=PKW(P1,14), pw3); \
    l_reg+=sacc2.x+sacc2.y; \
    if(GK){DMA_K((t)+3,sl_cur);} if(GV){DMA_V((t)+1,sl_next);} \
    CMASK(C0,C1,t); \
    if(THRL>=0)   \
    { float a=MX3(C0[0],C0[1],C1[0]),b=MX3(C0[2],C0[3],C1[1]); a=MX3(a,C1[2],C1[3]); \
      _Pragma("unroll") for(int r=4;r<16;r+=4){a=MX3(a,C0[r],C0[r+1]);b=MX3(b,C0[r+2],C0[r+3]);a=MX3(a,C1[r],C1[r+1]);b=MX3(b,C1[r+2],C1[r+3]);} \
      float rm=__builtin_fmaxf(a,b); { auto rr=__builtin_amdgcn_permlane32_swap(__float_as_uint(rm),__float_as_uint(rm),false,false); rm=__builtin_fmaxf(__uint_as_float(rr[0]),__uint_as_float(rr[1])); } \
      resc=false; \
      if(__builtin_expect(__any(rm>(float)THRL),0)){ const float dl=__builtin_fmaxf(rm,0.f); mhat+=dl; \
        _Pragma("unroll") for(int r=0;r<16;++r){C0[r]-=dl;C1[r]-=dl;} \
        _Pragma("unroll") for(int r=0;r<16;++r)negm[r]=-mhat; asm volatile("":"+v"(negm)); \
        const float f=__builtin_amdgcn_exp2f(-dl); l_reg*=f; if(hi==0)wsf[r32]=f; resc=true; } } \
    else { resc=false; } \
    SBAR(); \
    GAPB(o[0]=__builtin_amdgcn_mfma_f32_32x32x16_bf16(PAF(0),VFR(0),o[0],0,0,0), C0,0); \
    GAPB(o[1]=__builtin_amdgcn_mfma_f32_32x32x16_bf16(PAF(0),VFR(4),o[1],0,0,0), C0,4); \
    KRD(GL,0); GAPB(o[0]=__builtin_amdgcn_mfma_f32_32x32x16_bf16(PAF(1),VFR(1),o[0],0,0,0), C0,8); \
    KRD(GL,1); GAPB(o[1]=__builtin_amdgcn_mfma_f32_32x32x16_bf16(PAF(1),VFR(5),o[1],0,0,0), C0,12); \
    KRD(GL,2); GAPB(o[0]=__builtin_amdgcn_mfma_f32_32x32x16_bf16(PAF(2),VFR(2),o[0],0,0,0), C1,0); \
    KRD(GL,3); GAPB(o[1]=__builtin_amdgcn_mfma_f32_32x32x16_bf16(PAF(2),VFR(6),o[1],0,0,0), C1,4); \
    GAPB(o[0]=__builtin_amdgcn_mfma_f32_32x32x16_bf16(PAF(3),VFR(3),o[0],0,0,0), C1,8); \
    GAPB(o[1]=__builtin_amdgcn_mfma_f32_32x32x16_bf16(PAF(3),VFR(7),o[1],0,0,0), C1,12); \
    }while(0)
  int t=1;
  #undef CMASK
  #define CMASK(P0,P1,t) do{}while(0)
  for(;t+5<NT;t+=2){
    STEP(pB0,pB1,pA0,pA1,t,true,true,true);     WAIT_BAR(2); RESC(); ROT();
    STEP(pA0,pA1,pB0,pB1,t+1,true,true,true);   WAIT_BAR(2); RESC(); ROT();
  }
  #undef CMASK
  #define CMASK(P0,P1,t) do{}while(0)
  #define ENDW(tt) do{ if((tt)+3<NT){WAIT_BAR(2);} else if((tt)+2<NT){WAIT_BAR(1);} else {WAIT_BAR(0);} }while(0)
  for(;t+1<NT;t+=2){
    STEP(pB0,pB1,pA0,pA1,t,(t+3<NT),(t+1<NT),(t+1<NT));       ENDW(t);   RESC(); ROT();
    STEP(pA0,pA1,pB0,pB1,t+1,(t+4<NT),(t+2<NT),(t+2<NT));     ENDW(t+1); RESC(); ROT();
  }
  STEP(pB0,pB1,pA0,pA1,NT-1,false,false,false); RESC();
  { float sacc=pB0[0]+pB0[1]; _Pragma("unroll") for(int r=2;r<16;++r)sacc+=pB0[r]; _Pragma("unroll") for(int r=0;r<16;++r)sacc+=pB1[r]; l_reg+=sacc;
    pw0=(u32x4){PKW(pB0,0),PKW(pB0,2),PKW(pB0,4),PKW(pB0,6)};pw1=(u32x4){PKW(pB0,8),PKW(pB0,10),PKW(pB0,12),PKW(pB0,14)};pw2=(u32x4){PKW(pB1,0),PKW(pB1,2),PKW(pB1,4),PKW(pB1,6)};pw3=(u32x4){PKW(pB1,8),PKW(pB1,10),PKW(pB1,12),PKW(pB1,14)};
    SBAR(); pv(o,vb0+sl_cur,PAF(0),PAF(1),PAF(2),PAF(3)); }
  #undef PKW
  #undef PAF
  #undef VFR
  #undef PIN
  #undef MX3
  #undef GAPA
  #undef GAPB
  #undef EX
  #undef VRD
  #undef KRD
  #undef STEP
  #undef ENDW
  {auto rr=__builtin_amdgcn_permlane32_swap(__float_as_uint(l_reg),__float_as_uint(l_reg),false,false);l_reg=__uint_as_float(rr[0])+__uint_as_float(rr[1]);}
  if(hi==0)wsf[32+r32]=l_reg;asm volatile("s_waitcnt lgkmcnt(0)":::"memory");
  float rli[16];
  #pragma unroll
  for(int r=0;r<16;++r)rli[r]=__builtin_amdgcn_rcpf(wsf[32+crow(r,hi)]);
  bf16*Ow=O+(rowbase+q0+wid*QBLK)*OP+h*D;
  { bf16*stg=(bf16*)(shm+LDS_OST)+wid*2048;
    #pragma unroll
    for(int r=0;r<16;++r){const int orow=crow(r,hi);
      #pragma unroll
      for(int d0=0;d0<2;++d0)stg[orow*64+d0*32+r32]=__float2bfloat16(o[d0][r]*rli[r]);}
    asm volatile("s_waitcnt lgkmcnt(0)":::"memory");
    #pragma unroll
    for(int i=0;i<4;++i){const int row=i*8+(lane>>3),ch=lane&7; const u32x4 v=*(const u32x4*)(stg+row*64+ch*8); ATTN_STORE16(Ow+(long)row*OP+ch*8,v);} }
  asm volatile("s_waitcnt lgkmcnt(0)\n\ts_barrier":::"memory");
  #undef DMA_K
  #undef DMA_V
  #undef CMASK
  #undef START
  #undef RESC
  #undef ROT
}
constexpr int ATTN_LDS_BYTES=LDS_BYTES;
struct AttnTensors { const bf16* Q; const bf16* K; const bf16* V; bf16* O; };
struct AttnUnit { int bh; int qb; };
struct StaticOrder {
  int vcu,G;
  __device__ __forceinline__ explicit StaticOrder(int grid,int block):vcu((grid%8==0)?(block%8)*(grid/8)+block/8:block),G(grid){}
  __device__ __forceinline__ bool next(int i,AttnUnit&u)const{ const int U=vcu+G*i; if(U>=BATCH*NHEAD*NQB)return false; u.bh=U/NQB; u.qb=U%NQB; return true; }
  __device__ __forceinline__ void a_ready(const AttnUnit&)const{}
  __device__ __forceinline__ void done(const AttnUnit&)const{}
};
template<class Sched,int THRL=8> __device__ __forceinline__ void attn_phase(char*lds,const AttnTensors&T,const Sched&S){
  AttnUnit u;
  for(int i=0;S.next(i,u);++i){ S.a_ready(u); attn_unit<THRL>(u.bh/NHEAD,u.bh%NHEAD,u.qb,T.Q,T.K,T.V,T.O,lds); S.done(u); }
}
#undef SBAR
#undef WAIT_BAR
}
namespace cg = cooperative_groups;
#define LAS __attribute__((address_space(3)))
typedef unsigned short bf16;
typedef float f32x4 __attribute__((ext_vector_type(4)));
typedef float f32x16 __attribute__((ext_vector_type(16)));
typedef short bf16x8 __attribute__((ext_vector_type(8)));
typedef short s16x4 __attribute__((ext_vector_type(4)));
typedef unsigned v4u __attribute__((ext_vector_type(4)));
typedef unsigned v2u __attribute__((ext_vector_type(2)));

constexpr int NB = 8, SEQ = 8192, DM = 1024, M = NB * SEQ, NPROJ = 2816, NPAD = 3072, FF = 2816, NWAVES = 8;
constexpr float EPS = 1e-6f;
constexpr size_t MiB = 1u << 20;
constexpr size_t WS_SS = 0;
constexpr size_t WS_BA = 1 * MiB;
constexpr size_t WS_EG = 5 * MiB;
constexpr size_t WS_WIN = 10 * MiB, WS_WOUT = 16 * MiB, WS_WGU = 18 * MiB, WS_WDN = 30 * MiB, WS_WPG = 36 * MiB, WS_WPL = 38 * MiB;
constexpr size_t WS_PB = 48 * MiB;
constexpr size_t WS_B = 80 * MiB;
constexpr size_t WS_C = 208 * MiB;
constexpr size_t WS_W = WS_C, WS_UT = WS_C + 128 * MiB, WS_QKM = WS_C + 256 * MiB;
constexpr size_t WS_D = 560 * MiB;
constexpr size_t WS_QA = WS_D, WS_KA = WS_D + 64 * MiB, WS_VA = WS_D + 80 * MiB, WS_DQ = WS_D + 96 * MiB, WS_DK = WS_D + 160 * MiB, WS_KT = WS_D + 224 * MiB, WS_VT = WS_D + 288 * MiB, WS_Z = WS_D + 352 * MiB;
constexpr size_t WS_OF = WS_VT, WS_OB = WS_DK, WS_HB1 = WS_D;
constexpr size_t WS_QCTR = 800 * 1024;
constexpr size_t WS_END = 1024 * MiB;
static_assert(WS_Z + 64 * MiB <= WS_END, "ws map");
constexpr int LDS_BYTES = 147456;
constexpr int SAP = 68;

struct Args { const float* in[19]; float* out; unsigned char* ws; int ph_lo, ph_hi; };

struct Frame {
    LAS unsigned char* lds; int tid, lane, wave, vcu, G;
    const float* const* in; float* out; unsigned char* ws;
    __device__ __forceinline__ const float* x() const { return in[0]; }
    __device__ __forceinline__ const float* p() const { return in[1]; }
    __device__ __forceinline__ const float* norm_mix() const { return in[2]; }
    __device__ __forceinline__ const float* w_in() const { return in[3]; }
    __device__ __forceinline__ const float* conv_w() const { return in[4]; }
    __device__ __forceinline__ const float* q_norm() const { return in[5]; }
    __device__ __forceinline__ const float* k_norm() const { return in[6]; }
    __device__ __forceinline__ const float* a_log() const { return in[7]; }
    __device__ __forceinline__ const float* dt_bias() const { return in[8]; }
    __device__ __forceinline__ const float* dn_norm() const { return in[9]; }
    __device__ __forceinline__ const float* w_out() const { return in[10]; }
    __device__ __forceinline__ const float* norm_ffn() const { return in[11]; }
    __device__ __forceinline__ const float* w_gate() const { return in[12]; }
    __device__ __forceinline__ const float* w_up() const { return in[13]; }
    __device__ __forceinline__ const float* w_down() const { return in[14]; }
    __device__ __forceinline__ const float* norm_ple() const { return in[15]; }
    __device__ __forceinline__ const float* w_ple_gate() const { return in[16]; }
    __device__ __forceinline__ const float* w_ple() const { return in[17]; }
    __device__ __forceinline__ const float* norm_final() const { return in[18]; }
    __device__ __forceinline__ float* SS() const { return (float*)(ws + WS_SS); }
    __device__ __forceinline__ float* BA() const { return (float*)(ws + WS_BA); }
    __device__ __forceinline__ float* EG() const { return (float*)(ws + WS_EG); }
    __device__ __forceinline__ unsigned* QCTR() const { return (unsigned*)(ws + WS_QCTR); }
    __device__ __forceinline__ bf16* Wt_in() const { return (bf16*)(ws + WS_WIN); }
    __device__ __forceinline__ bf16* Wt_out() const { return (bf16*)(ws + WS_WOUT); }
    __device__ __forceinline__ bf16* Wt_gu() const { return (bf16*)(ws + WS_WGU); }
    __device__ __forceinline__ bf16* Wt_dn() const { return (bf16*)(ws + WS_WDN); }
    __device__ __forceinline__ bf16* Wt_pg() const { return (bf16*)(ws + WS_WPG); }
    __device__ __forceinline__ bf16* Wt_pl() const { return (bf16*)(ws + WS_WPL); }
    __device__ __forceinline__ bf16* PB() const { return (bf16*)(ws + WS_PB); }
    __device__ __forceinline__ bf16* XN() const { return (bf16*)(ws + WS_B); }
    __device__ __forceinline__ bf16* MIXED() const { return (bf16*)(ws + WS_B); }
    __device__ __forceinline__ bf16* HB2() const { return (bf16*)(ws + WS_B); }
    __device__ __forceinline__ bf16* PROJ() const { return (bf16*)(ws + WS_C); }
    __device__ __forceinline__ bf16* W() const { return (bf16*)(ws + WS_W); }
    __device__ __forceinline__ bf16* UT() const { return (bf16*)(ws + WS_UT); }
    __device__ __forceinline__ bf16* QKM() const { return (bf16*)(ws + WS_QKM); }
    __device__ __forceinline__ bf16* ACT() const { return (bf16*)(ws + WS_C); }
    __device__ __forceinline__ bf16* PE() const { return (bf16*)(ws + WS_C); }
    __device__ __forceinline__ bf16* QA() const { return (bf16*)(ws + WS_QA); }
    __device__ __forceinline__ bf16* KA() const { return (bf16*)(ws + WS_KA); }
    __device__ __forceinline__ bf16* VA() const { return (bf16*)(ws + WS_VA); }
    __device__ __forceinline__ bf16* DQ() const { return (bf16*)(ws + WS_DQ); }
    __device__ __forceinline__ bf16* DK() const { return (bf16*)(ws + WS_DK); }
    __device__ __forceinline__ bf16* KT() const { return (bf16*)(ws + WS_KT); }
    __device__ __forceinline__ bf16* VT() const { return (bf16*)(ws + WS_VT); }
    __device__ __forceinline__ bf16* Z() const { return (bf16*)(ws + WS_Z); }
    __device__ __forceinline__ bf16* OF() const { return (bf16*)(ws + WS_OF); }
    __device__ __forceinline__ bf16* OB() const { return (bf16*)(ws + WS_OB); }
    __device__ __forceinline__ bf16* HB1() const { return (bf16*)(ws + WS_HB1); }
};
#define LDS_FENCE() asm volatile("s_waitcnt lgkmcnt(0)" ::: "memory")
__device__ __forceinline__ unsigned pk2(float lo, float hi) { return attn_body::cvtpk_s(lo, hi); }
__device__ __forceinline__ float bflo(unsigned w) { return __uint_as_float(w << 16); }
__device__ __forceinline__ float bfhi(unsigned w) { return __uint_as_float(w & 0xffff0000u); }
__device__ __forceinline__ float bf2f(short s) { return __uint_as_float(((unsigned)(unsigned short)s) << 16); }
__device__ __forceinline__ bf16 f2bf(float f) { return (bf16)(pk2(f, 0.f) & 0xffffu); }
__device__ __forceinline__ float wave_sum(float v) {
#pragma unroll
    for (int o = 1; o < 64; o <<= 1) v += __shfl_xor(v, o);
    return v;
}
__device__ __forceinline__ int crow(int r, int hi) { return (r & 3) + 8 * (r >> 2) + 4 * hi; }
__device__ __forceinline__ float fast_sig(float v) { return __builtin_amdgcn_rcpf(1.f + __expf(-v)); }
#define MFMA32(a, b, c) __builtin_amdgcn_mfma_f32_32x32x16_bf16((a), (b), (c), 0, 0, 0)

__device__ __forceinline__ void p0_transpose_item(const float* W, int ldw, int K, int ncols, int nvalid, bf16* WT, int rb, int rstride, int roff, const float* gain, LAS float* scr, int item, int lane) {
    const int nblk = ncols / 32, kb = item / nblk, nb = item % nblk, k0 = 64 * kb, n0 = 32 * nb;
    float tv[32];
#pragma unroll
    for (int i = 0; i < 32; ++i) { const int kk = 2 * i + (lane >> 5), n = n0 + (lane & 31); tv[i] = (n < nvalid) ? W[(size_t)(k0 + kk) * ldw + n] : 0.f; }
#pragma unroll
    for (int i = 0; i < 32; ++i) { const int kk = 2 * i + (lane >> 5); float v = tv[i]; if (gain) v *= gain[k0 + kk]; scr[kk * 33 + (lane & 31)] = v; }
    LDS_FENCE();
    const int c = lane & 7;
#pragma unroll
    for (int j = 0; j < 4; ++j) { const int nl = (lane >> 3) + 8 * j, n = n0 + nl; const LAS float* s = scr + (8 * c) * 33 + nl;
        v4u o; o.x = pk2(s[0 * 33], s[1 * 33]); o.y = pk2(s[2 * 33], s[3 * 33]); o.z = pk2(s[4 * 33], s[5 * 33]); o.w = pk2(s[6 * 33], s[7 * 33]);
        const int drow = (n / rb) * rstride + roff + (n % rb);
        *(v4u*)(WT + (size_t)drow * K + k0 + 8 * c) = o; }
    LDS_FENCE();
}
__device__ __forceinline__ void p0_prologue(Frame& F) {
    LAS float* scr = (LAS float*)(F.lds + F.wave * 16384);
    const int gw = F.vcu * NWAVES + F.wave, NGW = F.G * NWAVES;
    constexpr int I_IN = 16 * (NPAD / 32), I_OUT = 16 * 32, I_G = 16 * (FF / 32), I_DN = (FF / 64) * 32, I_PG = 16 * 32, I_PL = 4 * 32;
    constexpr int NITEMS = I_IN + I_OUT + 2 * I_G + I_DN + I_PG + I_PL;
    constexpr int BIG = 1 << 30;
    for (int it = gw; it < NITEMS; it += NGW) {
        int r = it;
        if (r < I_IN) { p0_transpose_item(F.w_in(), 2832, 1024, NPAD, 2832, F.Wt_in(), BIG, 0, 0, nullptr, scr, r, F.lane); continue; } r -= I_IN;
        if (r < I_OUT) { p0_transpose_item(F.w_out(), 1024, 1024, 1024, 1024, F.Wt_out(), BIG, 0, 0, nullptr, scr, r, F.lane); continue; } r -= I_OUT;
        if (r < I_G) { p0_transpose_item(F.w_gate(), FF, 1024, FF, FF, F.Wt_gu(), 128, 256, 0, F.norm_ffn(), scr, r, F.lane); continue; } r -= I_G;
        if (r < I_G) { p0_transpose_item(F.w_up(), FF, 1024, FF, FF, F.Wt_gu(), 128, 256, 128, F.norm_ffn(), scr, r, F.lane); continue; } r -= I_G;
        if (r < I_DN) { p0_transpose_item(F.w_down(), 1024, FF, 1024, 1024, F.Wt_dn(), BIG, 0, 0, nullptr, scr, r, F.lane); continue; } r -= I_DN;
        if (r < I_PG) { p0_transpose_item(F.w_ple_gate(), 1024, 1024, 1024, 1024, F.Wt_pg(), BIG, 0, 0, F.norm_ple(), scr, r, F.lane); continue; } r -= I_PG;
        p0_transpose_item(F.w_ple(), 1024, 256, 1024, 1024, F.Wt_pl(), BIG, 0, 0, nullptr, scr, r, F.lane);
    }
    f32x4 gn[4];
#pragma unroll
    for (int j = 0; j < 4; ++j) gn[j] = ((const f32x4*)F.norm_mix())[F.lane + 64 * j];
    for (int m0 = gw * 4; m0 < M; m0 += NGW * 4) { f32x4 v[4][4];
#pragma unroll
        for (int r = 0; r < 4; ++r) { const f32x4* xr = (const f32x4*)(F.x() + (size_t)(m0 + r) * DM) + F.lane;
#pragma unroll
            for (int j = 0; j < 4; ++j) v[r][j] = xr[64 * j]; }
#pragma unroll
        for (int r = 0; r < 4; ++r) { float s = 0.f;
#pragma unroll
            for (int j = 0; j < 4; ++j) s += (v[r][j].x * v[r][j].x + v[r][j].y * v[r][j].y) + (v[r][j].z * v[r][j].z + v[r][j].w * v[r][j].w);
            const float rstd = rsqrtf(wave_sum(s) * (1.f / DM) + EPS); v2u* o8 = (v2u*)(F.XN() + (size_t)(m0 + r) * DM) + F.lane;
#pragma unroll
            for (int j = 0; j < 4; ++j) { const f32x4 y = v[r][j] * rstd * gn[j]; v2u w; w.x = pk2(y.x, y.y); w.y = pk2(y.z, y.w); o8[64 * j] = w; } }
    }
    const size_t gt = (size_t)F.vcu * 512 + F.tid, NGT = (size_t)F.G * 512;
    for (size_t i = gt; i < (size_t)M * 256 / 4; i += NGT * 4) { f32x4 v[4];
#pragma unroll
        for (int k = 0; k < 4; ++k) if (i + k * NGT < (size_t)M * 256 / 4) v[k] = ((const f32x4*)F.p())[i + k * NGT];
#pragma unroll
        for (int k = 0; k < 4; ++k) if (i + k * NGT < (size_t)M * 256 / 4) { v2u w; w.x = pk2(v[k].x, v[k].y); w.y = pk2(v[k].z, v[k].w); ((v2u*)F.PB())[i + k * NGT] = w; } }
    for (size_t i = gt; i < (size_t)3 * M; i += NGT) F.SS()[i] = 0.f;
    if (gt < 8 * 64 || (gt >= 600 && gt < 832)) F.QCTR()[gt] = 0u;
}

constexpr int P2_TAB_BYTES = 192 * 16 * 8;
__device__ __forceinline__ void p2_rope_table(Frame& F) {
    LAS float* tab = (LAS float*)F.lds;
    for (int i = F.tid; i < 192 * 16; i += NWAVES * 64) { const int pos = i >> 4, j = i & 15; const float inv = powf(10000.0f, -(float)j * (1.f / 16.f));
        float s, c; sincosf((float)(pos < 128 ? pos : pos - 128) * inv, &s, &c); tab[2 * i] = c; tab[2 * i + 1] = s; }
    LDS_FENCE(); __syncthreads();
}
__device__ __forceinline__ void p2_attn_rows(Frame& F) {
    const int gw = F.vcu * NWAVES + F.wave, NGW = F.G * NWAVES, lane = F.lane;
    constexpr float C2 = 0.125f * 1.4426950408889634f;
    const LAS float* tab = (const LAS float*)F.lds;
    const bf16* __restrict__ PROJ = F.PROJ(); bf16* __restrict__ QA = F.QA(); bf16* __restrict__ KA = F.KA(); bf16* __restrict__ VA = F.VA(); bf16* __restrict__ Z = F.Z();
    float gq[4], gk[4];
#pragma unroll
    for (int k = 0; k < 4; ++k) { gq[k] = F.q_norm()[(lane & 15) + 16 * k]; gk[k] = F.k_norm()[(lane & 15) + 16 * k]; }
    for (int m0 = gw * 4; m0 < M; m0 += NGW * 4) {
        bf16 xr[4][3][4]; unsigned vv[4]; v4u zz[4];
#pragma unroll
        for (int rr = 0; rr < 4; ++rr) { const bf16* pr = PROJ + (size_t)(m0 + rr) * NPROJ;
#pragma unroll
            for (int it = 0; it < 3; ++it) { const int idx = it * 64 + lane, head = idx >> 4, j = idx & 15;
                if (head < 10) { const bf16* hp = pr + head * 64 + j;
#pragma unroll
                    for (int k = 0; k < 4; ++k) xr[rr][it][k] = hp[16 * k]; } }
            vv[rr] = ((const unsigned*)(pr + 640))[lane]; zz[rr] = ((const v4u*)(pr + 2304))[lane]; }
#pragma unroll
        for (int rr = 0; rr < 4; ++rr) { const int m = m0 + rr, s = m & (SEQ - 1), prow = s >> 6, pcol = 128 + (s & 63);
#pragma unroll
            for (int it = 0; it < 3; ++it) { const int idx = it * 64 + lane, head = idx >> 4, j = idx & 15;
                if (head < 10) {
                    float x0 = __uint_as_float((unsigned)xr[rr][it][0] << 16), x1 = __uint_as_float((unsigned)xr[rr][it][1] << 16), x2 = __uint_as_float((unsigned)xr[rr][it][2] << 16), x3 = __uint_as_float((unsigned)xr[rr][it][3] << 16);
                    float ss = (x0 * x0 + x1 * x1) + (x2 * x2 + x3 * x3);
                    ss += __shfl_xor(ss, 1); ss += __shfl_xor(ss, 2); ss += __shfl_xor(ss, 4); ss += __shfl_xor(ss, 8);
                    const float rs = rsqrtf(ss * (1.f / 64.f) + EPS); const bool isq = head < 8;
                    x0 *= rs * (isq ? gq[0] : gk[0]); x1 *= rs * (isq ? gq[1] : gk[1]); x2 *= rs * (isq ? gq[2] : gk[2]); x3 *= rs * (isq ? gq[3] : gk[3]);
                    const float cr = tab[(prow * 16 + j) * 2], sr = tab[(prow * 16 + j) * 2 + 1], cc = tab[(pcol * 16 + j) * 2], sc = tab[(pcol * 16 + j) * 2 + 1];
                    float o0 = x0 * cr - x1 * sr, o1 = x1 * cr + x0 * sr, o2 = x2 * cc - x3 * sc, o3 = x3 * cc + x2 * sc;
                    bf16* op;
                    if (isq) { o0 *= C2; o1 *= C2; o2 *= C2; o3 *= C2; op = QA + (size_t)m * 512 + head * 64 + j; } else op = KA + (size_t)m * 128 + (head - 8) * 64 + j;
                    op[0] = f2bf(o0); op[16] = f2bf(o1); op[32] = f2bf(o2); op[48] = f2bf(o3);
                } }
            ((unsigned*)(VA + (size_t)m * 128))[lane] = vv[rr]; ((v4u*)(Z + (size_t)m * 512))[lane] = zz[rr]; }
    }
}
struct ConvIn { unsigned u[12]; float w0[5], w1[5]; };
__device__ __forceinline__ void p2_conv_load(Frame& F, int item, ConvIn& C, int lane, int wid) {
    const int type = item % 3, h4 = (item / 3) & 3, n = (item / 12) & 127, b = item / (12 * 128); const int ch = type * 512 + h4 * 128 + 2 * lane;
    const bf16* src = F.PROJ() + (size_t)b * SEQ * NPROJ + 768 + ch; const int s0 = n * 64 + 8 * wid - 2;
#pragma unroll
    for (int k = 0; k < 12; ++k) { const int s = s0 + k; C.u[k] = (s >= 0 && s < SEQ) ? *(const unsigned*)(src + (size_t)s * NPROJ) : 0u; }
#pragma unroll
    for (int j = 0; j < 5; ++j) { C.w0[j] = F.conv_w()[j * 1536 + ch]; C.w1[j] = F.conv_w()[j * 1536 + ch + 1]; }
}
__device__ __forceinline__ void p2_dn_conv(Frame& F) {
    const int lane = F.lane, wid = F.wave; constexpr int NIT = NB * 128 * 12;
    ConvIn C, Cn; int item = F.vcu; if (item < NIT) p2_conv_load(F, item, C, lane, wid);
    for (; item < NIT; item += F.G) {
        const int type = item % 3, h4 = (item / 3) & 3, n = (item / 12) & 127, b = item / (12 * 128);
        if (item + F.G < NIT) p2_conv_load(F, item + F.G, Cn, lane, wid);
        float y0[8], y1[8];
#pragma unroll
        for (int i = 0; i < 8; ++i) { float a0 = 0.f, a1 = 0.f;
#pragma unroll
            for (int j = 0; j < 5; ++j) { a0 += C.w0[j] * bflo(C.u[i + j]); a1 += C.w1[j] * bfhi(C.u[i + j]); }
            a0 = a0 * fast_sig(a0); a1 = a1 * fast_sig(a1);
            if (type < 2) { const float ss = wave_sum(a0 * a0 + a1 * a1); float rs = rsqrtf(ss + EPS); if (type == 0) rs *= 0.08838834764831845f; a0 *= rs; a1 *= rs; }
            y0[i] = a0; y1[i] = a1; }
        const size_t row0 = (size_t)b * SEQ + n * 64 + 8 * wid;
        if (type < 2) { bf16* dst = (type == 0 ? F.DQ() : F.DK()) + row0 * 512 + h4 * 128 + 2 * lane;
#pragma unroll
            for (int i = 0; i < 8; ++i) *(unsigned*)(dst + (size_t)i * 512) = pk2(y0[i], y1[i]); }
        if (type != 0) {
            bf16* dst = (type == 1 ? F.KT() : F.VT()) + ((size_t)(b * 4 + h4) * 128 + n) * 8192 + (size_t)(2 * lane) * 64 + 8 * wid;
            v4u o0, o1; o0.x = pk2(y0[0], y0[1]); o0.y = pk2(y0[2], y0[3]); o0.z = pk2(y0[4], y0[5]); o0.w = pk2(y0[6], y0[7]);
            o1.x = pk2(y1[0], y1[1]); o1.y = pk2(y1[2], y1[3]); o1.z = pk2(y1[4], y1[5]); o1.w = pk2(y1[6], y1[7]);
            *(v4u*)dst = o0; *(v4u*)(dst + 64) = o1; }
        C = Cn;
    }
}
__device__ __forceinline__ bf16x8 ld8(const bf16* p) { return *(const bf16x8*)p; }
__device__ __forceinline__ bf16x8 ld44(const bf16* p) { const s16x4 a = *(const s16x4*)p, b = *(const s16x4*)(p + 8); return (bf16x8){a[0], a[1], a[2], a[3], b[0], b[1], b[2], b[3]}; }
__device__ __forceinline__ bf16x8 pack8(float a0, float a1, float a2, float a3, float a4, float a5, float a6, float a7) {
    v4u w; w.x = pk2(a0, a1); w.y = pk2(a2, a3); w.z = pk2(a4, a5); w.w = pk2(a6, a7); return __builtin_bit_cast(bf16x8, w); }
__device__ __forceinline__ void dn_prep_item(Frame& F, int item, LAS float* SA, LAS float* sv, int lane) {
    const int n = item & 127, h8 = (item >> 7) & 7, b = item >> 10, dir = h8 >> 2, h4 = h8 & 3;
    const size_t tok0 = (size_t)b * SEQ + n * 64; const int r32 = lane & 31, hi = lane >> 5;
    const bf16* Kp = F.DK() + (tok0 + r32) * 512 + h4 * 128 + 8 * hi; const bf16* Qp = F.DQ() + (tok0 + r32) * 512 + h4 * 128 + 8 * hi;
    bf16x8 kf[2][8], qf[8];
#pragma unroll
    for (int kb = 0; kb < 8; ++kb) { kf[0][kb] = ld8(Kp + 16 * kb); kf[1][kb] = ld8(Kp + (size_t)32 * 512 + 16 * kb); qf[kb] = ld8(Qp + 16 * kb); }
    { const float* ba = F.BA() + (tok0 + lane) * 16; const float braw = ba[h8], araw = ba[8 + h8];
      const float beta = 1.f / (1.f + __expf(-braw)); const float xx = araw + F.dt_bias()[h8];
      const float sp = fmaxf(xx, 0.f) + log1pf(__expf(-fabsf(xx))); const float g = -__expf(F.a_log()[h8]) * sp;
      float gc = dir ? __shfl(g, 63 - lane) : g;
#pragma unroll
      for (int o = 1; o < 64; o <<= 1) { const float t = __shfl_up(gc, o); if (lane >= o) gc += t; }
      const float Gtot = __shfl(gc, 63); const float G = dir ? __shfl(gc, 63 - lane) : gc; const float eg = __expf(G);
      sv[lane] = G; sv[64 + lane] = beta; sv[128 + lane] = beta * eg;
      F.EG()[(size_t)item * 128 + lane] = eg; F.EG()[(size_t)item * 128 + 64 + lane] = __expf(Gtot - G); }
    LDS_FENCE();
#ifdef PROBE_SUB
    unsigned long long t_a = __builtin_amdgcn_s_memrealtime();
#endif
#pragma unroll
    for (int ti = 0; ti < 2; ++ti)
#pragma unroll
        for (int tj = 0; tj < 2; ++tj) { f32x16 acc = {}, acq = {}; int r32c = r32, hic = hi; asm volatile("" : "+v"(r32c), "+v"(hic));
#pragma unroll
            for (int kb = 0; kb < 8; ++kb) { acc = MFMA32(kf[tj][kb], kf[ti][kb], acc); acq = MFMA32(kf[tj][kb], qf[kb], acq); }
            if (ti == 0 && tj == 1) {
#pragma unroll
                for (int kb = 0; kb < 8; ++kb) qf[kb] = ld8(Qp + (size_t)32 * 512 + 16 * kb); }
            const int i = 32 * ti + r32c, ci = dir ? 63 - i : i; const float Gi = sv[i], bi = sv[64 + i]; float qv[16];
#pragma unroll
            for (int r = 0; r < 16; ++r) { const int j = 32 * tj + crow(r, hic), cj = dir ? 63 - j : j; const float dec = __expf(fminf(Gi - sv[j], 0.f));
                SA[ci * SAP + cj] = (ci > cj) ? bi * acc[r] * dec : 0.f; qv[r] = (ci >= cj) ? acq[r] * dec : 0.f; }
            bf16* qp = F.QKM() + (size_t)item * 4096 + i * 64 + 32 * tj + 4 * hic;
#pragma unroll
            for (int q = 0; q < 4; ++q) { v2u w; w.x = pk2(qv[4 * q], qv[4 * q + 1]); w.y = pk2(qv[4 * q + 2], qv[4 * q + 3]); *(v2u*)(qp + 8 * q) = w; }
            asm volatile("" ::: "memory"); }
    LDS_FENCE();
#ifdef PROBE_SUB
    unsigned long long t_b = __builtin_amdgcn_s_memrealtime();
#endif
    const bf16* VTp = F.VT() + ((size_t)(b * 4 + h4) * 128 + n) * 8192 + r32 * 64 + 8 * hi; const bf16* KTp = F.KT() + ((size_t)(b * 4 + h4) * 128 + n) * 8192 + r32 * 64 + 8 * hi;
    bf16x8 xf[4][4];
#pragma unroll
    for (int td = 0; td < 4; ++td)
#pragma unroll
        for (int kb = 0; kb < 4; ++kb) xf[td][kb] = ld8(VTp + td * 2048 + 16 * kb);
    asm volatile("" ::: "memory");
    { float T[64];
#if defined(DUP_PH) && DUP_PH == 33
      for (int rep33 = 0; rep33 < 2; ++rep33)
#endif
#pragma unroll
      for (int i = 0; i < 64; ++i) { float a = (lane == i) ? 1.f : 0.f, a2 = 0.f;
#pragma unroll
          for (int jq = 0; jq * 4 < i; ++jq) { const f32x4 a4 = *(const LAS f32x4*)(SA + i * SAP + 4 * jq);
              a -= a4.x * T[4 * jq]; if (4 * jq + 1 < i) a2 -= a4.y * T[4 * jq + 1]; if (4 * jq + 2 < i) a -= a4.z * T[4 * jq + 2]; if (4 * jq + 3 < i) a2 -= a4.w * T[4 * jq + 3];
              if ((jq & 3) == 3) asm volatile("" ::: "memory"); }
          T[i] = a + a2; asm volatile("" ::: "memory"); }
      LDS_FENCE();
#pragma unroll
      for (int i = 0; i < 64; ++i) SA[i * SAP + lane] = T[i]; }
    LDS_FENCE();
#ifdef PROBE_SUB
    unsigned long long t_c = __builtin_amdgcn_s_memrealtime();
#endif
    int r32b = r32, hib = hi; asm volatile("" : "+v"(r32b), "+v"(hib));
#if defined(DUP_PH) && DUP_PH == 35
    for (int rep35 = 0; rep35 < 2; ++rep35)
#endif
#pragma unroll
    for (int pass = 0; pass < 2; ++pass) {
        bf16x8 tb[2][4]; asm volatile("" : "+v"(r32b), "+v"(hib));
#pragma unroll
        for (int ti = 0; ti < 2; ++ti) { const int i = 32 * ti + r32b, ci = dir ? 63 - i : i;
#pragma unroll
            for (int kb = 0; kb < 4; ++kb) { float a[8];
#pragma unroll
                for (int e = 0; e < 8; ++e) { const int j = 16 * kb + 8 * hib + e, cj = dir ? 63 - j : j; a[e] = SA[ci * SAP + cj] * sv[64 + 64 * pass + j]; }
                tb[ti][kb] = pack8(a[0], a[1], a[2], a[3], a[4], a[5], a[6], a[7]); asm volatile("" ::: "memory"); } }
#pragma unroll
        for (int td = 0; td < 4; ++td) { f32x16 a0 = {}, a1 = {}; asm volatile("" : "+v"(r32b), "+v"(hib));
            if (pass == 0) {
#pragma unroll
                for (int kb = 0; kb < 4; ++kb) { a0 = MFMA32(tb[0][kb], xf[td][kb], a0); a1 = MFMA32(tb[1][kb], xf[td][kb], a1); }
#pragma unroll
                for (int kb = 0; kb < 4; ++kb) xf[td][kb] = ld8(KTp + td * 2048 + 16 * kb);
                bf16* up = F.UT() + (size_t)item * 8192 + (32 * td + r32b) * 64 + 4 * hib;
#pragma unroll
                for (int q = 0; q < 4; ++q) { v2u w; w.x = pk2(a0[4 * q], a0[4 * q + 1]); w.y = pk2(a0[4 * q + 2], a0[4 * q + 3]); *(v2u*)(up + 8 * q) = w;
                    v2u w1; w1.x = pk2(a1[4 * q], a1[4 * q + 1]); w1.y = pk2(a1[4 * q + 2], a1[4 * q + 3]); *(v2u*)(up + 32 + 8 * q) = w1; }
            } else {
#pragma unroll
                for (int kb = 0; kb < 4; ++kb) { a0 = MFMA32(xf[td][kb], tb[0][kb], a0); a1 = MFMA32(xf[td][kb], tb[1][kb], a1); }
                bf16* wp = F.W() + (size_t)item * 8192 + r32b * 128 + 32 * td + 4 * hib;
#pragma unroll
                for (int q = 0; q < 4; ++q) { v2u w; w.x = pk2(a0[4 * q], a0[4 * q + 1]); w.y = pk2(a0[4 * q + 2], a0[4 * q + 3]); *(v2u*)(wp + 8 * q) = w;
                    v2u w1; w1.x = pk2(a1[4 * q], a1[4 * q + 1]); w1.y = pk2(a1[4 * q + 2], a1[4 * q + 3]); *(v2u*)(wp + 32 * 128 + 8 * q) = w1; }
            }
            asm volatile("" ::: "memory"); }
    }
    LDS_FENCE();
#ifdef PROBE_SUB
    { asm volatile("s_waitcnt vmcnt(0)" ::: "memory"); unsigned long long t_d = __builtin_amdgcn_s_memrealtime();
      if (blockIdx.x == 0 && F.wave == 0 && lane == 0) { unsigned long long* ts = (unsigned long long*)(F.QCTR() + 1024); const unsigned long long d = (PROBE_SUB == 1) ? (t_b - t_a) : (PROBE_SUB == 2) ? (t_c - t_b) : (t_d - t_c);
          ts[13] = ((item >> 11) == 0 && (item & 2047) < 8 ? 0ull : ts[13]) + d; ts[12] = 0ull; } }
#endif
}
constexpr int SC_W = 0, SC_Q = 16896, SC_KT = 33792, SC_QK = 51200, SC_EG = 59904, SC_BUF = 60416, SC_PW = 264, SC_PK = 136;
#define SC_BAR() asm volatile("s_waitcnt lgkmcnt(0)\n\ts_barrier" ::: "memory")
__device__ __forceinline__ bf16x8 lds44(const LAS unsigned char* p) { const s16x4 a = *(const LAS s16x4*)p, b = *(const LAS s16x4*)(p + 16); return (bf16x8){a[0], a[1], a[2], a[3], b[0], b[1], b[2], b[3]}; }
__device__ __forceinline__ void lds_put16(LAS unsigned char* p, v4u v) { *(LAS v2u*)p = (v2u){v.x, v.y}; *(LAS v2u*)(p + 8) = (v2u){v.z, v.w}; }
struct ScanRegs { v4u w[4], q[4], k[4], m[2], e; };
__device__ __forceinline__ void scan_load(Frame& F, ScanRegs& R, int lt, size_t it, size_t tok0, int h4, size_t ktoff) {
#pragma unroll
    for (int k = 0; k < 4; ++k) { const int c = lt + 256 * k;
        R.w[k] = *(const v4u*)(F.W() + it * 8192 + c * 8);
        R.q[k] = *(const v4u*)(F.DQ() + (tok0 + (c >> 4)) * 512 + h4 * 128 + (c & 15) * 8);
        R.k[k] = *(const v4u*)(F.KT() + ktoff + c * 8); }
#pragma unroll
    for (int k = 0; k < 2; ++k) R.m[k] = *(const v4u*)(F.QKM() + it * 4096 + (lt + 256 * k) * 8);
    if (lt < 32) R.e = *(const v4u*)(F.EG() + it * 128 + lt * 4);
}
__device__ __forceinline__ void scan_put(const ScanRegs& R, LAS unsigned char* buf, int lt) {
#pragma unroll
    for (int k = 0; k < 4; ++k) { const int c = lt + 256 * k;
        lds_put16(buf + SC_W + (c >> 4) * SC_PW + (c & 15) * 16, R.w[k]); lds_put16(buf + SC_Q + (c >> 4) * SC_PW + (c & 15) * 16, R.q[k]); lds_put16(buf + SC_KT + (c >> 3) * SC_PK + (c & 7) * 16, R.k[k]); }
#pragma unroll
    for (int k = 0; k < 2; ++k) { const int c = lt + 256 * k; lds_put16(buf + SC_QK + (c >> 3) * SC_PK + (c & 7) * 16, R.m[k]); }
    if (lt < 32) lds_put16(buf + SC_EG + lt * 16, R.e);
}
__device__ __forceinline__ void dn_scan_wg(Frame& F, int bh8) {
    const int h8 = bh8 & 7, b = bh8 >> 3, dir = h8 >> 2, h4 = h8 & 3; const int lane = F.lane, r32 = lane & 31, hi = lane >> 5, wid = F.wave;
#define SC_N(s) (dir ? 127 - (s) : (s))
#define SC_IT(s) ((size_t)bh8 * 128 + SC_N(s))
#define SC_TOK(s) ((size_t)b * SEQ + SC_N(s) * 64)
#define SC_KTO(s) (((size_t)(b * 4 + h4) * 128 + SC_N(s)) * 8192)
    if (wid >= 4) {
        const int lt = F.tid - 256; ScanRegs R;
        scan_load(F, R, lt, SC_IT(0), SC_TOK(0), h4, SC_KTO(0)); scan_put(R, F.lds, lt);
        scan_load(F, R, lt, SC_IT(1), SC_TOK(1), h4, SC_KTO(1));
        SC_BAR();
        for (int s = 0; s < 128; ++s) {
            if (s + 1 < 128) scan_put(R, F.lds + ((s + 1) & 1) * SC_BUF, lt);
            if (s + 2 < 128) scan_load(F, R, lt, SC_IT(s + 2), SC_TOK(s + 2), h4, SC_KTO(s + 2));
            SC_BAR(); }
    } else {
        const int sl = wid; f32x16 S[4];
#pragma unroll
        for (int t = 0; t < 4; ++t) S[t] = (f32x16){};
        bf16* Obase = (dir ? F.OB() : F.OF()) + h4 * 128 + 32 * sl + 4 * hi;
        const bf16* UTb = F.UT() + (size_t)(32 * sl + r32) * 64 + 4 * hi;
        s16x4 ut[8];
#pragma unroll
        for (int q = 0; q < 8; ++q) ut[q] = *(const s16x4*)(UTb + SC_IT(0) * 8192 + 8 * q);
        SC_BAR();
        for (int s = 0; s < 128; ++s) {
            const LAS unsigned char* buf = F.lds + (s & 1) * SC_BUF; const size_t tok0 = SC_TOK(s);
            const LAS unsigned char* aW = buf + SC_W + r32 * SC_PW + 8 * hi; const LAS unsigned char* aQ = buf + SC_Q + r32 * SC_PW + 8 * hi;
            const LAS unsigned char* aK = buf + SC_KT + r32 * SC_PK + 8 * hi; const LAS unsigned char* aM = buf + SC_QK + r32 * SC_PK + 8 * hi;
            const LAS float* eg = (const LAS float*)(buf + SC_EG);
            bf16x8 Sb[8];
#pragma unroll
            for (int kb = 0; kb < 8; ++kb) { const int tk = kb >> 1, rb = 8 * (kb & 1); Sb[kb] = pack8(S[tk][rb], S[tk][rb + 1], S[tk][rb + 2], S[tk][rb + 3], S[tk][rb + 4], S[tk][rb + 5], S[tk][rb + 6], S[tk][rb + 7]); }
            f32x16 vn[2];
            { f32x16 a0 = {}, a1 = {};
#pragma unroll
              for (int kb = 0; kb < 8; ++kb) { a0 = MFMA32(lds44(aW + 32 * kb), Sb[kb], a0); a1 = MFMA32(lds44(aW + 32 * SC_PW + 32 * kb), Sb[kb], a1); }
#pragma unroll
              for (int q = 0; q < 4; ++q)
#pragma unroll
                  for (int e = 0; e < 4; ++e) { a0[4 * q + e] = bf2f(ut[q][e]) - a0[4 * q + e]; a1[4 * q + e] = bf2f(ut[4 + q][e]) - a1[4 * q + e]; }
              vn[0] = a0; vn[1] = a1; }
            if (s + 1 < 128) {
#pragma unroll
                for (int q = 0; q < 8; ++q) ut[q] = *(const s16x4*)(UTb + SC_IT(s + 1) * 8192 + 8 * q); }
            bf16x8 vb[4];
#pragma unroll
            for (int k2 = 0; k2 < 4; ++k2) { const int tc = k2 >> 1, rb = 8 * (k2 & 1);
                vb[k2] = pack8(vn[tc][rb], vn[tc][rb + 1], vn[tc][rb + 2], vn[tc][rb + 3], vn[tc][rb + 4], vn[tc][rb + 5], vn[tc][rb + 6], vn[tc][rb + 7]); }
            { f32x16 o0 = {}, o1 = {};
#pragma unroll
              for (int kb = 0; kb < 8; ++kb) { o0 = MFMA32(Sb[kb], lds44(aQ + 32 * kb), o0); o1 = MFMA32(Sb[kb], lds44(aQ + 32 * SC_PW + 32 * kb), o1); }
              o0 = o0 * eg[r32]; o1 = o1 * eg[32 + r32];
#pragma unroll
              for (int k2 = 0; k2 < 4; ++k2) { o0 = MFMA32(vb[k2], lds44(aM + 32 * k2), o0); o1 = MFMA32(vb[k2], lds44(aM + 32 * SC_PK + 32 * k2), o1); }
              bf16* op = Obase + (tok0 + r32) * 512;
#pragma unroll
              for (int q = 0; q < 4; ++q) { v2u w; w.x = pk2(o0[4 * q], o0[4 * q + 1]); w.y = pk2(o0[4 * q + 2], o0[4 * q + 3]); *(v2u*)(op + 8 * q) = w;
                  v2u w1; w1.x = pk2(o1[4 * q], o1[4 * q + 1]); w1.y = pk2(o1[4 * q + 2], o1[4 * q + 3]); *(v2u*)(op + 32 * 512 + 8 * q) = w1; } }
            const float gtot = eg[dir ? 0 : 63];
#pragma unroll
            for (int tk = 0; tk < 4; ++tk) S[tk] = S[tk] * gtot;
#pragma unroll
            for (int k2 = 0; k2 < 4; ++k2) { const int tc = k2 >> 1, rb = 8 * (k2 & 1); float l[8];
#pragma unroll
                for (int h = 0; h < 2; ++h) { const f32x4 l4 = *(const LAS f32x4*)(eg + 64 + 32 * tc + 8 * (2 * (k2 & 1) + h) + 4 * hi);
#pragma unroll
                    for (int e = 0; e < 4; ++e) l[4 * h + e] = l4[e]; }
                const bf16x8 vsb = pack8(vn[tc][rb] * l[0], vn[tc][rb + 1] * l[1], vn[tc][rb + 2] * l[2], vn[tc][rb + 3] * l[3], vn[tc][rb + 4] * l[4], vn[tc][rb + 5] * l[5], vn[tc][rb + 6] * l[6], vn[tc][rb + 7] * l[7]);
#pragma unroll
                for (int tk = 0; tk < 4; ++tk) S[tk] = MFMA32(lds44(aK + tk * 32 * SC_PK + 32 * k2), vsb, S[tk]); }
            SC_BAR();
        }
    }
#undef SC_N
#undef SC_IT
#undef SC_TOK
#undef SC_KTO
}
struct DynOrder {
    unsigned* ctr; int xcd; LAS unsigned* slot;
    __device__ __forceinline__ bool next(int, attn_body::AttnUnit& u) const {
        if (threadIdx.x == 0) { unsigned v = 0xffffffffu;
            for (int k = 0; k < 8; ++k) { const int x = (xcd + k) & 7; const unsigned t = __hip_atomic_fetch_add(ctr + 64 * x, 1u, __ATOMIC_RELAXED, __HIP_MEMORY_SCOPE_AGENT); if (t < 256u) { v = (unsigned)x | (t << 3); break; } }
            *slot = v; }
        asm volatile("s_waitcnt vmcnt(0) lgkmcnt(0)\n\ts_barrier" ::: "memory");
        const unsigned v = *slot;
        asm volatile("s_waitcnt lgkmcnt(0)\n\ts_barrier" ::: "memory");
        if (v == 0xffffffffu) return false;
        const unsigned x = v & 7u, t = v >> 3; u.bh = (int)(x + 8u * (t >> 5)); u.qb = (int)(t & 31u); return true; }
    __device__ __forceinline__ void a_ready(const attn_body::AttnUnit&) const {}
    __device__ __forceinline__ void done(const attn_body::AttnUnit&) const {}
};
__device__ __forceinline__ void p5_mix_chunk(Frame& F, const int tok0) {
    const int lane = F.lane;
    const float g0 = F.dn_norm()[2 * lane], g1 = F.dn_norm()[2 * lane + 1];
    const bf16* __restrict__ OFp = F.OF(); const bf16* __restrict__ OBp = F.OB(); const bf16* __restrict__ Zp = F.Z(); bf16* __restrict__ MX = F.MIXED();
    for (int t0 = tok0 + 2 * F.wave; t0 < tok0 + 64; t0 += 2 * NWAVES) { unsigned a[8], c[8], z[8];
#pragma unroll
        for (int k = 0; k < 8; ++k) { const size_t off = (size_t)(t0 + (k >> 2)) * 512 + (k & 3) * 128 + 2 * lane; a[k] = *(const unsigned*)(OFp + off); c[k] = *(const unsigned*)(OBp + off); z[k] = *(const unsigned*)(Zp + off); }
#pragma unroll
        for (int k = 0; k < 8; ++k) { const float o0 = bflo(a[k]) + bflo(c[k]), o1 = bfhi(a[k]) + bfhi(c[k]); const float rs = rsqrtf(wave_sum(o0 * o0 + o1 * o1) * (1.f / 128.f) + EPS);
            const float z0 = bflo(z[k]), z1 = bfhi(z[k]);
            *(unsigned*)(MX + (size_t)(t0 + (k >> 2)) * 1024 + 512 + (k & 3) * 128 + 2 * lane) = pk2(o0 * rs * g0 * z0 * fast_sig(z0), o1 * rs * g1 * z1 * fast_sig(z1)); } }
}
__device__ __forceinline__ void p10_final(Frame& F, const float probe_delta) {
    const int gw = F.vcu * NWAVES + F.wave, NGW = F.G * NWAVES;
    f32x4 gn[4];
#pragma unroll
    for (int j = 0; j < 4; ++j) gn[j] = ((const f32x4*)F.norm_final())[F.lane + 64 * j];
    for (int m0 = gw * 4; m0 < M; m0 += NGW * 4) { v2u v[4][4]; float sq[4];
#pragma unroll
        for (int r = 0; r < 4; ++r) { const v2u* xr = (const v2u*)(F.HB1() + (size_t)(m0 + r) * DM) + F.lane; sq[r] = F.SS()[2 * M + m0 + r];
#pragma unroll
            for (int j = 0; j < 4; ++j) v[r][j] = xr[64 * j]; }
#pragma unroll
        for (int r = 0; r < 4; ++r) { f32x4* xr = (f32x4*)(F.out + (size_t)(m0 + r) * DM) + F.lane; const float rstd = rsqrtf(sq[r] * (1.f / DM) + EPS); const int m = m0 + r;
#pragma unroll
            for (int j = 0; j < 4; ++j) { f32x4 y = (f32x4){bflo(v[r][j].x), bfhi(v[r][j].x), bflo(v[r][j].y), bfhi(v[r][j].y)} * rstd * gn[j]; if (probe_delta != 0.f && m < 1024) y = y + probe_delta; __builtin_nontemporal_store(y, &xr[64 * j]);
#ifdef PROBE_DUPWRITE
                __builtin_nontemporal_store(y, (f32x4*)((float*)(F.ws + WS_C) + (size_t)m * DM) + F.lane + 64 * j);
#endif
#ifdef PROBE_DUPOUT
                asm volatile("" ::: "memory"); __builtin_nontemporal_store(y, &xr[64 * j]);
#endif
            } } }
}
constexpr int N_PHASES = 11;
__global__ void __launch_bounds__(NWAVES * 64, 2) hymba_fwd(Args args) {
    extern __shared__ __attribute__((aligned(16))) unsigned char lds[];
    cg::grid_group grid = cg::this_grid();
    Frame F;
    F.lds = (LAS unsigned char*)lds; F.tid = threadIdx.x; F.lane = F.tid & 63; F.wave = __builtin_amdgcn_readfirstlane(F.tid >> 6);
    F.G = gridDim.x; { const int bx = blockIdx.x; F.vcu = (F.G % 8 == 0) ? (bx % 8) * (F.G / 8) + bx / 8 : bx; }
    F.in = args.in; F.out = args.out; F.ws = args.ws;
    const int lo = args.ph_lo, hi = args.ph_hi; unsigned bar_epoch = 0u;
    if (hi > 1000) grid.sync();
#ifndef ONLY_PH
#define ONLY_PH -1
#endif
#define IN(k) ((ONLY_PH < 0 || ONLY_PH == (k)) && lo <= (k) && (k) < hi)
#ifndef DUP_PH
#define DUP_PH -1
#endif
#define REPS(k) ((DUP_PH == (k)) ? 2 : 1)
#define SEAM(k) do { if (IN(k) && IN((k) + 1)) { { \
        asm volatile("s_waitcnt vmcnt(0)" ::: "memory"); __syncthreads();            \
        ++bar_epoch; \
        if (F.tid == 0) { unsigned* c_ = F.QCTR() + 512; __builtin_amdgcn_fence(__ATOMIC_RELEASE, "agent"); asm volatile("s_waitcnt vmcnt(0)" ::: "memory");     \
            __hip_atomic_fetch_add(c_, 1u, __ATOMIC_RELAXED, __HIP_MEMORY_SCOPE_AGENT); \
            const unsigned tgt_ = bar_epoch * (unsigned)F.G; while (__hip_atomic_load(c_, __ATOMIC_RELAXED, __HIP_MEMORY_SCOPE_AGENT) < tgt_) __builtin_amdgcn_s_sleep(1); \
            __builtin_amdgcn_fence(__ATOMIC_ACQUIRE, "agent"); asm volatile("s_waitcnt vmcnt(0)" ::: "memory"); }     \
        __syncthreads(); } } } while (0)
#ifndef PROBE_SCALE
#define PROBE_SCALE 4e-5f
#endif
#ifdef PROBE_T
#define STAMP(k) do { if (blockIdx.x == 0 && F.tid == 0) ((unsigned long long*)(F.QCTR() + 1024))[k] = __builtin_amdgcn_s_memrealtime(); } while (0)
#else
#define STAMP(k) do { } while (0)
#endif
    STAMP(0);
    if (IN(0)) for (int rep = 0; rep < REPS(0); ++rep) { p0_prologue(F); __syncthreads(); }
    SEAM(0); STAMP(1);
    if (IN(1)) for (int rep = 0; rep < REPS(1); ++rep) { pg8::Gemm g{F.XN(), F.Wt_in(), M, NPAD, DM}; pg8::StaticOrder S; S.init(M, NPAD, F.G, (int)blockIdx.x); pg8::EpiProj E{F.PROJ(), F.BA()};
        pg8::gemm_phase<pg8::EpiProj, pg8::StaticOrder, true, true>(F.lds, g, S, E, F.wave); }
    SEAM(1); STAMP(2);
    if (IN(2)) for (int rep = 0; rep < REPS(2); ++rep) { p2_rope_table(F); for (int r2 = 0; r2 < REPS(21); ++r2) p2_attn_rows(F); for (int r2 = 0; r2 < REPS(22); ++r2) p2_dn_conv(F); __syncthreads(); }
    SEAM(2); STAMP(3);
    if (IN(3)) {
        { LAS float* SA = (LAS float*)(F.lds + F.wave * 18176); LAS float* sv = SA + 64 * SAP;
          for (int it = F.vcu * NWAVES + F.wave; it < NB * 8 * 128; it += F.G * NWAVES) dn_prep_item(F, it, SA, sv, F.lane); }
        asm volatile("s_waitcnt vmcnt(0)" ::: "memory"); __syncthreads();
        if (F.tid == 0) { __builtin_amdgcn_fence(__ATOMIC_RELEASE, "agent"); asm volatile("s_waitcnt vmcnt(0)" ::: "memory"); __hip_atomic_fetch_add(F.QCTR() + 768, 1u, __ATOMIC_RELAXED, __HIP_MEMORY_SCOPE_AGENT); }
    }
    STAMP(4);
    if (IN(4)) {
#ifndef NO_SCAN
        if ((int)blockIdx.x < NB * 8) {
            if (F.tid == 0) { while (__hip_atomic_load(F.QCTR() + 768, __ATOMIC_RELAXED, __HIP_MEMORY_SCOPE_AGENT) < (unsigned)F.G) __builtin_amdgcn_s_sleep(2);
                __builtin_amdgcn_fence(__ATOMIC_ACQUIRE, "agent"); asm volatile("s_waitcnt vmcnt(0)" ::: "memory"); }
            __syncthreads();
            dn_scan_wg(F, (int)blockIdx.x);
            asm volatile("s_waitcnt vmcnt(0)" ::: "memory"); __syncthreads();
            if (F.tid == 0) { __builtin_amdgcn_fence(__ATOMIC_RELEASE, "agent"); asm volatile("s_waitcnt vmcnt(0)" ::: "memory"); __hip_atomic_fetch_add(F.QCTR() + 640, 1u, __ATOMIC_RELAXED, __HIP_MEMORY_SCOPE_AGENT); } }
#endif
#ifdef PROBE_SERIAL
        { __builtin_amdgcn_fence(__ATOMIC_RELEASE, "agent"); __syncthreads(); if (F.tid == 0) { unsigned* c_ = F.QCTR() + 576; __hip_atomic_fetch_add(c_, 1u, __ATOMIC_RELEASE, __HIP_MEMORY_SCOPE_AGENT); while (__hip_atomic_load(c_, __ATOMIC_RELAXED, __HIP_MEMORY_SCOPE_AGENT) < (unsigned)F.G) __builtin_amdgcn_s_sleep(2); } __syncthreads(); }
#endif
        { const attn_body::AttnTensors AT{(const attn_body::bf16*)F.QA(), (const attn_body::bf16*)F.KA(), (const attn_body::bf16*)F.VA(), (attn_body::bf16*)F.MIXED()};
          const DynOrder S{F.QCTR(), (int)(__builtin_amdgcn_s_getreg((3 << 11) | 20) & 7), (LAS unsigned*)(F.lds + 135168)};
          float mq = fabsf(F.q_norm()[F.lane]), mk = fabsf(F.k_norm()[F.lane]);
#pragma unroll
          for (int o = 1; o < 64; o <<= 1) { mq = fmaxf(mq, __shfl_xor(mq, o)); mk = fmaxf(mk, __shfl_xor(mk, o)); }
          const bool bounded = __builtin_amdgcn_readfirstlane((int)(23.1f * mq * mk < 60.f)) != 0;
          if (bounded) attn_body::attn_phase<DynOrder, -1>((char*)lds, AT, S); else attn_body::attn_phase<DynOrder, 8>((char*)lds, AT, S); }
        __syncthreads();
        F.lane = (int)__builtin_amdgcn_mbcnt_hi(~0u, __builtin_amdgcn_mbcnt_lo(~0u, 0u)); F.tid = F.wave * 64 + F.lane;
        if (F.tid == 0) { while (__hip_atomic_load(F.QCTR() + 640, __ATOMIC_RELAXED, __HIP_MEMORY_SCOPE_AGENT) < (unsigned)(NB * 8)) __builtin_amdgcn_s_sleep(2);
            __builtin_amdgcn_fence(__ATOMIC_ACQUIRE, "agent"); asm volatile("s_waitcnt vmcnt(0)" ::: "memory"); }
        __syncthreads();
        { LAS unsigned* slot = (LAS unsigned*)(F.lds + 135168);
          for (;;) { if (F.tid == 0) *slot = __hip_atomic_fetch_add(F.QCTR() + 704, 1u, __ATOMIC_RELAXED, __HIP_MEMORY_SCOPE_AGENT);
              asm volatile("s_waitcnt vmcnt(0) lgkmcnt(0)\n\ts_barrier" ::: "memory"); const unsigned c = *slot; asm volatile("s_waitcnt lgkmcnt(0)\n\ts_barrier" ::: "memory");
              if (c >= (unsigned)(M / 64)) break; p5_mix_chunk(F, (int)c * 64); } }
    }
    F.lane = (int)__builtin_amdgcn_mbcnt_hi(~0u, __builtin_amdgcn_mbcnt_lo(~0u, 0u)); F.tid = F.wave * 64 + F.lane;
    SEAM(4); STAMP(5);
    STAMP(6);
#ifdef PROBE_BAR
    for (int xb = 1; xb <= 20; ++xb) { asm volatile("s_waitcnt vmcnt(0)" ::: "memory"); __syncthreads();
        if (F.tid == 0) { unsigned* c_ = F.QCTR() + 512 + 16; __builtin_amdgcn_fence(__ATOMIC_RELEASE, "agent"); asm volatile("s_waitcnt vmcnt(0)" ::: "memory");
            __hip_atomic_fetch_add(c_, 1u, __ATOMIC_RELAXED, __HIP_MEMORY_SCOPE_AGENT);
            const unsigned tgt_ = (unsigned)xb * (unsigned)F.G; while (__hip_atomic_load(c_, __ATOMIC_RELAXED, __HIP_MEMORY_SCOPE_AGENT) < tgt_) __builtin_amdgcn_s_sleep(1);
            __builtin_amdgcn_fence(__ATOMIC_ACQUIRE, "agent"); asm volatile("s_waitcnt vmcnt(0)" ::: "memory"); }
        __syncthreads(); }
#endif
    if (IN(6)) { pg8::Gemm g{F.MIXED(), F.Wt_out(), M, DM, DM}; pg8::StaticOrder S; S.init(M, DM, F.G, (int)blockIdx.x); pg8::EpiRes<false> E{F.x(), F.HB1(), F.SS()};
        pg8::gemm_phase<pg8::EpiRes<false>, pg8::StaticOrder, true, true>(F.lds, g, S, E, F.wave); }
    SEAM(6); STAMP(7);
    if (IN(7)) for (int rep = 0; rep < REPS(7); ++rep) { pg8::Gemm g{F.HB1(), F.Wt_gu(), M, 2 * FF, DM}; pg8::StaticOrder S; S.init(M, 2 * FF, F.G, (int)blockIdx.x); pg8::EpiGU E{F.SS(), F.ACT()};
        pg8::gemm_phase<pg8::EpiGU, pg8::StaticOrder, true, true>(F.lds, g, S, E, F.wave); }
    SEAM(7); STAMP(8);
    if (IN(8)) { pg8::Gemm g{F.ACT(), F.Wt_dn(), M, DM, FF}; pg8::StaticOrder S; S.init(M, DM, F.G, (int)blockIdx.x); pg8::EpiRes<true> E{F.HB1(), F.HB2(), F.SS() + M};
        pg8::gemm_phase<pg8::EpiRes<true>, pg8::StaticOrder, true, true>(F.lds, g, S, E, F.wave); }
    SEAM(8); STAMP(9);
    if (IN(9)) {
#ifndef NO_G9A
        { int kpe = 256; asm volatile("" : "+s"(kpe)); pg8::Gemm g{F.PB(), F.Wt_pl(), M, DM, kpe}; pg8::StaticOrder S; S.init(M, DM, F.G, (int)blockIdx.x); pg8::EpiStore E{F.PE(), DM};
          pg8::gemm_phase<pg8::EpiStore, pg8::StaticOrder, true, true>(F.lds, g, S, E, F.wave); }
#endif
        asm volatile("s_waitcnt vmcnt(0)" ::: "memory"); __syncthreads();
#ifndef NO_G9B
        { pg8::Gemm g{F.HB2(), F.Wt_pg(), M, DM, DM}; pg8::StaticOrder S; S.init(M, DM, F.G, (int)blockIdx.x); pg8::EpiPle E{F.HB2(), F.HB1(), F.PE(), F.SS() + M, F.SS() + 2 * M};
          pg8::gemm_phase<pg8::EpiPle, pg8::StaticOrder, true, true>(F.lds, g, S, E, F.wave); }
#endif
    }
    SEAM(9); STAMP(10);
    if (IN(10)) { p10_final(F, 0.f); }
#ifdef PROBE_T
    {
        asm volatile("s_waitcnt vmcnt(0)" ::: "memory"); __syncthreads();
        if (F.tid == 0) { unsigned* c_ = F.QCTR() + 512; __builtin_amdgcn_fence(__ATOMIC_RELEASE, "agent"); asm volatile("s_waitcnt vmcnt(0)" ::: "memory");
            __hip_atomic_fetch_add(c_, 1u, __ATOMIC_RELAXED, __HIP_MEMORY_SCOPE_AGENT);
            const unsigned tgt_ = 11u * (unsigned)F.G; while (__hip_atomic_load(c_, __ATOMIC_RELAXED, __HIP_MEMORY_SCOPE_AGENT) < tgt_) __builtin_amdgcn_s_sleep(1);
            __builtin_amdgcn_fence(__ATOMIC_ACQUIRE, "agent"); asm volatile("s_waitcnt vmcnt(0)" ::: "memory"); }
        __syncthreads();
        STAMP(11);
        float delta = 0.f; { const unsigned long long* ts = (const unsigned long long*)(F.QCTR() + 1024); unsigned long long acc_ = 0;
          for (int k = 0; k < 13; ++k) if ((PROBE_T >> k) & 1) acc_ += __hip_atomic_load(ts + k + 1, __ATOMIC_RELAXED, __HIP_MEMORY_SCOPE_AGENT) - __hip_atomic_load(ts + k, __ATOMIC_RELAXED, __HIP_MEMORY_SCOPE_AGENT);
          delta = (float)acc_ * 0.01f * PROBE_SCALE; }
        for (int m = F.vcu * NWAVES + F.wave; m < 1024; m += F.G * NWAVES) { f32x4* xr = (f32x4*)(F.out + (size_t)m * DM) + F.lane;
            for (int j = 0; j < 4; ++j) xr[64 * j] = xr[64 * j] + delta; }
    }
#endif
#undef IN
#undef SEAM
}

#ifndef MK_PER_PHASE
#define MK_PER_PHASE 0
#endif
extern "C" void kernel_launch(void* const* d_in, const int* in_sizes, int n_in, void* d_out, int out_size, void* d_ws, size_t ws_size, hipStream_t stream) {
    static int grid = 0;
    if (grid == 0) {
        if (n_in != 19 || in_sizes[0] != M * DM || out_size != M * DM || ws_size < WS_END) { fprintf(stderr, "kernel_launch: unexpected shapes / workspace (n_in %d, ws %zu); nothing launched\n", n_in, ws_size); grid = -1; return; }
        int dev = 0, cus = 0, per_cu = 0;
        (void)hipGetDevice(&dev); (void)hipDeviceGetAttribute(&cus, hipDeviceAttributeMultiprocessorCount, dev);
        (void)hipFuncSetAttribute((const void*)hymba_fwd, hipFuncAttributeMaxDynamicSharedMemorySize, LDS_BYTES);
        (void)hipOccupancyMaxActiveBlocksPerMultiprocessor(&per_cu, (const void*)hymba_fwd, NWAVES * 64, LDS_BYTES);
        (void)hipGetLastError();
        if (per_cu < 1) { fprintf(stderr, "kernel_launch: occupancy query says %d blocks per CU\n", per_cu); per_cu = 1; }
        grid = cus;
    }
    if (grid < 0) return;
    (void)hipMemsetAsync((unsigned char*)d_ws + WS_QCTR + 512 * 4, 0, 256, stream);
    Args a{};
    for (int i = 0; i < 19; ++i) a.in[i] = (const float*)d_in[i];
    a.out = (float*)d_out; a.ws = (unsigned char*)d_ws;
#if MK_PER_PHASE
    for (int ph = 0; ph < N_PHASES; ++ph) { a.ph_lo = ph; a.ph_hi = ph + 1; hipLaunchKernelGGL(hymba_fwd, dim3(grid), dim3(NWAVES * 64), LDS_BYTES, stream, a); }
#else
    a.ph_lo = 0; a.ph_hi = N_PHASES;
    void* kargs[] = {&a};
    hipError_t e = hipLaunchCooperativeKernel((const void*)hymba_fwd, dim3(grid), dim3(NWAVES * 64), kargs, LDS_BYTES, stream);
    if (e != hipSuccess) fprintf(stderr, "cooperative launch failed: %s (grid %d)\n", hipGetErrorString(e), grid);
#endif
}
```
